# Optimizing an MI355X kernel written in HIP

```python
import math
import jax, jax.numpy as jnp
from jax import lax
import numpy as np

D_MODEL = 1024
BATCH = 1
SEQ = 16384
DEPTH = 2

A_HEADS = 4
A_DK = 128
A_DV = 128
A_CHUNK = 64
A_KEY = A_HEADS * A_DK
A_VAL = A_HEADS * A_DV
A_COLS = 3 * A_KEY + 2 * A_VAL
B_HEADS = 8
B_DH = 64
B_WIDTH = B_HEADS * B_DH
B_GROUPS = ((128, 1), (512, 4), (2048, 16))
B_BLOCK = 128
N_BUCKETS = 32
MAX_DISTANCE = 1024
AB_IN = A_COLS + 3 * B_WIDTH
AB_MIX = A_VAL + B_WIDTH
C_DH = 64
C_HEADS = D_MODEL // C_DH
C_DECAY_LORA = 64
C_AAA_LORA = 64
C_GATE_LORA = 128
C_GN_EPS = 64e-5
N_EXPERTS = 16
CAPACITY_FACTOR = 2
D_EXPERT = 2 * D_MODEL
N_EVEN = (DEPTH + 1) // 2
N_ODD = DEPTH // 2
RMS_EPS = 1e-6
NEG_INF = -1e30

kernel_name = 'hybrid_hgrn2_dilattn_rwkv7_ecmoe'


def rmsnorm(x, gain):
    xf = x.astype(jnp.float32)
    y = xf * lax.rsqrt(jnp.mean(xf * xf, axis=-1, keepdims=True) + RMS_EPS)
    return (y * gain.astype(jnp.float32)).astype(x.dtype)


def t5_bucket(rel):
    half = N_BUCKETS // 2
    max_exact = half // 2
    n = jnp.abs(rel)
    nf = jnp.maximum(n, 1).astype(jnp.float32)
    large = max_exact + (jnp.log(nf / max_exact) / math.log(MAX_DISTANCE / max_exact) * (half - max_exact)).astype(jnp.int32)
    large = jnp.minimum(large, half - 1)
    return jnp.where(rel > 0, half, 0) + jnp.where(n < max_exact, n, large)


def _gla_chunk_step(state, inp):
    q, k, v, g = inp
    c = q.shape[-2]
    cum = jnp.cumsum(g, axis=-2)
    last = cum[..., -1:, :]
    inter = jnp.einsum('zbhck,zbhkv->zbhcv', q * jnp.exp(cum), state)
    lower = jnp.tril(jnp.ones((c, c), dtype=bool))[:, :, None]
    decay = jnp.exp(jnp.where(lower, cum[..., :, None, :] - cum[..., None, :, :], -jnp.inf))
    scores = jnp.einsum('zbhtk,zbhsk,zbhtsk->zbhts', q, k, decay)
    intra = jnp.einsum('zbhts,zbhsv->zbhtv', scores, v)
    new_state = jnp.exp(last[..., 0, :])[..., None] * state + jnp.einsum('zbhck,zbhcv->zbhkv', k * jnp.exp(last - cum), v)
    return new_state, inter + intra


def hgrn2_bidir(q, k, v, logf):
    b, s, h, dk = q.shape
    dv = v.shape[-1]
    nc = s // A_CHUNK
    both = lambda t: jnp.stack([t, jnp.flip(t, axis=1)])
    per_dir = lambda t: jnp.stack([t[0], jnp.flip(t[1], axis=1)])
    def chunks(t):
        return t.reshape(2, b, nc, A_CHUNK, h, t.shape[-1]).transpose(2, 0, 1, 4, 3, 5)
    xs = (chunks(both(q)), chunks(per_dir(k)), chunks(both(v)), chunks(per_dir(logf)))
    state0 = jnp.zeros((2, b, h, dk, dv), jnp.float32)
    _, o = lax.scan(_gla_chunk_step, state0, xs)
    o = o.transpose(1, 2, 0, 4, 3, 5).reshape(2, b, s, h, dv)
    return o[0] + jnp.flip(o[1], axis=1)


def hgrn2_mixer(p, lb, onorm):
    b, s, _ = p.shape
    q = p[..., :A_KEY].astype(jnp.float32).reshape(b, s, A_HEADS, A_DK)
    zf = p[..., A_KEY:3 * A_KEY].astype(jnp.float32).reshape(b, s, 2, A_HEADS, A_DK).transpose(2, 0, 1, 3, 4)
    v = p[..., 3 * A_KEY:3 * A_KEY + A_VAL].astype(jnp.float32).reshape(b, s, A_HEADS, A_DV)
    gate = p[..., 3 * A_KEY + A_VAL:A_COLS].astype(jnp.float32)
    lbh = lb.reshape(2, 1, 1, A_HEADS, A_DK)
    logf = jnp.log(lbh + (1.0 - lbh) * jax.nn.sigmoid(zf))
    k = (1.0 - lbh) * jax.nn.sigmoid(-zf)
    o = hgrn2_bidir(q, k, v, logf)
    o = o * lax.rsqrt(jnp.mean(o * o, axis=-1, keepdims=True) + RMS_EPS) * onorm.astype(jnp.float32)
    return (o.reshape(b, s, A_VAL) * jax.nn.silu(gate)).astype(p.dtype)


def dilated_group(q, k, v, window, dilation, rel_bias):
    b, s, h, d = q.shape
    side = window // (2 * dilation)
    L = s // dilation
    n = b * dilation
    nb = -(-L // B_BLOCK)
    lp = nb * B_BLOCK
    def to_res(t):
        return t.reshape(b, L, dilation, h, d).transpose(0, 2, 1, 3, 4).reshape(n, L, h, d)
    qr, kr, vr = to_res(q), to_res(k), to_res(v)
    qb = jnp.pad(qr, ((0, 0), (0, lp - L), (0, 0), (0, 0))).reshape(n, nb, B_BLOCK, h, d)
    kv_pad = ((0, 0), (side, (nb + 1) * B_BLOCK - side - L), (0, 0), (0, 0))
    def windows(t):
        tb = jnp.pad(t, kv_pad).reshape(n, nb + 1, B_BLOCK, h, d)
        return jnp.concatenate([tb[:, :-1], tb[:, 1:]], axis=2)
    kw, vw = windows(kr), windows(vr)
    t_idx = jnp.arange(B_BLOCK)[:, None]
    j_idx = jnp.arange(2 * B_BLOCK)[None, :]
    rel = j_idx - side - t_idx
    key_pos = jnp.arange(nb)[:, None, None] * B_BLOCK - side + j_idx[None]
    valid = (jnp.abs(rel) <= side)[None] & (key_pos >= 0) & (key_pos < L)
    bias = rel_bias.astype(jnp.float32)[t5_bucket(rel * dilation)].transpose(2, 0, 1)
    logits = jnp.einsum('nbqhd,nbkhd->nbhqk', qb, kw) * (d ** -0.5) + bias
    logits = jnp.where(valid[None, :, None], logits, NEG_INF)
    lse = jax.nn.logsumexp(logits, axis=-1)
    probs = jnp.exp(logits - lse[..., None])
    out = jnp.einsum('nbhqk,nbkhd->nbqhd', probs, vw).reshape(n, lp, h, d)[:, :L]
    lse = lse.transpose(0, 1, 3, 2).reshape(n, lp, h)[:, :L]
    out = out.reshape(b, dilation, L, h, d).transpose(0, 2, 1, 3, 4).reshape(b, s, h, d)
    lse = lse.reshape(b, dilation, L, h).transpose(0, 2, 1, 3).reshape(b, s, h)
    return out, lse


def dilated_attention(p, rel_bias):
    b, s, _ = p.shape
    q, k, v = [p[..., i * B_WIDTH:(i + 1) * B_WIDTH].astype(jnp.float32).reshape(b, s, B_HEADS, B_DH) for i in range(3)]
    res = [dilated_group(q, k, v, w, dil, rel_bias) for (w, dil) in B_GROUPS]
    outs = jnp.stack([r[0] for r in res])
    lses = jnp.stack([r[1] for r in res])
    wts = jax.nn.softmax(lses, axis=0)
    y = jnp.sum(wts[..., None] * outs, axis=0)
    return y.reshape(b, s, B_WIDTH).astype(p.dtype)


def rwkv7_bidir(r, decay, k, v, a, bb):
    both = lambda t: jnp.stack([t, jnp.flip(t, axis=1)])
    per_dir = lambda t: jnp.stack([t[0], jnp.flip(t[1], axis=1)])
    xs = tuple(jnp.moveaxis(t, 2, 0) for t in (both(r), per_dir(decay), both(k), both(v), both(a), both(bb)))
    def step(state, inp):
        r_t, w_t, k_t, v_t, a_t, b_t = inp
        sa = jnp.einsum('zbhvk,zbhk->zbhv', state, a_t)
        state = state * w_t[..., None, :] + sa[..., None] * b_t[..., None, :] + v_t[..., None] * k_t[..., None, :]
        return state, jnp.einsum('zbhvk,zbhk->zbhv', state, r_t)
    b_, s, h, n = r.shape
    state0 = jnp.zeros((2, b_, h, n, n), jnp.float32)
    _, ys = lax.scan(step, state0, xs)
    ys = jnp.moveaxis(ys, 0, 2)
    return ys[0] + jnp.flip(ys[1], axis=1)


def rwkv7_mixer(h, mu, mu_w, w_rkv, w0, w1, w2, a0, a1, a2, g1, g2, k_k, k_a, r_k, ln_w, ln_b, w_out):
    b, s, d = h.shape
    hf = h.astype(jnp.float32)
    zero = jnp.zeros_like(hf[:, :1])
    x_prev = jnp.concatenate([zero, hf[:, :-1]], axis=1)
    x_next = jnp.concatenate([hf[:, 1:], zero], axis=1)
    xx = 0.5 * (x_prev + x_next) - hf
    xr, xk, xv, xa, xg = [hf + xx * mu[i] for i in range(5)]
    r = xr @ w_rkv[0]
    k = xk @ w_rkv[1]
    v = xv @ w_rkv[2]
    xw = hf[None] + xx[None] * mu_w[:, None, None, :]
    wlog = -jax.nn.softplus(-(w0[:, None, None, :] + jnp.einsum('zbsr,zrd->zbsd', jnp.tanh(jnp.einsum('zbsd,zdr->zbsr', xw, w1)), w2))) - 0.5
    decay = jnp.exp(-jnp.exp(wlog))
    a = jax.nn.sigmoid(a0 + (xa @ a1) @ a2)
    g = jax.nn.sigmoid(xg @ g1) @ g2
    heads = lambda t: t.reshape(t.shape[:-1] + (C_HEADS, C_DH))
    kk = heads(k * k_k)
    kk = kk / jnp.maximum(jnp.linalg.norm(kk, axis=-1, keepdims=True), 1e-12)
    k = k * (1.0 + (a - 1.0) * k_a)
    rh, kh, vh, ah = heads(r), heads(k), heads(v), heads(a)
    y = rwkv7_bidir(rh, heads(decay), kh, vh, -kk, kk * ah)
    mean = jnp.mean(y, axis=-1, keepdims=True)
    var = jnp.mean((y - mean) ** 2, axis=-1, keepdims=True)
    y = (y - mean) * lax.rsqrt(var + C_GN_EPS) * heads(ln_w) + heads(ln_b)
    y = y + jnp.sum(rh * kh * r_k, axis=-1, keepdims=True) * vh
    return ((y.reshape(b, s, d) * g) @ w_out).astype(h.dtype)


def ec_moe(h, router, w_gate, w_up, w_down):
    b, s, d = h.shape
    cap = CAPACITY_FACTOR * s // N_EXPERTS
    aff = jax.nn.softmax(jnp.einsum('bsd,de->bse', h, router).astype(jnp.float32), axis=-1)
    gates, idx = lax.top_k(aff.transpose(0, 2, 1), cap)
    bidx = jnp.arange(b)[:, None, None]
    xe = h[bidx, idx]
    hid = jax.nn.silu(jnp.einsum('becd,edf->becf', xe, w_gate)) * jnp.einsum('becd,edf->becf', xe, w_up)
    ye = jnp.einsum('becf,efd->becd', hid, w_down) * gates[..., None].astype(h.dtype)
    return jnp.zeros_like(h).at[bidx, idx].add(ye.astype(h.dtype))


def setup_inputs(seed: int = 0) -> dict:
    key = jax.random.key(seed)
    ks = iter(jax.random.split(key, 40))
    D = D_MODEL
    nrm = lambda shape, scale: jax.random.normal(next(ks), shape, jnp.float32) * scale
    uni = lambda shape: jax.random.uniform(next(ks), shape, jnp.float32)
    return {
        'x': nrm((BATCH, SEQ, D), 1.0),
        'rel_bias': nrm((N_BUCKETS, B_HEADS), 0.5),
        'a_lb_logits': nrm((DEPTH + 1, 2, A_KEY), 0.5),
        'ab_norm': 1.0 + nrm((N_EVEN, D), 0.02),
        'ab_w_in': nrm((N_EVEN, D, AB_IN), D ** -0.5),
        'a_onorm': 1.0 + nrm((N_EVEN, A_HEADS, A_DV), 0.02),
        'ab_w_out': nrm((N_EVEN, AB_MIX, D), AB_MIX ** -0.5),
        'c_norm': 1.0 + nrm((N_ODD, D), 0.02),
        'c_mu': uni((N_ODD, 5, D)),
        'c_mu_w': uni((N_ODD, 2, D)),
        'c_w_rkv': nrm((N_ODD, 3, D, D), D ** -0.5),
        'c_w0': nrm((N_ODD, 2, D), 1.0),
        'c_w1': nrm((N_ODD, 2, D, C_DECAY_LORA), D ** -0.5),
        'c_w2': nrm((N_ODD, 2, C_DECAY_LORA, D), 0.5 * C_DECAY_LORA ** -0.5),
        'c_a0': nrm((N_ODD, D), 0.5),
        'c_a1': nrm((N_ODD, D, C_AAA_LORA), D ** -0.5),
        'c_a2': nrm((N_ODD, C_AAA_LORA, D), 0.5 * C_AAA_LORA ** -0.5),
        'c_g1': nrm((N_ODD, D, C_GATE_LORA), D ** -0.5),
        'c_g2': nrm((N_ODD, C_GATE_LORA, D), C_GATE_LORA ** -0.5),
        'c_k_k': 0.85 + nrm((N_ODD, D), 0.1),
        'c_k_a': 1.0 + nrm((N_ODD, D), 0.1),
        'c_r_k': nrm((N_ODD, C_HEADS, C_DH), 0.1),
        'c_ln_w': 1.0 + nrm((N_ODD, D), 0.02),
        'c_ln_b': nrm((N_ODD, D), 0.01),
        'c_w_out': nrm((N_ODD, D, D), D ** -0.5),
        'ffn_norm': 1.0 + nrm((DEPTH, D), 0.02),
        'ffn_router': nrm((DEPTH, D, N_EXPERTS), D ** -0.5),
        'ffn_w_gate': nrm((DEPTH, N_EXPERTS, D, D_EXPERT), D ** -0.5),
        'ffn_w_up': nrm((DEPTH, N_EXPERTS, D, D_EXPERT), D ** -0.5),
        'ffn_w_down': nrm((DEPTH, N_EXPERTS, D_EXPERT, D), D_EXPERT ** -0.5),
        'final_norm': 1.0 + nrm((D,), 0.02),
    }


def reference(x, rel_bias, a_lb_logits, ab_norm, ab_w_in, a_onorm, ab_w_out, c_norm, c_mu, c_mu_w, c_w_rkv, c_w0, c_w1, c_w2, c_a0, c_a1, c_a2, c_g1, c_g2, c_k_k, c_k_a, c_r_k, c_ln_w, c_ln_b, c_w_out, ffn_norm, ffn_router, ffn_w_gate, ffn_w_up, ffn_w_down, final_norm):
    lb_all = jnp.cumsum(jax.nn.softmax(a_lb_logits.astype(jnp.float32), axis=0), axis=0)
    for layer in range(DEPTH):
        if layer % 2 == 0:
            e = layer // 2
            h = rmsnorm(x, ab_norm[e])
            proj = h @ ab_w_in[e]
            ya = hgrn2_mixer(proj[..., :A_COLS], lb_all[layer], a_onorm[e])
            yb = dilated_attention(proj[..., A_COLS:], rel_bias)
            x = x + jnp.concatenate([ya, yb], axis=-1) @ ab_w_out[e]
        else:
            o = layer // 2
            h = rmsnorm(x, c_norm[o])
            x = x + rwkv7_mixer(h, c_mu[o], c_mu_w[o], c_w_rkv[o], c_w0[o], c_w1[o], c_w2[o], c_a0[o], c_a1[o], c_a2[o], c_g1[o], c_g2[o], c_k_k[o], c_k_a[o], c_r_k[o], c_ln_w[o], c_ln_b[o], c_w_out[o])
        x = x + ec_moe(rmsnorm(x, ffn_norm[layer]), ffn_router[layer], ffn_w_gate[layer], ffn_w_up[layer], ffn_w_down[layer])
    return rmsnorm(x, final_norm)
```

```cpp
#include <hip/hip_runtime.h>
#include <cstdio>
#include <cstdint>

#define XB_TMO      128
#define XB_XCNT(j)  (256  + 64 * (j))
#define XB_XSUB(j)  (1280 + 64 * (j))
#define XB_XGEN(j)  (2304 + 64 * (j))
#define XB_TOP      3328
#define XB_TOPGEN   3392
#define XCD_BAR_WORDS 3456
#define XB_SPIN_CAP (1u << 22)
#define LAS __attribute__((address_space(3)))

__device__ __forceinline__ unsigned xb_ld(unsigned* p)              { return __hip_atomic_load(p, __ATOMIC_RELAXED, __HIP_MEMORY_SCOPE_AGENT); }
__device__ __forceinline__ unsigned xb_add(unsigned* p, unsigned v) { return __hip_atomic_fetch_add(p, v, __ATOMIC_RELAXED, __HIP_MEMORY_SCOPE_AGENT); }
__device__ __forceinline__ unsigned xb_xcc_id() { return (unsigned)__builtin_amdgcn_s_getreg((3 << 11) | 20) & 0xFu; }
#define XB_SPIN(cond, bar) do { unsigned _sp = 0; while (cond) { __builtin_amdgcn_s_sleep(1); \
    if ((++_sp & 255u) == 0u) { if (xb_ld(&(bar)[XB_TMO])) break; if (_sp > XB_SPIN_CAP) { atomicAdd(&(bar)[XB_TMO], 1u); break; } } } } while (0)

struct XcdBarrier { unsigned* bar; unsigned x; volatile LAS unsigned* st; };

__device__ __forceinline__ XcdBarrier xcd_barrier_post(unsigned* bar, volatile LAS unsigned* st) {
    XcdBarrier b; b.bar = bar; b.x = xb_xcc_id(); b.st = st;
    if (threadIdx.x == 0) (void)xb_add(&bar[XB_XCNT(b.x)], 1u);
    return b;
}
__device__ __forceinline__ void xcd_barrier_complete(unsigned* bar, unsigned x, unsigned& nloc, unsigned& nx) {
    const unsigned G = gridDim.x * gridDim.y * gridDim.z;
    unsigned sum, cnt, mine, sp = 0u;
    for (;;) {
        sum = 0u; cnt = 0u; mine = 0u;
#pragma unroll
        for (unsigned j = 0; j < 16; ++j) { const unsigned c = xb_ld(&bar[XB_XCNT(j)]); sum += c; cnt += (c > 0u) ? 1u : 0u; mine = (j == x) ? c : mine; }
        if (sum == G) break;
        __builtin_amdgcn_s_sleep(1);
        if ((++sp & 255u) == 0u) { if (xb_ld(&bar[XB_TMO])) break; if (sp > XB_SPIN_CAP) { atomicAdd(&bar[XB_TMO], 1u); break; } }
    }
    nloc = mine > 0u ? mine : 1u; nx = cnt > 0u ? cnt : 1u;
}
__device__ __forceinline__ void xcd_barrier(const XcdBarrier& b) {
    asm volatile("s_waitcnt vmcnt(0)" ::: "memory");
    __syncthreads();
    if (threadIdx.x == 0) {
        unsigned* bar = b.bar;
        __builtin_amdgcn_s_waitcnt(0);
        unsigned nloc = b.st[0], nx = b.st[1];
        if (nloc == 0u) { xcd_barrier_complete(bar, b.x, nloc, nx); b.st[0] = nloc; b.st[1] = nx; }
        const unsigned old = xb_add(&bar[XB_XSUB(b.x)], 1u);
        const unsigned gen = old / nloc;
        if (old + 1u == (gen + 1u) * nloc) {
            __builtin_amdgcn_fence(__ATOMIC_RELEASE, "agent");
            asm volatile("s_waitcnt vmcnt(0)" ::: "memory");
            const unsigned og = xb_add(&bar[XB_TOP], 1u);
            const unsigned tg = og / nx;
            if (og + 1u == (tg + 1u) * nx) xb_add(&bar[XB_TOPGEN], 1u);
            else XB_SPIN(xb_ld(&bar[XB_TOPGEN]) == tg, bar);
            __builtin_amdgcn_fence(__ATOMIC_ACQUIRE, "agent");
            xb_add(&bar[XB_XGEN(b.x)], 1u);
            asm volatile("s_waitcnt vmcnt(0)" ::: "memory");
        } else {
            XB_SPIN(xb_ld(&bar[XB_XGEN(b.x)]) == gen, bar);
            __builtin_amdgcn_fence(__ATOMIC_ACQUIRE, "agent");
            asm volatile("s_waitcnt vmcnt(0)" ::: "memory");
        }
    }
    __syncthreads();
}

typedef unsigned short bf16_t;
typedef short bf16x8 __attribute__((ext_vector_type(8)));
typedef float f32x4 __attribute__((ext_vector_type(4)));
typedef unsigned u32x2 __attribute__((ext_vector_type(2)));
typedef unsigned u32x4 __attribute__((ext_vector_type(4)));
typedef int v8i_t __attribute__((ext_vector_type(8)));

constexpr int S = 16384, D = 1024;
constexpr int NTHR = 512;
constexpr int LDS_BYTES = 147456;
constexpr int NPH = 26;
constexpr bool kSingleLaunch = true;
#ifndef PROBE_LO
#define PROBE_LO -1
#define PROBE_HI -1
#endif

typedef __bf16 bf2_t __attribute__((ext_vector_type(2)));
__device__ __forceinline__ unsigned pk_bf16(float lo, float hi) { bf2_t v = {(__bf16)lo, (__bf16)hi}; return __builtin_bit_cast(unsigned, v); }
__device__ __forceinline__ unsigned pk4_fp8(float a, float b, float c, float d) { int w = __builtin_amdgcn_cvt_pk_fp8_f32(a, b, 0, false); w = __builtin_amdgcn_cvt_pk_fp8_f32(c, d, w, true); return (unsigned)w; }
__device__ __forceinline__ float bf_lo(unsigned u) { return __uint_as_float(u << 16); }
__device__ __forceinline__ float bf_hi(unsigned u) { return __uint_as_float(u & 0xffff0000u); }
__device__ __forceinline__ float bf2f(bf16_t b) { return __uint_as_float(((unsigned)b) << 16); }
__device__ __forceinline__ f32x4 bf4_to_f32(u32x2 v) { f32x4 r = {bf_lo(v[0]), bf_hi(v[0]), bf_lo(v[1]), bf_hi(v[1])}; return r; }
__device__ __forceinline__ float wave_sum(float x) {
#pragma unroll
    for (int o = 32; o >= 1; o >>= 1) x += __shfl_xor(x, o);
    return x;
}
__device__ __forceinline__ float sigmoidf_(float z) { return __builtin_amdgcn_rcpf(1.f + __expf(-z)); }
__device__ __forceinline__ f32x4 mfma16(bf16x8 a, bf16x8 b, f32x4 c) { return __builtin_amdgcn_mfma_f32_16x16x32_bf16(a, b, c, 0, 0, 0); }

constexpr size_t MiB = 1ull << 20;
constexpr size_t WS_WT_IN = 0, WS_WT_OUT = 8 * MiB, WS_WT_RKV = 10 * MiB, WS_WT_COUT = 16 * MiB, WS_WT_L1 = 18 * MiB, WS_WT_L2 = 20 * MiB;
constexpr size_t WS_BT_GU = 22 * MiB, WS_BT_DN = 150 * MiB, WS_SMALL = 214 * MiB;
constexpr size_t WS_BAR = WS_SMALL, WS_LB = WS_SMALL + 16384, WS_BIAS = WS_SMALL + 20480, WS_DTOT = WS_SMALL + 65536;
constexpr size_t WS_AFF = WS_DTOT + MiB, WS_SLOT = WS_AFF + MiB, WS_IDX = WS_SLOT + MiB, WS_GATEW = WS_IDX + 131072, WS_ATTL = WS_GATEW + 131072;
constexpr size_t WS_RSTD = WS_SMALL + 5 * MiB, WS_RSTDE = WS_RSTD + 65536;
constexpr size_t WS_XA = 222 * MiB, WS_XB = 286 * MiB, WS_ACT = 350 * MiB;
constexpr size_t HH = 32 * MiB;
constexpr size_t WS_END = WS_ACT + 21 * HH;
constexpr size_t A_H0 = WS_ACT, A_Q = WS_ACT + HH, A_V = WS_ACT + HH + HH / 2, A_KF = WS_ACT + 2 * HH, A_LOGF = WS_ACT + 3 * HH, A_GATE = WS_ACT + 5 * HH;
constexpr size_t A_AQ = WS_ACT + 6 * HH, A_AK = A_AQ + HH / 2, A_AV = A_AK + HH / 2, A_YAB = A_AV + HH / 2, A_U = A_YAB + HH, A_SC = A_U + 4 * HH, A_ATTO = A_SC + 2 * HH;
constexpr size_t M_HB = WS_ACT, M_XE = WS_ACT + HH, M_HID = WS_ACT + 3 * HH, M_YE = WS_ACT + 9 * HH;
constexpr size_t R_H1 = WS_ACT, R_MIX = WS_ACT + 2 * HH, R_RR = WS_ACT + 9 * HH, R_KK = WS_ACT + 11 * HH, R_VV = WS_ACT + 13 * HH, R_L1O = WS_ACT + 15 * HH;
constexpr size_t R_SREC = WS_ACT + 2 * HH;
constexpr size_t R_REC_A = WS_ACT + 15 * HH;
constexpr size_t R_GREC = WS_ACT + 4 * HH;
constexpr size_t R_KKN = R_H1;
constexpr size_t R_LOGW = R_MIX;
constexpr size_t R_AA = R_MIX + 4 * HH;
constexpr size_t R_G = R_MIX + 6 * HH;
constexpr size_t R_YG = WS_ACT + HH;

struct Params { const float* in[31]; float* out; unsigned char* ws; int lo, hi; };
typedef const __attribute__((address_space(4))) Params* KP;

__device__ __forceinline__ int tid_() { int t = threadIdx.x; asm volatile("" : "+v"(t)); return t; }

constexpr int BM = 256, BK = 64, HALF = 128, HT = HALF * BK;
__device__ __forceinline__ int lds_byte(int r, int c) { int st = (r >> 4) * 2 + (c >> 5), rr = r & 15, cc = c & 31, ob = rr * 64 + cc * 2; return st * 1024 + (ob ^ (((ob >> 9) & 1) << 5)); }
__device__ __forceinline__ void stage_rc(int b, int& R, int& C) { int st = b / 1024, sb = b % 1024, swz = sb ^ (((sb >> 9) & 1) << 5); R = (st >> 1) * 16 + swz / 64; C = (st & 1) * 32 + (swz % 64) / 2; }

__device__ __forceinline__ void tile_order(int L, int nM, int nN, int& pm, int& pn) {
    const int nwg = nM * nN, q = nwg / 8, xcd = L % 8, off = L / 8, wgid = xcd * q + off;
    const int nig = 8 * nN, gid = wgid / nig, w = wgid % nig;
    pm = gid * 8 + (w % 8); pn = w / 8;
}
template <class T> __device__ __forceinline__ T* uni_ptr(T* p) {
    const unsigned long long u = (unsigned long long)p;
    const unsigned lo = __builtin_amdgcn_readfirstlane((unsigned)u), hi = __builtin_amdgcn_readfirstlane((unsigned)(u >> 32));
    return (T*)(((unsigned long long)hi << 32) | lo);
}

struct GemmNext { const bf16_t* A; const bf16_t* Bt; const int* gidx; int brow, bcol, valid; };
template <class Epi, bool GATHER = false, bool F8 = false>
__device__ __forceinline__ void gemm_tile(const bf16_t* __restrict__ A, const bf16_t* __restrict__ Bt, int K, int brow, int bcol, bf16_t* shm, const Epi& epi, const int* __restrict__ gidx = nullptr,
                                          int pre = 0, GemmNext nx = GemmNext{nullptr, nullptr, nullptr, 0, 0, 0}) {
#define SA(b,h) (shm+((b)*2+(h))*HT)
#define SB(b,h) (shm+(4+(b)*2+(h))*HT)
#define STAGE_X(P,BASE,br,kt) do{ const char* _gb = (const char*)((BASE) + (long)(br)*K + (long)(kt)*BK); \
    __builtin_amdgcn_global_load_lds((const unsigned*)(_gb + voff), (unsigned LAS*)((char*)(P) + wvu*1024), 16, 0, 0); \
    __builtin_amdgcn_global_load_lds((const unsigned*)(_gb + (size_t)K*128 + voff), (unsigned LAS*)((char*)(P) + wvu*1024 + 8192), 16, 0, 0);}while(0)
#define STAGE_A(P,br,kt) do { if constexpr (GATHER) { const char* _ga = (const char*)(A + (long)(kt)*BK); \
    __builtin_amdgcn_global_load_lds((const unsigned*)(_ga + (((br) != brow) ? vA2 : vA0)), (unsigned LAS*)((char*)(P) + wvu*1024), 16, 0, 0); \
    __builtin_amdgcn_global_load_lds((const unsigned*)(_ga + (((br) != brow) ? vA3 : vA1)), (unsigned LAS*)((char*)(P) + wvu*1024 + 8192), 16, 0, 0); } \
    else { STAGE_X(P,A,br,kt); } } while(0)
#define STAGE_B(P,br,kt) STAGE_X(P,Bt,br,kt)
typedef int i32x4_t __attribute__((ext_vector_type(4)));
#define LDA(dst,b,h) do { if constexpr (F8) { for(int m=0;m<4;++m) { \
      const i32x4_t _l = *reinterpret_cast<const i32x4_t*>((char*)SA(b,h)+lds_byte(wr*64+m*16+fr,fq*8)), _h = *reinterpret_cast<const i32x4_t*>((char*)SA(b,h)+lds_byte(wr*64+m*16+fr,32+fq*8)); \
      dst##8[m] = __builtin_shufflevector(_l, _h, 0, 1, 2, 3, 4, 5, 6, 7); } } \
    else { for(int m=0;m<4;++m)for(int k=0;k<2;++k) dst[m][k]=*reinterpret_cast<const bf16x8*>((char*)SA(b,h)+lds_byte(wr*64+m*16+fr,k*32+fq*8)); } } while(0)
#define LDB(dst,b,h) do { if constexpr (F8) { for(int n=0;n<2;++n) { \
      const i32x4_t _l = *reinterpret_cast<const i32x4_t*>((char*)SB(b,h)+lds_byte(wc*32+n*16+fr,fq*8)), _h = *reinterpret_cast<const i32x4_t*>((char*)SB(b,h)+lds_byte(wc*32+n*16+fr,32+fq*8)); \
      dst##8[n] = __builtin_shufflevector(_l, _h, 0, 1, 2, 3, 4, 5, 6, 7); } } \
    else { for(int n=0;n<2;++n)for(int k=0;k<2;++k) dst[n][k]=*reinterpret_cast<const bf16x8*>((char*)SB(b,h)+lds_byte(wc*32+n*16+fr,k*32+fq*8)); } } while(0)
#define MMA(ai,bj,At,Bq) do{__builtin_amdgcn_s_setprio(1); \
    if constexpr (F8) { for(int m=0;m<4;++m)for(int n=0;n<2;++n) \
        asm volatile("v_mfma_scale_f32_16x16x128_f8f6f4 %0, %1, %2, %0, %3, %3 op_sel_hi:[0,0,0]" : "+v"(acc[ai][bj][m][n]) : "v"(Bq##8[n]), "v"(At##8[m]), "v"(f8one)); } \
    else { for(int m=0;m<4;++m)for(int n=0;n<2;++n)for(int k=0;k<2;++k) \
      acc[ai][bj][m][n]=__builtin_amdgcn_mfma_f32_16x16x32_bf16(Bq[n][k],At[m][k],acc[ai][bj][m][n],0,0,0); } \
    __builtin_amdgcn_s_setprio(0);}while(0)
#define WAIT_V(n) asm volatile("s_waitcnt vmcnt(" #n ")":::"memory")
#define WAIT_L(n) asm volatile("s_waitcnt lgkmcnt(" #n ")":::"memory")
#define BAR __builtin_amdgcn_s_barrier()
#define SCHED __builtin_amdgcn_sched_barrier(0)
    int tz = tid_();
    int wid = tz >> 6, lane = tz & 63, wr = wid >> 2, wc = wid & 3, fr = lane & 15, fq = lane >> 4;
    const int wvu = __builtin_amdgcn_readfirstlane(tz >> 6);
    unsigned voff, vA0 = 0, vA1 = 0, vA2 = 0, vA3 = 0; { int _r, _c; stage_rc(tz * 16, _r, _c); voff = (unsigned)((_r * K + _c) * 2);
        if constexpr (GATHER) { const int* gi = gidx + brow + _r; vA0 = (unsigned)((gi[0] * K + _c) * 2); vA1 = (unsigned)((gi[64] * K + _c) * 2); vA2 = (unsigned)((gi[128] * K + _c) * 2); vA3 = (unsigned)((gi[192] * K + _c) * 2); } }
    f32x4 acc[2][2][4][2] = {};
    bf16x8 At[4][2], B0[2][2], B1[2][2];
    v8i_t At8[4], B08[2], B18[2];
    const int f8one = 0x7F7F7F7F;
    const int nt = K / BK;
    if (!pre) {
        STAGE_B(SB(0,0),bcol,0); STAGE_A(SA(0,0),brow,0);
        STAGE_B(SB(0,1),bcol+HALF,0); STAGE_A(SA(0,1),brow+HALF,0);
    }
    if (wr == 1) BAR;
    WAIT_V(4); BAR;
    STAGE_B(SB(1,0),bcol,1); STAGE_A(SA(1,0),brow,1); STAGE_B(SB(1,1),bcol+HALF,1);
    WAIT_V(6); BAR;
    for (int t = 0; t < nt - 2; t += 2) {
        LDB(B0,0,0); SCHED; LDA(At,0,0); STAGE_A(SA(1,1),brow+HALF,t+1);
        WAIT_L(8); BAR; WAIT_L(0); MMA(0,0,At,B0); BAR; SCHED;
        LDB(B1,0,1); STAGE_B(SB(0,0),bcol,t+2);
        BAR; WAIT_L(0); MMA(0,1,At,B1); BAR;
        LDA(At,0,1); STAGE_A(SA(0,0),brow,t+2);
        BAR; WAIT_L(0); MMA(1,0,At,B0); BAR; SCHED;
        STAGE_B(SB(0,1),bcol+HALF,t+2);
        WAIT_V(6); BAR; MMA(1,1,At,B1); BAR;
        LDB(B0,1,0); SCHED; LDA(At,1,0); STAGE_A(SA(0,1),brow+HALF,t+2);
        WAIT_L(8); BAR; WAIT_L(0); MMA(0,0,At,B0); BAR; SCHED;
        LDB(B1,1,1); STAGE_B(SB(1,0),bcol,t+3);
        BAR; WAIT_L(0); MMA(0,1,At,B1); BAR;
        LDA(At,1,1); STAGE_A(SA(1,0),brow,t+3);
        BAR; WAIT_L(0); MMA(1,0,At,B0); BAR; SCHED;
        STAGE_B(SB(1,1),bcol+HALF,t+3);
        WAIT_V(6); BAR; MMA(1,1,At,B1); BAR;
    }
    asm volatile("" : "+v"(tz)); wid = tz >> 6; lane = tz & 63; wr = wid >> 2; wc = wid & 3; fr = lane & 15; fq = lane >> 4;
    const int nxv = __builtin_amdgcn_readfirstlane(nx.valid);
    float rv[8] = {0.f, 0.f, 0.f, 0.f, 0.f, 0.f, 0.f, 0.f};
    if constexpr (Epi::kRowVec) { const float* rp_ = epi.rowvec() + brow + wr * 64 + fr;
#pragma unroll
        for (int q_ = 0; q_ < 8; ++q_) rv[q_] = rp_[(q_ >> 2) * 128 + (q_ & 3) * 16]; }
    int n0 = 0, n1 = 0, n2 = 0, n3 = 0;
    if constexpr (GATHER) { if (nxv) { int _r, _c; stage_rc(tz * 16, _r, _c); const int* gi = nx.gidx + nx.brow + _r; n0 = gi[0]; n1 = gi[64]; n2 = gi[128]; n3 = gi[192]; } }
    { LDB(B0,0,0); WAIT_V(0); LDA(At,0,0); STAGE_A(SA(1,1),brow+HALF,nt-1);
      BAR; WAIT_L(0); MMA(0,0,At,B0); BAR;
      LDB(B1,0,1); BAR; WAIT_L(0); MMA(0,1,At,B1); BAR;
      LDA(At,0,1); WAIT_V(4); BAR; WAIT_L(0); MMA(1,0,At,B0); MMA(1,1,At,B1); BAR; }
    { LDB(B0,1,0); LDA(At,1,0);
      WAIT_V(2);
      BAR;
      if (nxv) {
          const int wvu2 = __builtin_amdgcn_readfirstlane(tz >> 6);
          unsigned vo2; int _c2; { int _r, _c; stage_rc(tz * 16, _r, _c); vo2 = (unsigned)((_r * K + _c) * 2); _c2 = _c; }
          const char* gb0 = (const char*)(nx.Bt + (long)nx.bcol * K); const char* gb1 = (const char*)(nx.Bt + (long)(nx.bcol + HALF) * K);
          __builtin_amdgcn_global_load_lds((const unsigned*)(gb0 + vo2), (unsigned LAS*)((char*)SB(0,0) + wvu2*1024), 16, 0, 0);
          __builtin_amdgcn_global_load_lds((const unsigned*)(gb0 + (size_t)K*128 + vo2), (unsigned LAS*)((char*)SB(0,0) + wvu2*1024 + 8192), 16, 0, 0);
          if constexpr (GATHER) {
              const char* ga = (const char*)nx.A;
              __builtin_amdgcn_global_load_lds((const unsigned*)(ga + (unsigned)((n0 * K + _c2) * 2)), (unsigned LAS*)((char*)SA(0,0) + wvu2*1024), 16, 0, 0);
              __builtin_amdgcn_global_load_lds((const unsigned*)(ga + (unsigned)((n1 * K + _c2) * 2)), (unsigned LAS*)((char*)SA(0,0) + wvu2*1024 + 8192), 16, 0, 0);
          } else {
              const char* ga0 = (const char*)(nx.A + (long)nx.brow * K);
              __builtin_amdgcn_global_load_lds((const unsigned*)(ga0 + vo2), (unsigned LAS*)((char*)SA(0,0) + wvu2*1024), 16, 0, 0);
              __builtin_amdgcn_global_load_lds((const unsigned*)(ga0 + (size_t)K*128 + vo2), (unsigned LAS*)((char*)SA(0,0) + wvu2*1024 + 8192), 16, 0, 0);
          }
          __builtin_amdgcn_global_load_lds((const unsigned*)(gb1 + vo2), (unsigned LAS*)((char*)SB(0,1) + wvu2*1024), 16, 0, 0);
          __builtin_amdgcn_global_load_lds((const unsigned*)(gb1 + (size_t)K*128 + vo2), (unsigned LAS*)((char*)SB(0,1) + wvu2*1024 + 8192), 16, 0, 0);
          if constexpr (GATHER) {
              const char* ga = (const char*)nx.A;
              __builtin_amdgcn_global_load_lds((const unsigned*)(ga + (unsigned)((n2 * K + _c2) * 2)), (unsigned LAS*)((char*)SA(0,1) + wvu2*1024), 16, 0, 0);
              __builtin_amdgcn_global_load_lds((const unsigned*)(ga + (unsigned)((n3 * K + _c2) * 2)), (unsigned LAS*)((char*)SA(0,1) + wvu2*1024 + 8192), 16, 0, 0);
          } else {
              const char* ga1 = (const char*)(nx.A + (long)(nx.brow + HALF) * K);
              __builtin_amdgcn_global_load_lds((const unsigned*)(ga1 + vo2), (unsigned LAS*)((char*)SA(0,1) + wvu2*1024), 16, 0, 0);
              __builtin_amdgcn_global_load_lds((const unsigned*)(ga1 + (size_t)K*128 + vo2), (unsigned LAS*)((char*)SA(0,1) + wvu2*1024 + 8192), 16, 0, 0);
          }
      }
      WAIT_L(0); MMA(0,0,At,B0); BAR;
      LDB(B1,1,1);
      if (nxv) WAIT_V(8); else WAIT_V(0);
      BAR; WAIT_L(0); MMA(0,1,At,B1); BAR;
      LDA(At,1,1); BAR; WAIT_L(0); MMA(1,0,At,B0); MMA(1,1,At,B1); BAR; }
    if (wr == 0) BAR;
    if constexpr (F8) asm volatile("s_nop 15\n\ts_nop 15" ::: "memory");
    if constexpr (Epi::kRowVec) epi(acc, brow + wr * 64 + fr, bcol + wc * 32 + 8 * fq, rv); else epi(acc, brow + wr * 64 + fr, bcol + wc * 32 + 8 * fq);
    __syncthreads();
#undef SA
#undef SB
#undef STAGE_X
#undef STAGE_A
#undef STAGE_B
#undef LDA
#undef LDB
#undef MMA
#undef WAIT_V
#undef WAIT_L
#undef BAR
#undef SCHED
}
#define EPI_FOR3 _Pragma("unroll") for (int ai = 0; ai < 2; ++ai) _Pragma("unroll") for (int m = 0; m < 4; ++m) _Pragma("unroll") for (int bj = 0; bj < 2; ++bj)
typedef f32x4 AccT[2][2][4][2];
__device__ __forceinline__ u32x4 pk8(f32x4 a, f32x4 b) { u32x4 o = {pk_bf16(a[0], a[1]), pk_bf16(a[2], a[3]), pk_bf16(b[0], b[1]), pk_bf16(b[2], b[3])}; return o; }

struct EpiProj {
    static constexpr bool kRowVec = false;
    bf16_t *Q, *V, *KF, *AQ, *AK, *AV; float *LOGF; bf16_t *GATE; const float* LB;
    __device__ __forceinline__ void operator()(const AccT& acc, int row0, int col0) const {
        const int seg = col0 >> 9; const int cb = col0 & 511;
        EPI_FOR3 {
            const int r = row0 + ai * 128 + m * 16, c = cb + bj * 128;
            const f32x4 v0 = acc[ai][bj][m][0], v1 = acc[ai][bj][m][1];
            if (seg == 1 || seg == 2) {
                const int dir = seg - 1;
                const f32x4 lb0 = *(const f32x4*)(LB + dir * 512 + c), lb1 = *(const f32x4*)(LB + dir * 512 + c + 4);
                f32x4 lf0, lf1, k0, k1;
#pragma unroll
                for (int i = 0; i < 4; ++i) {
                    { const float sg = sigmoidf_(v0[i]), sgn = __builtin_amdgcn_rcpf(1.f + __expf(v0[i])); lf0[i] = __logf(lb0[i] + (1.f - lb0[i]) * sg); k0[i] = (1.f - lb0[i]) * sgn; }
                    { const float sg = sigmoidf_(v1[i]), sgn = __builtin_amdgcn_rcpf(1.f + __expf(v1[i])); lf1[i] = __logf(lb1[i] + (1.f - lb1[i]) * sg); k1[i] = (1.f - lb1[i]) * sgn; }
                }
                float* lp = LOGF + ((size_t)dir * S + r) * 512 + c; *(f32x4*)lp = lf0; *(f32x4*)(lp + 4) = lf1;
                *(u32x4*)(KF + ((size_t)dir * S + r) * 512 + c) = pk8(k0, k1);
            } else if (seg == 4) {
                f32x4 g0, g1;
#pragma unroll
                for (int i = 0; i < 4; ++i) { g0[i] = v0[i] * sigmoidf_(v0[i]); g1[i] = v1[i] * sigmoidf_(v1[i]); }
                *(u32x4*)(GATE + (size_t)r * 512 + c) = pk8(g0, g1);
            } else {
                bf16_t* dst = seg == 0 ? Q : seg == 3 ? V : seg == 5 ? AQ : seg == 6 ? AK : AV;
                const float sc = seg == 5 ? 0.125f : 1.f;
                *(u32x4*)(dst + (size_t)r * 512 + c) = pk8(v0 * sc, v1 * sc);
            }
        }
    }
};
struct EpiResid {
    const float* res; float* out; bf16_t* xh;
    static constexpr bool kRowVec = false;
    __device__ __forceinline__ void operator()(const AccT& acc, int row0, int col0) const {
        EPI_FOR3 { const int r = row0 + ai * 128 + m * 16, c = col0 + bj * 128;
            const float* rp = res + (size_t)r * 1024 + c; float* op = out + (size_t)r * 1024 + c;
            const f32x4 x0 = *(const f32x4*)rp + acc[ai][bj][m][0], x1 = *(const f32x4*)(rp + 4) + acc[ai][bj][m][1];
            *(f32x4*)op = x0; *(f32x4*)(op + 4) = x1;
            { u32x2 o8; o8[0] = pk4_fp8(x0[0], x0[1], x0[2], x0[3]); o8[1] = pk4_fp8(x1[0], x1[1], x1[2], x1[3]); *(u32x2*)((unsigned char*)xh + (size_t)r * 1024 + c) = o8; } }
    }
};
struct EpiSwiglu {
    bf16_t* hid;
    const float* rse;
    static constexpr bool kRowVec = true;
    __device__ __forceinline__ const float* rowvec() const { return rse; }
    __device__ __forceinline__ void operator()(const AccT& acc, int row0, int col0, const float (&rv)[8]) const {
        const int fb = (col0 >> 8) * 128 + (col0 & 255);
#pragma unroll
        for (int ai = 0; ai < 2; ++ai)
#pragma unroll
            for (int m = 0; m < 4; ++m) {
                const int r = row0 + ai * 128 + m * 16; const float rs = rv[ai * 4 + m] * (1.f / 32.f);
                f32x4 h0, h1;
#pragma unroll
                for (int i = 0; i < 4; ++i) { const float g0 = rs * acc[ai][0][m][0][i], g1 = rs * acc[ai][0][m][1][i];
                    h0[i] = g0 * sigmoidf_(g0) * (rs * acc[ai][1][m][0][i]); h1[i] = g1 * sigmoidf_(g1) * (rs * acc[ai][1][m][1][i]); }
                { u32x2 o8; o8[0] = pk4_fp8(h0[0], h0[1], h0[2], h0[3]); o8[1] = pk4_fp8(h1[0], h1[1], h1[2], h1[3]); *(u32x2*)((unsigned char*)hid + (size_t)r * 2048 + fb) = o8; }
            }
    }
};
struct EpiDown {
    bf16_t* ye; const float* gw;
    static constexpr bool kRowVec = true;
    __device__ __forceinline__ const float* rowvec() const { return gw; }
    __device__ __forceinline__ void operator()(const AccT& acc, int row0, int col0, const float (&rv)[8]) const {
        EPI_FOR3 { const int r = row0 + ai * 128 + m * 16, c = col0 + bj * 128;
            const float g = rv[ai * 4 + m] * (1.f / 64.f);
            *(u32x4*)(ye + (size_t)r * 1024 + c) = pk8(acc[ai][bj][m][0] * g, acc[ai][bj][m][1] * g); }
    }
};
struct EpiRkvLora {
    int isl; bf16_t* outb; bf16_t* out; float al, be, ga, de;
    static constexpr bool kRowVec = false;
    __device__ __forceinline__ void operator()(const AccT& acc, int row0, int col0) const {
        if (isl) {
#pragma unroll
            for (int ai = 0; ai < 2; ++ai)
#pragma unroll
                for (int m = 0; m < 4; ++m) { const int r = row0 + ai * 128 + m * 16, c = col0;
                    const f32x4 v0 = acc[ai][0][m][0], v1 = acc[ai][0][m][1]; f32x4 h0, h1;
#pragma unroll
                    for (int i = 0; i < 4; ++i) { h0[i] = al * sigmoidf_(be * v0[i]) + ga + de * v0[i]; h1[i] = al * sigmoidf_(be * v1[i]) + ga + de * v1[i]; }
                    *(u32x4*)(out + (size_t)r * 128 + c) = pk8(h0, h1); }
        } else {
            EPI_FOR3 { const int r = row0 + ai * 128 + m * 16, c = col0 + bj * 128;
                *(u32x4*)(outb + (size_t)r * 1024 + c) = pk8(acc[ai][bj][m][0], acc[ai][bj][m][1]); }
        }
    }
};
struct EpiLora2 {
    int isg; float scale; const float* bias; bf16_t* outb;
    static constexpr bool kRowVec = false;
    __device__ __forceinline__ void operator()(const AccT& acc, int row0, int col0) const {
        if (isg) {
            EPI_FOR3 { const int r = row0 + ai * 128 + m * 16, c = col0 + bj * 128;
                *(u32x4*)(outb + (size_t)r * 1024 + c) = pk8(acc[ai][bj][m][0], acc[ai][bj][m][1]); }
        } else {
            EPI_FOR3 { const int r = row0 + ai * 128 + m * 16, c = col0 + bj * 128;
                const f32x4 b0 = *(const f32x4*)(bias + c), b1 = *(const f32x4*)(bias + c + 4); f32x4 o0, o1;
#pragma unroll
                for (int i = 0; i < 4; ++i) { o0[i] = scale * sigmoidf_(b0[i] + acc[ai][bj][m][0][i]); o1[i] = scale * sigmoidf_(b1[i] + acc[ai][bj][m][1][i]); }
                *(u32x4*)(outb + (size_t)r * 1024 + c) = pk8(o0, o1); }
        }
    }
};

__device__ __forceinline__ void cvt_tile(const float* __restrict__ src, int ldsrc, int k0, int n0, bf16_t* __restrict__ dst, int lddst, int drow0, float* tile, const float* __restrict__ kscale = nullptr, float f8scale = 0.f) {
    const int tid = tid_();
#pragma unroll
    for (int i = 0; i < 2; ++i) {
        const int idx = tid + i * 512, kk = idx >> 4, n4 = (idx & 15) * 4;
        const float4 v = *(const float4*)(src + (size_t)(k0 + kk) * ldsrc + n0 + n4);
        float* t = tile + kk * 65 + n4; t[0] = v.x; t[1] = v.y; t[2] = v.z; t[3] = v.w;
    }
    __syncthreads();
    const int n = tid >> 3, kq = (tid & 7) * 8;
    float f[8];
#pragma unroll
    for (int j = 0; j < 8; ++j) f[j] = tile[(kq + j) * 65 + n];
    if (kscale) {
#pragma unroll
        for (int j = 0; j < 8; ++j) f[j] *= kscale[k0 + kq + j];
    }
    const size_t drow = (size_t)(drow0 + (n & 32) + 16 * ((n >> 2) & 1) + 4 * ((n & 31) >> 3) + (n & 3));
    if (f8scale != 0.f) {
        u32x2 o8; o8[0] = pk4_fp8(f[0] * f8scale, f[1] * f8scale, f[2] * f8scale, f[3] * f8scale); o8[1] = pk4_fp8(f[4] * f8scale, f[5] * f8scale, f[6] * f8scale, f[7] * f8scale);
        *(u32x2*)((unsigned char*)dst + drow * lddst + k0 + kq) = o8;
    } else {
        u32x4 o; o[0] = pk_bf16(f[0], f[1]); o[1] = pk_bf16(f[2], f[3]); o[2] = pk_bf16(f[4], f[5]); o[3] = pk_bf16(f[6], f[7]);
        *(u32x4*)(dst + drow * lddst + k0 + kq) = o;
    }
    __syncthreads();
}
__device__ __forceinline__ void cvt_job(const float* src, int K, int N, bf16_t* dst, int lddst, int mode, int& rot, int bid, int G, float* tile, const float* kscale = nullptr, float f8scale = 0.f) {
    const int nkt = K / 64, nnt = N / 64, nt = nkt * nnt;
    int start = (bid - rot) % G; if (start < 0) start += G;
    for (int t = start; t < nt; t += G) {
        const int kt = t % nkt, ntile = t / nkt, n0 = ntile * 64;
        int drow0 = n0;
        if (mode == 1) drow0 = (n0 >> 7) * 256 + (n0 & 127); else if (mode == 2) drow0 = (n0 >> 7) * 256 + 128 + (n0 & 127);
        cvt_tile(src, N, kt * 64, n0, dst, lddst, drow0, tile, kscale, f8scale);
    }
    rot = (rot + nt) % G;
}
__device__ __forceinline__ void cvt_moe_layer(KP p, int layer, int e_lo, int e_hi, int& rot, int bid, int G, float* tile) {
    bf16_t* gu = (bf16_t*)(p->ws + WS_BT_GU); bf16_t* dn = (bf16_t*)(p->ws + WS_BT_DN);
    for (int e = e_lo; e < e_hi; ++e) {
        const size_t wo = ((size_t)layer * 16 + e) * 1024 * 2048;
        cvt_job(p->in[27] + wo, 1024, 2048, (bf16_t*)((unsigned char*)gu + (size_t)e * 4096 * 1024), 1024, 1, rot, bid, G, tile, p->in[25] + (size_t)layer * 1024, 32.f);
        cvt_job(p->in[28] + wo, 1024, 2048, (bf16_t*)((unsigned char*)gu + (size_t)e * 4096 * 1024), 1024, 2, rot, bid, G, tile, p->in[25] + (size_t)layer * 1024, 32.f);
        cvt_job(p->in[29] + wo, 2048, 1024, (bf16_t*)((unsigned char*)dn + (size_t)e * 1024 * 2048), 2048, 0, rot, bid, G, tile, nullptr, 64.f);
    }
}
struct CvGroup { const float* src; int lds, e, mat, kt, ng; };
__device__ __forceinline__ CvGroup cv_decode(KP p, int layer, int e_lo, int g) {
    CvGroup d; d.e = e_lo + g / 384; const int r = g % 384; d.mat = r >> 7; const int t = r & 127;
    const size_t wo = ((size_t)layer * 16 + d.e) * 1024 * 2048;
    d.kt = d.mat < 2 ? (t & 15) : (t & 31); d.ng = d.mat < 2 ? (t >> 4) : (t >> 5); d.lds = d.mat < 2 ? 2048 : 1024;
    d.src = (d.mat == 0 ? p->in[27] : d.mat == 1 ? p->in[28] : p->in[29]) + wo + (size_t)(d.kt * 64) * d.lds + d.ng * 256;
    return d;
}
__device__ __forceinline__ void cv_request(KP p, int layer, int e_lo, int g, f32x4 (&pf)[8]) {
    const CvGroup d = cv_decode(p, layer, e_lo, g); const int td = tid_();
#pragma unroll
    for (int c = 0; c < 4; ++c)
#pragma unroll
        for (int i = 0; i < 2; ++i) { const int idx = td + i * 512, kk = idx >> 4, n4 = (idx & 15) * 4; pf[c * 2 + i] = *(const f32x4*)(d.src + (size_t)kk * d.lds + 64 * c + n4); }
}
__device__ __forceinline__ void cv_to_lds(const f32x4 (&pf)[8], float* tile) {
    const int td = tid_();
#pragma unroll
    for (int c = 0; c < 4; ++c)
#pragma unroll
        for (int i = 0; i < 2; ++i) { const int idx = td + i * 512, kk = idx >> 4, n4 = (idx & 15) * 4; const f32x4 v = pf[c * 2 + i];
            float* t = tile + c * 4160 + kk * 65 + n4; t[0] = v[0]; t[1] = v[1]; t[2] = v[2]; t[3] = v[3]; }
}
__device__ __forceinline__ void cv_store(KP p, int layer, int e_lo, int g, const float* tile) {
    const CvGroup d = cv_decode(p, layer, e_lo, g); const int td = tid_();
    const int n = td >> 3, kq = (td & 7) * 8, k0 = d.kt * 64;
    const float f8scale = d.mat < 2 ? 32.f : 64.f;
    const float* gainp = p->in[25] + (size_t)layer * 1024;
    unsigned char* dst = d.mat < 2 ? p->ws + WS_BT_GU + (size_t)d.e * 4096 * 1024 : p->ws + WS_BT_DN + (size_t)d.e * 1024 * 2048;
    const int lddst = d.mat < 2 ? 1024 : 2048;
    float ks[8];
#pragma unroll
    for (int j = 0; j < 8; ++j) ks[j] = d.mat < 2 ? gainp[k0 + kq + j] * f8scale : f8scale;
#pragma unroll
    for (int c = 0; c < 4; ++c) {
        const int n0 = d.ng * 256 + 64 * c;
        const int drow0 = d.mat == 0 ? (n0 >> 7) * 256 + (n0 & 127) : d.mat == 1 ? (n0 >> 7) * 256 + 128 + (n0 & 127) : n0;
        float f[8];
#pragma unroll
        for (int j = 0; j < 8; ++j) f[j] = tile[c * 4160 + (kq + j) * 65 + n] * ks[j];
        const size_t drow = (size_t)(drow0 + (n & 32) + 16 * ((n >> 2) & 1) + 4 * ((n & 31) >> 3) + (n & 3));
        u32x2 o8; o8[0] = pk4_fp8(f[0], f[1], f[2], f[3]); o8[1] = pk4_fp8(f[4], f[5], f[6], f[7]);
        *(u32x2*)(dst + drow * lddst + k0 + kq) = o8;
    }
}
struct CvTile { const float* src; int lds, e, mat, kt, nt; };
__device__ __forceinline__ CvTile cv1_decode(KP p, int layer, int e_lo, int t) {
    CvTile d; d.e = e_lo + t / 1536; const int r = t % 1536; d.mat = r >> 9; const int q = r & 511;
    const size_t wo = ((size_t)layer * 16 + d.e) * 1024 * 2048;
    d.kt = d.mat < 2 ? (q & 15) : (q & 31); d.nt = d.mat < 2 ? (q >> 4) : (q >> 5); d.lds = d.mat < 2 ? 2048 : 1024;
    d.src = (d.mat == 0 ? p->in[27] : d.mat == 1 ? p->in[28] : p->in[29]) + wo + (size_t)(d.kt * 64) * d.lds + d.nt * 64;
    return d;
}
__device__ __forceinline__ void cv1_request(KP p, int layer, int e_lo, int t, f32x4 (&pf)[2]) {
    const CvTile d = cv1_decode(p, layer, e_lo, t); const int td = tid_();
#pragma unroll
    for (int i = 0; i < 2; ++i) { const int idx = td + i * 512, kk = idx >> 4, n4 = (idx & 15) * 4; pf[i] = *(const f32x4*)(d.src + (size_t)kk * d.lds + n4); }
}
__device__ __forceinline__ void cv1_to_lds(const f32x4 (&pf)[2], float* tile) {
    const int td = tid_();
#pragma unroll
    for (int i = 0; i < 2; ++i) { const int idx = td + i * 512, kk = idx >> 4, n4 = (idx & 15) * 4; const f32x4 v = pf[i];
        float* t = tile + kk * 65 + n4; t[0] = v[0]; t[1] = v[1]; t[2] = v[2]; t[3] = v[3]; }
}
__device__ __forceinline__ void cv1_store(KP p, int layer, int e_lo, int t, const float* tile) {
    const CvTile d = cv1_decode(p, layer, e_lo, t); const int td = tid_();
    const int n = td >> 3, kq = (td & 7) * 8, k0 = d.kt * 64;
    const float f8scale = d.mat < 2 ? 32.f : 64.f;
    const float* gainp = p->in[25] + (size_t)layer * 1024;
    unsigned char* dst = d.mat < 2 ? p->ws + WS_BT_GU + (size_t)d.e * 4096 * 1024 : p->ws + WS_BT_DN + (size_t)d.e * 1024 * 2048;
    const int lddst = d.mat < 2 ? 1024 : 2048;
    const int n0 = d.nt * 64;
    const int drow0 = d.mat == 0 ? (n0 >> 7) * 256 + (n0 & 127) : d.mat == 1 ? (n0 >> 7) * 256 + 128 + (n0 & 127) : n0;
    float f[8];
#pragma unroll
    for (int j = 0; j < 8; ++j) f[j] = tile[(kq + j) * 65 + n] * (d.mat < 2 ? gainp[k0 + kq + j] * f8scale : f8scale);
    const size_t drow = (size_t)(drow0 + (n & 32) + 16 * ((n >> 2) & 1) + 4 * ((n & 31) >> 3) + (n & 3));
    u32x2 o8; o8[0] = pk4_fp8(f[0], f[1], f[2], f[3]); o8[1] = pk4_fp8(f[4], f[5], f[6], f[7]);
    *(u32x2*)(dst + drow * lddst + k0 + kq) = o8;
}
__device__ __forceinline__ void rms_rows_bf16(const float* __restrict__ x, const float* __restrict__ gain, bf16_t* __restrict__ out, int bid, int G) {
    const int lane = tid_() & 63, wv = tid_() >> 6;
    for (int r = bid * 8 + wv; r < S; r += G * 8) {
        float4 v[4]; float ss = 0.f;
#pragma unroll
        for (int i = 0; i < 4; ++i) { v[i] = *(const float4*)(x + (size_t)r * 1024 + (i * 64 + lane) * 4); ss += v[i].x * v[i].x + v[i].y * v[i].y + v[i].z * v[i].z + v[i].w * v[i].w; }
        ss = wave_sum(ss);
        const float rs = rsqrtf(ss * (1.f / 1024.f) + 1e-6f);
#pragma unroll
        for (int i = 0; i < 4; ++i) { const float4 g = *(const float4*)(gain + (i * 64 + lane) * 4);
            u32x2 o; o[0] = pk_bf16(v[i].x * rs * g.x, v[i].y * rs * g.y); o[1] = pk_bf16(v[i].z * rs * g.z, v[i].w * rs * g.w);
            *(u32x2*)(out + (size_t)r * 1024 + (i * 64 + lane) * 4) = o; }
    }
}
__device__ __forceinline__ int t5_bucket(int rel) {
    const int n = rel < 0 ? -rel : rel;
    int b;
    if (n < 8) b = n; else b = n >= 559 ? 15 : n >= 305 ? 14 : n >= 166 ? 13 : n >= 91 ? 12 : n >= 50 ? 11 : n >= 27 ? 10 : n >= 15 ? 9 : 8;
    return (rel > 0 ? 16 : 0) + b;
}
__device__ __forceinline__ void phase_prologue(KP p, char* smem) {
    const int bid = blockIdx.x, G = gridDim.x, tid = tid_();
    float* tile = (float*)smem;
    rms_rows_bf16(p->in[0], p->in[3], (bf16_t*)(p->ws + A_H0), bid, G);
    if (bid == 0) {
        float* LB = (float*)(p->ws + WS_LB);
        for (int i = tid; i < 1024; i += NTHR) { const float a = p->in[2][i], b = p->in[2][1024 + i], c = p->in[2][2048 + i]; const float mx = fmaxf(a, fmaxf(b, c));
            const float ea = __expf(a - mx), eb = __expf(b - mx), ec = __expf(c - mx); LB[i] = ea / (ea + eb + ec); }
    }
    if (bid == 1 % G) {
        float* BI = (float*)(p->ws + WS_BIAS);
        for (int i = tid; i < 3 * 8 * 129; i += NTHR) { const int g = i / (8 * 129), h = (i / 129) % 8, ri = i % 129; const int dil = g == 0 ? 1 : g == 1 ? 4 : 16;
            BI[(g * 8 + h) * 132 + ri] = p->in[1][t5_bucket((ri - 64) * dil) * 8 + h]; }
    }
    {
        bf16_t* l1 = (bf16_t*)(p->ws + WS_WT_L1); bf16_t* l2 = (bf16_t*)(p->ws + WS_WT_L2);
        const u32x4 z = {0u, 0u, 0u, 0u};
        for (int j = 0; j < 4; ++j) {
            const int nv = j == 3 ? 128 : 64;
            const int n16 = (256 - nv) * 1024 / 8;
            for (int i = bid * NTHR + tid; i < n16; i += G * NTHR) *(u32x4*)(l1 + (size_t)j * 256 * 1024 + (size_t)nv * 1024 + (size_t)i * 8) = z;
            const int cpr = (128 - nv) / 8;
            for (int i = bid * NTHR + tid; i < 1024 * cpr; i += G * NTHR) { const int r = i / cpr, c = nv + (i % cpr) * 8; *(u32x4*)(l2 + (size_t)j * 1024 * 128 + (size_t)r * 128 + c) = z; }
        }
    }
    int rot = 0;
    cvt_job(p->in[4], 1024, 4096, (bf16_t*)(p->ws + WS_WT_IN), 1024, 0, rot, bid, G, tile);
    cvt_job(p->in[6], 1024, 1024, (bf16_t*)(p->ws + WS_WT_OUT), 1024, 0, rot, bid, G, tile);
    for (int i = 0; i < 3; ++i) cvt_job(p->in[10] + (size_t)i * 1024 * 1024, 1024, 1024, (bf16_t*)(p->ws + WS_WT_RKV) + (size_t)i * 1024 * 1024, 1024, 0, rot, bid, G, tile);
    cvt_job(p->in[24], 1024, 1024, (bf16_t*)(p->ws + WS_WT_COUT), 1024, 0, rot, bid, G, tile);
    {
        bf16_t* l1 = (bf16_t*)(p->ws + WS_WT_L1); bf16_t* l2 = (bf16_t*)(p->ws + WS_WT_L2);
        cvt_job(p->in[12], 1024, 64, l1, 1024, 0, rot, bid, G, tile);
        cvt_job(p->in[12] + 1024 * 64, 1024, 64, l1 + 256 * 1024, 1024, 0, rot, bid, G, tile);
        cvt_job(p->in[15], 1024, 64, l1 + 2 * 256 * 1024, 1024, 0, rot, bid, G, tile);
        cvt_job(p->in[17], 1024, 128, l1 + 3 * 256 * 1024, 1024, 0, rot, bid, G, tile);
        cvt_job(p->in[13], 64, 1024, l2, 128, 0, rot, bid, G, tile);
        cvt_job(p->in[13] + 64 * 1024, 64, 1024, l2 + 1024 * 128, 128, 0, rot, bid, G, tile);
        cvt_job(p->in[16], 64, 1024, l2 + 2 * 1024 * 128, 128, 0, rot, bid, G, tile);
        cvt_job(p->in[18], 128, 1024, l2 + 3 * 1024 * 128, 128, 0, rot, bid, G, tile);
    }
    cvt_moe_layer(p, 0, 0, 4, rot, bid, G, tile);
}

constexpr int H_CUM = 0, H_TOT = 65536, H_KT = 66560, H_VT = 101376, H_END = 118784;
__device__ __forceinline__ void hgrn_load_cum(KP p, int c, int h, char* smem) {
    float* CUM = (float*)(smem + H_CUM); float* TOT = (float*)(smem + H_TOT);
    const float* LOGF = (const float*)(p->ws + A_LOGF);
    const int tid = tid_(), t0 = c * 64;
    for (int i = tid; i < 2 * 64 * 32; i += NTHR) {
        const int dir = i >> 11, s = (i >> 5) & 63, k4 = (i & 31) * 4;
        *(float4*)(CUM + (dir * 64 + s) * 128 + k4) = *(const float4*)(LOGF + ((size_t)dir * S + t0 + s) * 512 + h * 128 + k4);
    }
    __syncthreads();
    if (tid < 256) {
        const int dir = tid >> 7, k = tid & 127; float* col = CUM + dir * 64 * 128 + k; float v[64];
#pragma unroll
        for (int s = 0; s < 64; ++s) v[s] = col[s * 128];
        float run = 0.f;
#pragma unroll
        for (int s = 0; s < 64; ++s) { const float x = v[s]; if (dir == 0) { run += x; v[s] = run; } else { v[s] = run; run += x; } }
#pragma unroll
        for (int s = 0; s < 64; ++s) col[s * 128] = v[s];
        TOT[dir * 128 + k] = run;
    }
    __syncthreads();
}
__device__ __forceinline__ void hgrn_load_vt(KP p, int c, int h, char* smem) {
    const bf16_t* V = (const bf16_t*)(p->ws + A_V); unsigned* VT = (unsigned*)(smem + H_VT);
    const int tid = tid_(), t0 = c * 64;
    for (int i = tid; i < 32 * 128; i += NTHR) { const int sp = i >> 7, v = i & 127;
        const unsigned a = V[(size_t)(t0 + 2 * sp) * 512 + h * 128 + v], b = V[(size_t)(t0 + 2 * sp + 1) * 512 + h * 128 + v];
        VT[v * 34 + sp] = a | (b << 16); }
}
__device__ __forceinline__ void phase_hgrn_local(KP p, char* smem) {
    const int bid = blockIdx.x, G = gridDim.x, tid = tid_(), lane = tid & 63, wv = tid >> 6, fr = lane & 15, fq = lane >> 4;
    float* CUM = (float*)(smem + H_CUM); float* TOT = (float*)(smem + H_TOT); unsigned* KT = (unsigned*)(smem + H_KT); unsigned* VT = (unsigned*)(smem + H_VT);
    const bf16_t* KF = (const bf16_t*)(p->ws + A_KF); const bf16_t* V = (const bf16_t*)(p->ws + A_V); const float* LOGF = (const float*)(p->ws + A_LOGF);
    bf16_t* U = (bf16_t*)(p->ws + A_U); float* DTOT = (float*)(p->ws + WS_DTOT);
    f32x4 lf[8]; unsigned va[4], vb[4], ka[8], kb[8];
    const int kp = tid & 63, spb = tid >> 6;
#define HL_LOAD_LF(uu) do { const int c_ = (uu) >> 2, h_ = (uu) & 3; _Pragma("unroll") for (int q = 0; q < 8; ++q) { const int dir = q >> 2, s_ = ((tid >> 5) + q * 16) & 63; \
        lf[q] = *(const f32x4*)(LOGF + ((size_t)dir * S + c_ * 64 + s_) * 512 + h_ * 128 + (tid & 31) * 4); } } while (0)
#define HL_LOAD_KV(uu) do { const int c_ = (uu) >> 2, h_ = (uu) & 3; \
        _Pragma("unroll") for (int q = 0; q < 4; ++q) { const bf16_t* vp_ = V + (size_t)(c_ * 64 + 2 * (spb + q * 8)) * 512 + h_ * 128 + 2 * kp; va[q] = *(const unsigned*)vp_; vb[q] = *(const unsigned*)(vp_ + 512); } \
        _Pragma("unroll") for (int q = 0; q < 8; ++q) { const bf16_t* kp_ = KF + ((size_t)(q >> 2) * S + c_ * 64 + 2 * (spb + (q & 3) * 8)) * 512 + h_ * 128 + 2 * kp; ka[q] = *(const unsigned*)kp_; kb[q] = *(const unsigned*)(kp_ + 512); } } while (0)
    if (bid < 1024) { HL_LOAD_LF(bid); HL_LOAD_KV(bid); }
    for (int u = bid; u < 1024; u += G) {
        const int c = u >> 2, h = u & 3;
#pragma unroll
        for (int q = 0; q < 8; ++q) { const int dir = q >> 2, s_ = ((tid >> 5) + q * 16) & 63; *(f32x4*)(CUM + (dir * 64 + s_) * 128 + (tid & 31) * 4) = lf[q]; }
        if (u + G < 1024) HL_LOAD_LF(u + G);
        __syncthreads();
        if (tid < 256) {
            const int dir = tid >> 7, k = tid & 127; float* col = CUM + dir * 64 * 128 + k; float v[64];
#pragma unroll
            for (int s2 = 0; s2 < 64; ++s2) v[s2] = col[s2 * 128];
            float run = 0.f;
#pragma unroll
            for (int s2 = 0; s2 < 64; ++s2) { const float x = v[s2]; if (dir == 0) { run += x; v[s2] = run; } else { v[s2] = run; run += x; } }
#pragma unroll
            for (int s2 = 0; s2 < 64; ++s2) col[s2 * 128] = v[s2];
            TOT[dir * 128 + k] = run;
            DTOT[((size_t)dir * 256 + c) * 512 + h * 128 + k] = __expf(run);
        }
        __syncthreads();
#pragma unroll
        for (int q = 0; q < 4; ++q) { const int sp = spb + q * 8;
            VT[(2 * kp) * 34 + sp] = (va[q] & 0xffffu) | (vb[q] << 16); VT[(2 * kp + 1) * 34 + sp] = (va[q] >> 16) | (vb[q] & 0xffff0000u); }
#pragma unroll
        for (int q = 0; q < 8; ++q) { const int dir = q >> 2, sp = spb + (q & 3) * 8, s0 = 2 * sp;
            const float2 c0 = *(const float2*)(CUM + (dir * 64 + s0) * 128 + 2 * kp), c1 = *(const float2*)(CUM + (dir * 64 + s0 + 1) * 128 + 2 * kp);
            float w00, w01, w10, w11;
            if (dir == 0) { const float2 L = *(const float2*)(TOT + 2 * kp); w00 = __expf(L.x - c0.x); w01 = __expf(L.y - c0.y); w10 = __expf(L.x - c1.x); w11 = __expf(L.y - c1.y); }
            else { w00 = __expf(c0.x); w01 = __expf(c0.y); w10 = __expf(c1.x); w11 = __expf(c1.y); }
            KT[(dir * 128 + 2 * kp) * 34 + sp] = pk_bf16(bf_lo(ka[q]) * w00, bf_lo(kb[q]) * w10);
            KT[(dir * 128 + 2 * kp + 1) * 34 + sp] = pk_bf16(bf_hi(ka[q]) * w01, bf_hi(kb[q]) * w11); }
        if (u + G < 1024) HL_LOAD_KV(u + G);
        __syncthreads();
        {
            const int dir = wv >> 2, kt0 = (wv & 3) * 2;
            const char* ktb = smem + H_KT; const char* vtb = smem + H_VT;
            bf16x8 xf[2][2];
#pragma unroll
            for (int a = 0; a < 2; ++a)
#pragma unroll
                for (int ks = 0; ks < 2; ++ks) {
                    const char* ad = ktb + ((dir * 128 + (kt0 + a) * 16 + fr) * 68 + ks * 32 + fq * 8) * 2;
                    u32x2 lo = *(const u32x2*)ad, hi = *(const u32x2*)(ad + 8); u32x4 t = {lo[0], lo[1], hi[0], hi[1]}; xf[a][ks] = __builtin_bit_cast(bf16x8, t);
                }
            bf16_t* Ub = U + ((size_t)((c * 4 + h) * 2 + dir)) * 16384;
#pragma unroll
            for (int vt = 0; vt < 8; ++vt) {
                bf16x8 yf[2];
#pragma unroll
                for (int ks = 0; ks < 2; ++ks) { const char* ad = vtb + ((vt * 16 + fr) * 68 + ks * 32 + fq * 8) * 2;
                    u32x2 lo = *(const u32x2*)ad, hi = *(const u32x2*)(ad + 8); u32x4 t = {lo[0], lo[1], hi[0], hi[1]}; yf[ks] = __builtin_bit_cast(bf16x8, t); }
#pragma unroll
                for (int a = 0; a < 2; ++a) {
                    f32x4 d = {0.f, 0.f, 0.f, 0.f};
                    d = mfma16(xf[a][0], yf[0], d); d = mfma16(xf[a][1], yf[1], d);
                    { u32x2 o; o[0] = pk_bf16(d[0], d[1]); o[1] = pk_bf16(d[2], d[3]); *(u32x2*)(Ub + (size_t)(vt * 16 + fr) * 128 + (kt0 + a) * 16 + 4 * fq) = o; }
                }
            }
        }
        __syncthreads();
    }
#undef HL_LOAD_LF
#undef HL_LOAD_KV
}
__device__ __forceinline__ void phase_hgrn_scan(KP p) {
    const int G = gridDim.x;
    const bf16_t* U = (const bf16_t*)(p->ws + A_U); const float* DTOT = (const float*)(p->ws + WS_DTOT); bf16_t* SC = (bf16_t*)(p->ws + A_SC);
    for (int e = blockIdx.x * NTHR + tid_(); e < 2 * 4 * 16384; e += G * NTHR) {
        const int dir = e >> 16, h = (e >> 14) & 3, vk = e & 16383, k = vk & 127;
        float st = 0.f;
        bf16_t ua[16], ub[16]; float da[16], db[16];
#define HS_LOAD(UU, DD, cc_) do { _Pragma("unroll") for (int j = 0; j < 16; ++j) { const int c = dir == 0 ? (cc_) + j : 255 - ((cc_) + j); \
            UU[j] = U[((size_t)((c * 4 + h) * 2 + dir)) * 16384 + vk]; DD[j] = DTOT[((size_t)dir * 256 + c) * 512 + h * 128 + k]; } } while (0)
#define HS_PROC(UU, DD, cc_) do { _Pragma("unroll") for (int j = 0; j < 16; ++j) { const int c = dir == 0 ? (cc_) + j : 255 - ((cc_) + j); \
            SC[((size_t)((c * 4 + h) * 2 + dir)) * 16384 + vk] = (bf16_t)(pk_bf16(st, 0.f) & 0xffffu); \
            st = DD[j] * st + bf2f(UU[j]); } } while (0)
        HS_LOAD(ua, da, 0);
#pragma unroll 1
        for (int cc = 0; cc < 256; cc += 32) {
            HS_LOAD(ub, db, cc + 16);
            HS_PROC(ua, da, cc);
            if (cc + 32 < 256) HS_LOAD(ua, da, cc + 32);
            HS_PROC(ub, db, cc + 16);
        }
#undef HS_LOAD
#undef HS_PROC
    }
}
__device__ __forceinline__ float clamp60(float x) { return fminf(fmaxf(x, -60.f), 60.f); }
__device__ __forceinline__ void phase_hgrn_out(KP p, char* smem) {
    const int bid = blockIdx.x, G = gridDim.x;
    float* CUM = (float*)(smem + H_CUM); float* TOT = (float*)(smem + H_TOT);
    float* OB = (float*)(smem + H_KT);
    const bf16_t* Qp = (const bf16_t*)(p->ws + A_Q); const bf16_t* KF = (const bf16_t*)(p->ws + A_KF); const bf16_t* SC = (const bf16_t*)(p->ws + A_SC);
    const bf16_t* GATE = (const bf16_t*)(p->ws + A_GATE); bf16_t* YAB = (bf16_t*)(p->ws + A_YAB); const float* ONORM = p->in[5];
    const bf16_t* V = (const bf16_t*)(p->ws + A_V); const float* LOGF = (const float*)(p->ws + A_LOGF); unsigned* VT = (unsigned*)(smem + H_VT);
    f32x4 lf[8]; unsigned va[4], vb[4];
#define HO_LOAD(uu) do { const int c_ = (uu) >> 2, h_ = (uu) & 3; const int t_ = tid_(); _Pragma("unroll") for (int q = 0; q < 8; ++q) { const int dr_ = q >> 2, s_ = ((t_ >> 5) + q * 16) & 63; \
        lf[q] = *(const f32x4*)(LOGF + ((size_t)dr_ * S + c_ * 64 + s_) * 512 + h_ * 128 + (t_ & 31) * 4); } \
        _Pragma("unroll") for (int q = 0; q < 4; ++q) { const bf16_t* vp_ = V + (size_t)(c_ * 64 + 2 * ((t_ >> 6) + q * 8)) * 512 + h_ * 128 + 2 * (t_ & 63); va[q] = *(const unsigned*)vp_; vb[q] = *(const unsigned*)(vp_ + 512); } } while (0)
    if (bid < 1024) HO_LOAD(bid);
    for (int u = bid; u < 1024; u += G) {
        const int c = u >> 2, h = u & 3, t0 = c * 64;
        const int tid = tid_(), lane = tid & 63, wv = tid >> 6, fr = lane & 15, fq = lane >> 4, kp = tid & 63, spb = tid >> 6;
        const int tt = wv & 3, dir = wv >> 2;
        const float* cum = CUM + dir * 64 * 128;
        const int midrow = dir == 0 ? 31 : 32;
        const int trow = tt * 16 + fr;
#pragma unroll
        for (int q = 0; q < 8; ++q) { const int dr_ = q >> 2, s_ = ((tid >> 5) + q * 16) & 63; *(f32x4*)(CUM + (dr_ * 64 + s_) * 128 + (tid & 31) * 4) = lf[q]; }
#pragma unroll
        for (int q = 0; q < 4; ++q) { const int sp = spb + q * 8;
            VT[(2 * kp) * 34 + sp] = (va[q] & 0xffffu) | (vb[q] << 16); VT[(2 * kp + 1) * 34 + sp] = (va[q] >> 16) | (vb[q] & 0xffff0000u); }
        u32x4 qvr[4];
#pragma unroll
        for (int ks = 0; ks < 4; ++ks) qvr[ks] = *(const u32x4*)(Qp + (size_t)(t0 + trow) * 512 + h * 128 + ks * 32 + fq * 8);
        __syncthreads();
        if (tid < 256) {
            const int dr = tid >> 7, k = tid & 127; float* col = CUM + dr * 64 * 128 + k; float run = 0.f;
#pragma unroll
            for (int b4 = 0; b4 < 4; ++b4) { float v[16];
#pragma unroll
                for (int s2 = 0; s2 < 16; ++s2) v[s2] = col[(b4 * 16 + s2) * 128];
#pragma unroll
                for (int s2 = 0; s2 < 16; ++s2) { const float x = v[s2]; if (dr == 0) { run += x; v[s2] = run; } else { v[s2] = run; run += x; } }
#pragma unroll
                for (int s2 = 0; s2 < 16; ++s2) col[(b4 * 16 + s2) * 128] = v[s2]; }
            TOT[dr * 128 + k] = run;
        }
        __syncthreads();
        bf16x8 qm[4], qi[4];
#pragma unroll
        for (int ks = 0; ks < 4; ++ks) {
            const int k0 = ks * 32 + fq * 8;
            const u32x4 qv = qvr[ks];
            unsigned om[4], oi[4];
#pragma unroll
            for (int jj = 0; jj < 4; ++jj) {
                const float q0 = bf_lo(qv[jj]), q1 = bf_hi(qv[jj]);
                const int ka = k0 + 2 * jj, kb = ka + 1;
                const float ca = cum[trow * 128 + ka], cb = cum[trow * 128 + kb], ma = cum[midrow * 128 + ka], mb = cum[midrow * 128 + kb];
                float em0, em1, ei0, ei1;
                if (dir == 0) { em0 = __expf(clamp60(ca - ma)); em1 = __expf(clamp60(cb - mb)); ei0 = __expf(ca); ei1 = __expf(cb); }
                else { em0 = __expf(clamp60(ma - ca)); em1 = __expf(clamp60(mb - cb)); ei0 = __expf(TOT[128 + ka] - ca); ei1 = __expf(TOT[128 + kb] - cb); }
                om[jj] = pk_bf16(q0 * em0, q1 * em1); oi[jj] = pk_bf16(q0 * ei0, q1 * ei1);
            }
            u32x4 tm = {om[0], om[1], om[2], om[3]}, ti = {oi[0], oi[1], oi[2], oi[3]};
            qm[ks] = __builtin_bit_cast(bf16x8, tm); qi[ks] = __builtin_bit_cast(bf16x8, ti);
        }
        f32x4 acc[8];
#pragma unroll
        for (int vt = 0; vt < 8; ++vt) acc[vt] = (f32x4){0.f, 0.f, 0.f, 0.f};
        unsigned pst[4][2];
#pragma unroll
        for (int st = 0; st < 4; ++st) {
            f32x4 sc = {0.f, 0.f, 0.f, 0.f};
            const bool need = dir == 0 ? (st <= tt) : (st >= tt);
            if (need) {
                const int srow = st * 16 + fr;
#pragma unroll
                for (int ks = 0; ks < 4; ++ks) {
                    const int k0 = ks * 32 + fq * 8;
                    const u32x4 kv = *(const u32x4*)(KF + ((size_t)dir * S + t0 + srow) * 512 + h * 128 + k0);
                    unsigned ok[4];
#pragma unroll
                    for (int jj = 0; jj < 4; ++jj) {
                        const int ka = k0 + 2 * jj, kb = ka + 1;
                        const float ca = cum[srow * 128 + ka], cb = cum[srow * 128 + kb], ma = cum[midrow * 128 + ka], mb = cum[midrow * 128 + kb];
                        float e0, e1;
                        if (dir == 0) { e0 = __expf(clamp60(ma - ca)); e1 = __expf(clamp60(mb - cb)); } else { e0 = __expf(clamp60(ca - ma)); e1 = __expf(clamp60(cb - mb)); }
                        ok[jj] = pk_bf16(bf_lo(kv[jj]) * e0, bf_hi(kv[jj]) * e1);
                    }
                    u32x4 tk = {ok[0], ok[1], ok[2], ok[3]};
                    sc = mfma16(__builtin_bit_cast(bf16x8, tk), qm[ks], sc);
                }
            }
            float pv[4];
#pragma unroll
            for (int i = 0; i < 4; ++i) { const int s = st * 16 + 4 * fq + i; const bool ok2 = need && (dir == 0 ? (s <= trow) : (s >= trow)); pv[i] = ok2 ? sc[i] : 0.f; }
            pst[st][0] = pk_bf16(pv[0], pv[1]); pst[st][1] = pk_bf16(pv[2], pv[3]);
        }
        {
            const char* vtb = smem + H_VT;
#pragma unroll
            for (int pp = 0; pp < 2; ++pp) {
                const int a = 2 * pp, b = 2 * pp + 1;
                u32x4 ty = {pst[a][0], pst[a][1], pst[b][0], pst[b][1]};
                const bf16x8 yf = __builtin_bit_cast(bf16x8, ty);
#pragma unroll
                for (int vt = 0; vt < 8; ++vt) {
                    const char* r0 = vtb + ((vt * 16 + fr) * 68) * 2;
                    const u32x2 lo = *(const u32x2*)(r0 + (16 * a + 4 * fq) * 2), hi = *(const u32x2*)(r0 + (16 * b + 4 * fq) * 2);
                    u32x4 tx = {lo[0], lo[1], hi[0], hi[1]};
                    acc[vt] = mfma16(__builtin_bit_cast(bf16x8, tx), yf, acc[vt]);
                }
            }
        }
        {
            const bf16_t* scb = SC + ((size_t)((c * 4 + h) * 2 + dir)) * 16384;
#pragma unroll
            for (int ks = 0; ks < 4; ++ks)
#pragma unroll
                for (int vt = 0; vt < 8; ++vt) {
                    const u32x4 sv = *(const u32x4*)(scb + (size_t)(vt * 16 + fr) * 128 + ks * 32 + fq * 8);
                    acc[vt] = mfma16(__builtin_bit_cast(bf16x8, sv), qi[ks], acc[vt]);
                }
        }
        if (u + G < 1024) HO_LOAD(u + G);
        __syncthreads();
        if (dir == 1) {
#pragma unroll
            for (int vt = 0; vt < 8; ++vt) *(f32x4*)(OB + ((tt * 64 + lane) * 32 + vt * 4)) = acc[vt];
        }
        __syncthreads();
        if (dir == 0) {
            float ss = 0.f;
#pragma unroll
            for (int vt = 0; vt < 8; ++vt) { const f32x4 o = *(const f32x4*)(OB + ((tt * 64 + lane) * 32 + vt * 4)); acc[vt] += o;
                ss += acc[vt][0] * acc[vt][0] + acc[vt][1] * acc[vt][1] + acc[vt][2] * acc[vt][2] + acc[vt][3] * acc[vt][3]; }
            ss += __shfl_xor(ss, 16); ss += __shfl_xor(ss, 32);
            const float rs = rsqrtf(ss * (1.f / 128.f) + 1e-6f);
            const int t = t0 + trow;
#pragma unroll
            for (int vt = 0; vt < 8; ++vt) {
                const int v = vt * 16 + 4 * fq;
                const f32x4 on = *(const f32x4*)(ONORM + h * 128 + v); const f32x4 g = bf4_to_f32(*(const u32x2*)(GATE + (size_t)t * 512 + h * 128 + v));
                u32x2 o; o[0] = pk_bf16(acc[vt][0] * rs * on[0] * g[0], acc[vt][1] * rs * on[1] * g[1]); o[1] = pk_bf16(acc[vt][2] * rs * on[2] * g[2], acc[vt][3] * rs * on[3] * g[3]);
                *(u32x2*)(YAB + (size_t)t * 1024 + h * 128 + v) = o;
            }
        }
        __syncthreads();
    }
#undef HO_LOAD
}

constexpr int AT_VT = 0;
constexpr int AT_VTS = 274;
constexpr int AT_BIAS = 35072;
constexpr int AT_CVT = 77824;
constexpr int AT_KL = 36864;
__device__ __forceinline__ void phase_attention(KP p, char* smem) {
    const int bid = blockIdx.x, G = gridDim.x, tid = tid_(), lane = tid & 63, wv = tid >> 6, fr = lane & 15, fq = lane >> 4;
    const bf16_t* AQ = (const bf16_t*)(p->ws + A_AQ); const bf16_t* AK = (const bf16_t*)(p->ws + A_AK); const bf16_t* AV = (const bf16_t*)(p->ws + A_AV);
    bf16_t* ATTO = (bf16_t*)(p->ws + A_ATTO); float* ATTL = (float*)(p->ws + WS_ATTL); const float* BI = (const float*)(p->ws + WS_BIAS);
    bf16_t* VT = (bf16_t*)(smem + AT_VT); float* BS = (float*)(smem + AT_BIAS);
    float* cvtile = (float*)(smem + AT_CVT);
    f32x4 cvpf[8]; int cvprev = -1;
    for (int u = bid; u < 3072; u += G) {
        cv_request(p, 0, 4, u, cvpf);
        if (cvprev >= 0) cv_store(p, 0, 4, cvprev, cvtile);
        const int g = u >> 10, rem = u & 1023, h = rem & 7, blk = rem >> 3;
        const int dil = g == 0 ? 1 : g == 1 ? 4 : 16, L = S / dil;
        const int r = blk % dil, jb = blk / dil, j0 = jb * 128, jw0 = j0 - 64;
        const int jq = j0 + 16 * wv + fr;
        const size_t qtok = (size_t)jq * dil + r;
        f32x4 sc[9];
        bf16x8 qf[2];
        {
            const int s = tid & 255, dq = tid >> 8;
            const int j = jw0 + s; const bool ok = (j >= 0 && j < L);
            const size_t tok = ok ? (size_t)j * dil + r : 0;
            u32x4 vreg[4], kreg[4];
#pragma unroll
            for (int cch = 0; cch < 4; ++cch) { vreg[cch] = (u32x4){0u, 0u, 0u, 0u}; kreg[cch] = (u32x4){0u, 0u, 0u, 0u};
                if (ok) { vreg[cch] = *(const u32x4*)(AV + tok * 512 + h * 64 + dq * 32 + cch * 8); kreg[cch] = *(const u32x4*)(AK + tok * 512 + h * 64 + dq * 32 + cch * 8); } }
#pragma unroll
            for (int ks = 0; ks < 2; ++ks) { const u32x4 t = *(const u32x4*)(AQ + qtok * 512 + h * 64 + ks * 32 + fq * 8); qf[ks] = __builtin_bit_cast(bf16x8, t); }
#pragma unroll
            for (int cch = 0; cch < 4; ++cch) {
                const int dh0 = dq * 32 + cch * 8; const u32x4 v = vreg[cch];
                *(u32x4*)(smem + AT_KL + s * 144 + dh0 * 2) = kreg[cch];
#pragma unroll
                for (int i = 0; i < 4; ++i) { VT[(dh0 + 2 * i) * AT_VTS + s] = (bf16_t)(v[i] & 0xffffu); VT[(dh0 + 2 * i + 1) * AT_VTS + s] = (bf16_t)(v[i] >> 16); }
            }
            for (int i = tid; i < 64 * 18; i += NTHR) { const int dh = i / 18, ss = 256 + (i % 18); VT[dh * AT_VTS + ss] = 0; }
            if (tid < 160) BS[tid] = (tid >= 16 && tid <= 144) ? BI[(g * 8 + h) * 132 + tid - 16] : -1e30f;
        }
        __syncthreads();
#pragma unroll
        for (int st = 0; st < 9; ++st) {
            f32x4 d = {0.f, 0.f, 0.f, 0.f};
#pragma unroll
            for (int ks = 0; ks < 2; ++ks) { const u32x4 t = *(const u32x4*)(smem + AT_KL + (16 * wv + 16 * st + fr) * 144 + ks * 64 + fq * 16); d = mfma16(__builtin_bit_cast(bf16x8, t), qf[ks], d); }
            sc[st] = d;
        }
        {
            float mx = -1e30f;
            const float* bsl = BS + 16 + 4 * fq - fr;
#pragma unroll
            for (int st = 0; st < 9; ++st)
#pragma unroll
                for (int i = 0; i < 4; ++i) sc[st][i] += bsl[16 * st + i];
            if (jw0 < 0 || jw0 + 256 > L) {
#pragma unroll
                for (int st = 0; st < 9; ++st)
#pragma unroll
                    for (int i = 0; i < 4; ++i) { const int jk = j0 + 16 * wv - 64 + 16 * st + 4 * fq + i; if (jk < 0 || jk >= L) sc[st][i] = -1e30f; }
            }
#pragma unroll
            for (int st = 0; st < 9; ++st)
#pragma unroll
                for (int i = 0; i < 4; ++i) mx = fmaxf(mx, sc[st][i]);
            mx = fmaxf(mx, __shfl_xor(mx, 16)); mx = fmaxf(mx, __shfl_xor(mx, 32));
            float sum = 0.f; unsigned pst[10][2];
#pragma unroll
            for (int st = 0; st < 9; ++st) {
                float pv[4];
#pragma unroll
                for (int i = 0; i < 4; ++i) { pv[i] = __expf(sc[st][i] - mx); sum += pv[i]; }
                pst[st][0] = pk_bf16(pv[0], pv[1]); pst[st][1] = pk_bf16(pv[2], pv[3]);
            }
            pst[9][0] = 0u; pst[9][1] = 0u;
            sum += __shfl_xor(sum, 16); sum += __shfl_xor(sum, 32);
            f32x4 o[4];
#pragma unroll
            for (int dt = 0; dt < 4; ++dt) o[dt] = (f32x4){0.f, 0.f, 0.f, 0.f};
#pragma unroll
            for (int pp = 0; pp < 5; ++pp) {
                const int a = 2 * pp, b = 2 * pp + 1;
                u32x4 ty = {pst[a][0], pst[a][1], pst[b][0], pst[b][1]};
                const bf16x8 yf = __builtin_bit_cast(bf16x8, ty);
#pragma unroll
                for (int dt = 0; dt < 4; ++dt) {
                    const bf16_t* row = VT + (dt * 16 + fr) * AT_VTS + 16 * wv + 4 * fq;
                    const unsigned a0 = *(const unsigned*)(row + 16 * a), a1 = *(const unsigned*)(row + 16 * a + 2);
                    const unsigned b0 = *(const unsigned*)(row + 16 * b), b1 = *(const unsigned*)(row + 16 * b + 2);
                    u32x4 tx = {a0, a1, b0, b1};
                    o[dt] = mfma16(__builtin_bit_cast(bf16x8, tx), yf, o[dt]);
                }
            }
            const float inv = 1.f / sum;
            bf16_t* ob = ATTO + ((size_t)g * S + qtok) * 512 + h * 64;
#pragma unroll
            for (int dt = 0; dt < 4; ++dt) { const f32x4 ov = o[dt] * inv; u32x2 oo = {pk_bf16(ov[0], ov[1]), pk_bf16(ov[2], ov[3])}; *(u32x2*)(ob + dt * 16 + 4 * fq) = oo; }
            if (fq == 0) ATTL[((size_t)g * S + qtok) * 8 + h] = mx + __logf(sum);
        }
        cv_to_lds(cvpf, cvtile); cvprev = u;
        __syncthreads();
    }
    if (cvprev >= 0) cv_store(p, 0, 4, cvprev, cvtile);
    __syncthreads();
}
__device__ __forceinline__ void phase_attn_merge(KP p) {
    const int G = gridDim.x;
    const bf16_t* ATTO = (const bf16_t*)(p->ws + A_ATTO); const float* ATTL = (const float*)(p->ws + WS_ATTL); bf16_t* YAB = (bf16_t*)(p->ws + A_YAB);
    for (int i = blockIdx.x * NTHR + tid_(); i < S * 128; i += G * NTHR) {
        const int t = i >> 7, c = (i & 127) * 4, h = c >> 6;
        const float l0 = ATTL[((size_t)0 * S + t) * 8 + h], l1 = ATTL[((size_t)1 * S + t) * 8 + h], l2 = ATTL[((size_t)2 * S + t) * 8 + h];
        const float mx = fmaxf(l0, fmaxf(l1, l2)); const float e0 = __expf(l0 - mx), e1 = __expf(l1 - mx), e2 = __expf(l2 - mx); const float inv = 1.f / (e0 + e1 + e2);
        const f32x4 a = bf4_to_f32(*(const u32x2*)(ATTO + ((size_t)0 * S + t) * 512 + c)), b = bf4_to_f32(*(const u32x2*)(ATTO + ((size_t)1 * S + t) * 512 + c)), d = bf4_to_f32(*(const u32x2*)(ATTO + ((size_t)2 * S + t) * 512 + c));
        const f32x4 y = (a * e0 + b * e1 + d * e2) * inv;
        u32x2 o; o[0] = pk_bf16(y[0], y[1]); o[1] = pk_bf16(y[2], y[3]);
        *(u32x2*)(YAB + (size_t)t * 1024 + 512 + c) = o;
    }
}

__device__ __forceinline__ void phase_moe_router(KP p, int layer, const float* __restrict__ X, char* smem) {
    const int bid = blockIdx.x, G = gridDim.x, tid = tid_(), lane = tid & 63, wv = tid >> 6, fr = lane & 15, fq = lane >> 4;
    float* RT = (float*)smem;
    float* XCH = (float*)(smem + 65536);
    const float* R = p->in[26] + (size_t)layer * 1024 * 16; const float* gain = p->in[25] + (size_t)layer * 1024;
    for (int i = tid; i < 16384; i += NTHR) { const int k = i >> 4, e = i & 15; RT[e * 1024 + k] = R[i] * gain[k]; }
    __syncthreads();
    float* AFF = (float*)(p->ws + WS_AFF); int* SLOT = (int*)(p->ws + WS_SLOT); float* RSTD = (float*)(p->ws + WS_RSTD);
    const int tw = wv & 3, kh = wv >> 2;
    for (int T = bid * 4 + tw; T < S / 16; T += G * 4) {
        const int t0 = T * 16;
        f32x4 acc = {0.f, 0.f, 0.f, 0.f}; float ssq = 0.f;
        const float* xr = X + (size_t)(t0 + fr) * 1024 + kh * 512 + 4 * fq;
        const float* rr = RT + fr * 1024 + kh * 512 + 4 * fq;
#pragma unroll 1
        for (int jb = 0; jb < 4; ++jb) {
            f32x4 xa[8];
#pragma unroll
            for (int j = 0; j < 8; ++j) xa[j] = *(const f32x4*)(xr + (jb * 8 + j) * 16);
#pragma unroll
            for (int j = 0; j < 8; ++j) {
                const f32x4 rb = *(const f32x4*)(rr + (jb * 8 + j) * 16);
#pragma unroll
                for (int i = 0; i < 4; ++i) { acc = __builtin_amdgcn_mfma_f32_16x16x4f32(xa[j][i], rb[i], acc, 0, 0, 0); ssq += xa[j][i] * xa[j][i]; }
            }
        }
        ssq += __shfl_xor(ssq, 16); ssq += __shfl_xor(ssq, 32);
        if (kh == 1) { float* o = XCH + (tw * 64 + lane) * 5; o[0] = acc[0]; o[1] = acc[1]; o[2] = acc[2]; o[3] = acc[3]; o[4] = ssq; }
        __syncthreads();
        if (kh == 0) {
            const float* o = XCH + (tw * 64 + lane) * 5;
            acc[0] += o[0]; acc[1] += o[1]; acc[2] += o[2]; acc[3] += o[3]; ssq += o[4];
            const float rs_own = rsqrtf(ssq * (1.f / 1024.f) + 1e-6f);
            if (fq == 0) RSTD[t0 + fr] = rs_own;
            float aff[4];
#pragma unroll
            for (int r = 0; r < 4; ++r) {
                const float rs = __shfl(rs_own, 4 * fq + r);
                const float lg = acc[r] * rs;
                float mx = lg;
                mx = fmaxf(mx, __shfl_xor(mx, 1)); mx = fmaxf(mx, __shfl_xor(mx, 2)); mx = fmaxf(mx, __shfl_xor(mx, 4)); mx = fmaxf(mx, __shfl_xor(mx, 8));
                const float ex = expf(lg - mx);
                float sm = ex;
                sm += __shfl_xor(sm, 1); sm += __shfl_xor(sm, 2); sm += __shfl_xor(sm, 4); sm += __shfl_xor(sm, 8);
                aff[r] = ex / sm;
                SLOT[(size_t)(t0 + 4 * fq + r) * 16 + fr] = -1;
            }
            const f32x4 av = {aff[0], aff[1], aff[2], aff[3]};
            *(f32x4*)(AFF + (size_t)fr * S + t0 + 4 * fq) = av;
        }
        __syncthreads();
    }
}
__device__ __forceinline__ void phase_moe_select(KP p, char* smem) {
    const int bid = blockIdx.x, G = gridDim.x, tid = tid_(), lane = tid & 63, wv = tid >> 6;
    unsigned* vals = (unsigned*)smem; unsigned* hist = vals + 16384; unsigned* misc = hist + 256; unsigned* wsum = misc + 16;
    const float* AFF = (const float*)(p->ws + WS_AFF); int* SLOT = (int*)(p->ws + WS_SLOT); int* IDX = (int*)(p->ws + WS_IDX); float* GW = (float*)(p->ws + WS_GATEW);
    const float* RSTD = (const float*)(p->ws + WS_RSTD); float* RSE = (float*)(p->ws + WS_RSTDE);
    for (int e = bid; e < 16; e += G) {
        for (int i = tid; i < 16384; i += NTHR) vals[i] = __float_as_uint(AFF[(size_t)e * S + i]);
        unsigned long long prefix = 0ull; unsigned remaining = 2048u;
        for (int pass = 0; pass < 6; ++pass) {
            const int shift = 40 - 8 * pass;
            if (tid < 256) hist[tid] = 0u;
            __syncthreads();
            {
                unsigned cur = 0u, cn = 0u;
                for (int i = tid; i < 16384; i += NTHR) {
                    const unsigned long long key = ((unsigned long long)vals[i] << 14) | (unsigned long long)(16383 - i);
                    if ((key >> (shift + 8)) == prefix) { const unsigned d = (unsigned)(key >> shift) & 255u;
                        if (cn != 0u && d == cur) ++cn; else { if (cn != 0u) atomicAdd(&hist[cur], cn); cur = d; cn = 1u; } }
                }
                if (cn != 0u) atomicAdd(&hist[cur], cn);
            }
            __syncthreads();
            if (wv == 0) {
                unsigned cj[4]; unsigned loc = 0u;
#pragma unroll
                for (int j = 0; j < 4; ++j) { cj[j] = hist[255 - (4 * lane + j)]; loc += cj[j]; }
                unsigned inc = loc;
#pragma unroll
                for (int o = 1; o < 64; o <<= 1) { const unsigned t = __shfl_up(inc, o); if (lane >= o) inc += t; }
                unsigned before = inc - loc;
#pragma unroll
                for (int j = 0; j < 4; ++j) { if (before < remaining && remaining <= before + cj[j]) { misc[0] = 255u - (unsigned)(4 * lane + j); misc[1] = remaining - before; } before += cj[j]; }
            }
            __syncthreads();
            prefix = (prefix << 8) | (unsigned long long)misc[0]; remaining = misc[1];
            __syncthreads();
        }
        const int tb = tid * 32; unsigned sel = 0u; unsigned cnt = 0u;
#pragma unroll 4
        for (int i = 0; i < 32; ++i) { const int t = tb + i; const unsigned long long key = ((unsigned long long)vals[t] << 14) | (unsigned long long)(16383 - t); if (key >= prefix) { sel |= 1u << i; ++cnt; } }
        unsigned inc = cnt;
#pragma unroll
        for (int o = 1; o < 64; o <<= 1) { const unsigned t = __shfl_up(inc, o); if (lane >= o) inc += t; }
        if (lane == 63) wsum[wv] = inc;
        __syncthreads();
        unsigned base = inc - cnt;
        for (int w = 0; w < wv; ++w) base += wsum[w];
        for (int i = 0; i < 32; ++i) if (sel & (1u << i)) { const int t = tb + i; if (base < 2048u) { IDX[e * 2048 + base] = t; GW[e * 2048 + base] = __uint_as_float(vals[t]); RSE[e * 2048 + base] = RSTD[t]; SLOT[(size_t)t * 16 + e] = (int)base; } ++base; }
        __syncthreads();
    }
}
__device__ __forceinline__ void phase_moe_gather(KP p) {
    const int G = gridDim.x, lane = tid_() & 63, wv = tid_() >> 6;
    const bf16_t* HB = (const bf16_t*)(p->ws + M_HB); bf16_t* XE = (bf16_t*)(p->ws + M_XE); const int* IDX = (const int*)(p->ws + WS_IDX);
    for (int r = blockIdx.x * 8 + wv; r < 32768; r += G * 8) {
        const int t = IDX[r];
        const u32x4 a = *(const u32x4*)(HB + (size_t)t * 1024 + lane * 8), b = *(const u32x4*)(HB + (size_t)t * 1024 + 512 + lane * 8);
        *(u32x4*)(XE + (size_t)r * 1024 + lane * 8) = a; *(u32x4*)(XE + (size_t)r * 1024 + 512 + lane * 8) = b;
    }
}
__device__ __forceinline__ void moe_add_rows(float4 (&v)[4], const bf16_t* __restrict__ YE, int myslot, int lane) {
    unsigned mask = (unsigned)(__ballot(lane < 16 && myslot >= 0) & 0xFFFFull);
    while (mask) {
        u32x2 a[4][4]; int cnt = 0;
#pragma unroll
        for (int k = 0; k < 4; ++k) {
            if (mask) { const int e = __builtin_ctz(mask); mask &= mask - 1; const int sl = __shfl(myslot, e); ++cnt;
                const bf16_t* y = YE + ((size_t)e * 2048 + sl) * 1024;
#pragma unroll
                for (int i = 0; i < 4; ++i) a[k][i] = *(const u32x2*)(y + (i * 64 + lane) * 4); }
            else {
#pragma unroll
                for (int i = 0; i < 4; ++i) a[k][i] = (u32x2){0u, 0u}; }
        }
#pragma unroll
        for (int k = 0; k < 4; ++k)
#pragma unroll
            for (int i = 0; i < 4; ++i) { v[i].x += bf_lo(a[k][i][0]); v[i].y += bf_hi(a[k][i][0]); v[i].z += bf_lo(a[k][i][1]); v[i].w += bf_hi(a[k][i][1]); }
        (void)cnt;
    }
}
__device__ __forceinline__ void phase_moe_combine(KP p, const float* __restrict__ Xin, float* __restrict__ Xout, const float* __restrict__ gain, float* __restrict__ Hout) {
    const int G = gridDim.x, lane = tid_() & 63, wv = tid_() >> 6;
    const bf16_t* YE = (const bf16_t*)(p->ws + M_YE); const int* SLOT = (const int*)(p->ws + WS_SLOT);
    float4 vn[4]; int slotn = -1;
    { const int r0 = blockIdx.x * 8 + wv;
      if (r0 < S) {
#pragma unroll
          for (int i = 0; i < 4; ++i) vn[i] = *(const float4*)(Xin + (size_t)r0 * 1024 + (i * 64 + lane) * 4);
          slotn = lane < 16 ? SLOT[(size_t)r0 * 16 + lane] : -1; } }
    for (int r = blockIdx.x * 8 + wv; r < S; r += G * 8) {
        float4 v[4];
#pragma unroll
        for (int i = 0; i < 4; ++i) v[i] = vn[i];
        const int myslot = slotn;
        { const int rn = r + G * 8;
          if (rn < S) {
#pragma unroll
              for (int i = 0; i < 4; ++i) vn[i] = *(const float4*)(Xin + (size_t)rn * 1024 + (i * 64 + lane) * 4);
              slotn = lane < 16 ? SLOT[(size_t)rn * 16 + lane] : -1; } }
        moe_add_rows(v, YE, myslot, lane);
        float ss = 0.f;
#pragma unroll
        for (int i = 0; i < 4; ++i) { if (Xout) *(float4*)(Xout + (size_t)r * 1024 + (i * 64 + lane) * 4) = v[i]; ss += v[i].x * v[i].x + v[i].y * v[i].y + v[i].z * v[i].z + v[i].w * v[i].w; }
        ss = wave_sum(ss);
        const float rs = rsqrtf(ss * (1.f / 1024.f) + 1e-6f);
#pragma unroll
        for (int i = 0; i < 4; ++i) { const float4 g = *(const float4*)(gain + (i * 64 + lane) * 4);
            float4 o; o.x = v[i].x * rs * g.x; o.y = v[i].y * rs * g.y; o.z = v[i].z * rs * g.z; o.w = v[i].w * rs * g.w;
            *(float4*)(Hout + (size_t)r * 1024 + (i * 64 + lane) * 4) = o; }
    }
}
__device__ __forceinline__ void phase_combine_mix(KP p, const float* __restrict__ Xin, float* __restrict__ Xout, const float* __restrict__ gain, char* smem) {
    const int G = gridDim.x, tid = tid_(), lane = tid & 63, wv = tid >> 6;
    const bf16_t* YE = (const bf16_t*)(p->ws + M_YE); const int* SLOT = (const int*)(p->ws + WS_SLOT);
    bf16_t* MIX = (bf16_t*)(p->ws + R_MIX); const float* mu = p->in[8]; const float* muw = p->in[9];
    for (int u = blockIdx.x; u < 256; u += G) {
        const int r0 = u * 64 - 1;
        float4 vn[4]; int slotn = -1;
        { const int rf = r0 + wv;
          if (rf >= 0 && rf < S) {
#pragma unroll
              for (int i = 0; i < 4; ++i) vn[i] = *(const float4*)(Xin + (size_t)rf * 1024 + (i * 64 + lane) * 4);
              slotn = lane < 16 ? SLOT[(size_t)rf * 16 + lane] : -1; } }
        for (int j = wv; j < 66; j += 8) {
            const int r = r0 + j;
            u32x2* hrow = (u32x2*)(smem + j * 2048);
            float4 v[4];
#pragma unroll
            for (int i = 0; i < 4; ++i) v[i] = vn[i];
            const int myslot = slotn;
            { const int rn = r + 8;
              if (j + 8 < 66 && rn >= 0 && rn < S) {
#pragma unroll
                  for (int i = 0; i < 4; ++i) vn[i] = *(const float4*)(Xin + (size_t)rn * 1024 + (i * 64 + lane) * 4);
                  slotn = lane < 16 ? SLOT[(size_t)rn * 16 + lane] : -1; } }
            if (r < 0 || r >= S) {
#pragma unroll
                for (int i = 0; i < 4; ++i) { u32x2 zz = {0u, 0u}; hrow[i * 64 + lane] = zz; }
                continue;
            }
            moe_add_rows(v, YE, myslot, lane);
            float ss = 0.f;
#pragma unroll
            for (int i = 0; i < 4; ++i) { if (j >= 1 && j <= 64) *(float4*)(Xout + (size_t)r * 1024 + (i * 64 + lane) * 4) = v[i]; ss += v[i].x * v[i].x + v[i].y * v[i].y + v[i].z * v[i].z + v[i].w * v[i].w; }
            ss = wave_sum(ss);
            const float rs = rsqrtf(ss * (1.f / 1024.f) + 1e-6f);
#pragma unroll
            for (int i = 0; i < 4; ++i) { const float4 g = *(const float4*)(gain + (i * 64 + lane) * 4);
                u32x2 o; o[0] = pk_bf16(v[i].x * rs * g.x, v[i].y * rs * g.y); o[1] = pk_bf16(v[i].z * rs * g.z, v[i].w * rs * g.w); hrow[i * 64 + lane] = o; }
        }
        __syncthreads();
        for (int j = 1 + wv; j <= 64; j += 8) {
            const int r = r0 + j;
#pragma unroll
            for (int i = 0; i < 2; ++i) {
                const int c = (i * 64 + lane) * 8;
                const u32x4 hb = ((const u32x4*)(smem + j * 2048))[i * 64 + lane], pb = ((const u32x4*)(smem + (j - 1) * 2048))[i * 64 + lane], nb = ((const u32x4*)(smem + (j + 1) * 2048))[i * 64 + lane];
                const u32x2 hb0 = {hb[0], hb[1]}, hb1 = {hb[2], hb[3]}, pb0 = {pb[0], pb[1]}, pb1 = {pb[2], pb[3]}, nb0 = {nb[0], nb[1]}, nb1 = {nb[2], nb[3]};
                const f32x4 h0 = bf4_to_f32(hb0), h1 = bf4_to_f32(hb1);
                const f32x4 xx0 = (bf4_to_f32(pb0) + bf4_to_f32(nb0)) * 0.5f - h0, xx1 = (bf4_to_f32(pb1) + bf4_to_f32(nb1)) * 0.5f - h1;
#pragma unroll
                for (int q = 0; q < 7; ++q) {
                    const float* mp = (q < 5 ? mu + q * 1024 : muw + (q - 5) * 1024) + c;
                    const f32x4 m0 = *(const f32x4*)mp, m1 = *(const f32x4*)(mp + 4);
                    *(u32x4*)(MIX + ((size_t)q * S + r) * 1024 + c) = pk8(h0 + xx0 * m0, h1 + xx1 * m1);
                }
            }
        }
        __syncthreads();
    }
}
__device__ __forceinline__ void moe_gemms_gateup(KP p, char* smem) {
    const bf16_t* HB = (const bf16_t*)(p->ws + M_HB); const int* IDX = (const int*)(p->ws + WS_IDX); const bf16_t* GU = (const bf16_t*)(p->ws + WS_BT_GU); bf16_t* HID = (bf16_t*)(p->ws + M_HID);
    int pre = 0;
    for (int L = blockIdx.x; L < 16 * 128; L += gridDim.x) {
        const int rr = L >> 8, x = L & 7, i = (L >> 3) & 31, e = 2 * rr + (x >> 2), pm = (x & 1) * 4 + (i & 3), pn = ((x >> 1) & 1) * 8 + (i >> 2);
        const int Ln = L + gridDim.x; GemmNext nx{HB, nullptr, nullptr, 0, 0, Ln < 16 * 128 ? 1 : 0};
        if (nx.valid) { const int rr2 = Ln >> 8, x2 = Ln & 7, i2 = (Ln >> 3) & 31, e2 = 2 * rr2 + (x2 >> 2);
            nx.Bt = GU + (size_t)e2 * 4096 * 512; nx.gidx = IDX + e2 * 2048; nx.brow = ((x2 & 1) * 4 + (i2 & 3)) * 256; nx.bcol = (((x2 >> 1) & 1) * 8 + (i2 >> 2)) * 256; }
        EpiSwiglu E{HID + (size_t)e * 2048 * 1024, (const float*)(p->ws + WS_RSTDE) + e * 2048};
        gemm_tile<EpiSwiglu, true, true>(HB, GU + (size_t)e * 4096 * 512, 512, pm * 256, pn * 256, (bf16_t*)smem, E, IDX + e * 2048, pre, nx);
        pre = nx.valid;
    }
}
__device__ __forceinline__ void moe_gemms_down(KP p, char* smem) {
    const bf16_t* HID = (const bf16_t*)(p->ws + M_HID); const bf16_t* DN = (const bf16_t*)(p->ws + WS_BT_DN); bf16_t* YE = (bf16_t*)(p->ws + M_YE); const float* GW = (const float*)(p->ws + WS_GATEW);
    int pre = 0;
    for (int L = blockIdx.x; L < 16 * 32; L += gridDim.x) {
        const int rr = L >> 8, x = L & 7, i = (L >> 3) & 31, e = 8 * rr + x, pm = i & 7, pn = i >> 3;
        const int Ln = L + gridDim.x; GemmNext nx{nullptr, nullptr, nullptr, 0, 0, Ln < 16 * 32 ? 1 : 0};
        if (nx.valid) { const int e2 = 8 * (Ln >> 8) + (Ln & 7), i2 = (Ln >> 3) & 31; nx.A = HID + (size_t)e2 * 2048 * 1024; nx.Bt = DN + (size_t)e2 * 1024 * 1024; nx.brow = (i2 & 7) * 256; nx.bcol = (i2 >> 3) * 256; }
        EpiDown E{YE + (size_t)e * 2048 * 1024, GW + e * 2048};
        gemm_tile<EpiDown, false, true>(HID + (size_t)e * 2048 * 1024, DN + (size_t)e * 1024 * 1024, 1024, pm * 256, pn * 256, (bf16_t*)smem, E, nullptr, pre, nx);
        pre = nx.valid;
    }
}

__device__ __forceinline__ void phase_rwkv_mix(KP p) {
    const int G = gridDim.x, lane = tid_() & 63, wv = tid_() >> 6;
    const float* H1 = (const float*)(p->ws + R_H1); bf16_t* MIX = (bf16_t*)(p->ws + R_MIX);
    const float* mu = p->in[8]; const float* muw = p->in[9];
    for (int r = blockIdx.x * 8 + wv; r < S; r += G * 8) {
#pragma unroll
        for (int i = 0; i < 4; ++i) {
            const int c = (i * 64 + lane) * 4;
            const f32x4 h = *(const f32x4*)(H1 + (size_t)r * 1024 + c);
            f32x4 hp = {0.f, 0.f, 0.f, 0.f}, hn = {0.f, 0.f, 0.f, 0.f};
            if (r > 0) hp = *(const f32x4*)(H1 + (size_t)(r - 1) * 1024 + c);
            if (r < S - 1) hn = *(const f32x4*)(H1 + (size_t)(r + 1) * 1024 + c);
            const f32x4 xx = (hp + hn) * 0.5f - h;
#pragma unroll
            for (int j = 0; j < 7; ++j) {
                const f32x4 m = *(const f32x4*)((j < 5 ? mu + j * 1024 : muw + (j - 5) * 1024) + c);
                const f32x4 o = h + xx * m;
                u32x2 w; w[0] = pk_bf16(o[0], o[1]); w[1] = pk_bf16(o[2], o[3]);
                *(u32x2*)(MIX + ((size_t)j * S + r) * 1024 + c) = w;
            }
        }
    }
}
__device__ __forceinline__ void phase_rwkv_prep(KP p) {
    const int G = gridDim.x;
    float* KK = (float*)(p->ws + R_KK); float* AA = (float*)(p->ws + R_AA); float* KKN = (float*)(p->ws + R_KKN);
    const float* k_k = p->in[19]; const float* k_a = p->in[20];
    for (int i = blockIdx.x * NTHR + tid_(); i < S * 256; i += G * NTHR) {
        const int t = i >> 8, c = (i & 255) * 4;
        const f32x4 k = *(const f32x4*)(KK + (size_t)t * 1024 + c), a = *(const f32x4*)(AA + (size_t)t * 1024 + c);
        const f32x4 kkw = *(const f32x4*)(k_k + c), kaw = *(const f32x4*)(k_a + c);
        f32x4 kk = k * kkw;
        float ss = kk[0] * kk[0] + kk[1] * kk[1] + kk[2] * kk[2] + kk[3] * kk[3];
        ss += __shfl_xor(ss, 1); ss += __shfl_xor(ss, 2); ss += __shfl_xor(ss, 4); ss += __shfl_xor(ss, 8);
        const float inv = 1.f / fmaxf(sqrtf(ss), 1e-12f);
        kk = kk * inv;
        f32x4 kn, b;
#pragma unroll
        for (int j = 0; j < 4; ++j) { kn[j] = k[j] * (1.f + (a[j] - 1.f) * kaw[j]); b[j] = kk[j] * a[j]; }
        *(f32x4*)(KKN + (size_t)t * 1024 + c) = kk; *(f32x4*)(KK + (size_t)t * 1024 + c) = kn; *(f32x4*)(AA + (size_t)t * 1024 + c) = b;
    }
}
#ifndef RW_SIMPLE_INV
#define RW_SIMPLE_INV 0
#endif
constexpr int RS = 68;
constexpr int RBUF = 64 * RS * 2;
constexpr int RW_MF = 12 * RBUF;
constexpr int RW_SEG = RW_MF + 64 * 68 * 4;
constexpr int RW_PC = RW_SEG + 2048;
constexpr int RW_CVT = RW_PC + 512;
constexpr int RW_CVT_TILES = 4 * 1536;
enum { B_AT = 0  , B_ATT = 1, B_BT = 2  , B_KT = 3  , B_RT = 4, B_BHT = 5, B_KHT = 6, B_VT = 7, B_MAK = 8, B_TT = 9, B_NBRT = 10, B_W2 = 11 };

__device__ __forceinline__ bf16x8 rw_frag(const char* buf, int row, int col) {
    const char* ad = buf + (row * RS + col) * 2;
    const u32x2 lo = *(const u32x2*)ad, hi = *(const u32x2*)(ad + 8);
    u32x4 t = {lo[0], lo[1], hi[0], hi[1]};
    return __builtin_bit_cast(bf16x8, t);
}
struct Frag2 { bf16x8 f[2]; };
__device__ __forceinline__ Frag2 rw_frag2(const char* buf, int tile, int fr, int fq) { Frag2 r; r.f[0] = rw_frag(buf, tile * 16 + fr, fq * 8); r.f[1] = rw_frag(buf, tile * 16 + fr, 32 + fq * 8); return r; }
__device__ __forceinline__ f32x4 rw_mm(const Frag2& x, const Frag2& y, f32x4 acc) { acc = mfma16(x.f[0], y.f[0], acc); return mfma16(x.f[1], y.f[1], acc); }
__device__ __forceinline__ f32x4 rw_tile(const char* xbuf, int xt, const char* ybuf, int yt, f32x4 acc, int fr, int fq) {
#pragma unroll
    for (int ks = 0; ks < 2; ++ks) acc = mfma16(rw_frag(xbuf, xt * 16 + fr, ks * 32 + fq * 8), rw_frag(ybuf, yt * 16 + fr, ks * 32 + fq * 8), acc);
    return acc;
}
__device__ __forceinline__ void rw_store_t(char* buf, int xt, int yt, f32x4 d, int fr, int fq) {
    u32x2 o; o[0] = pk_bf16(d[0], d[1]); o[1] = pk_bf16(d[2], d[3]);
    *(u32x2*)(buf + ((yt * 16 + fr) * RS + xt * 16 + 4 * fq) * 2) = o;
}
__device__ __forceinline__ bool nf4(f32x4 v) { return !(fabsf(v[0]) < 1e30f) || !(fabsf(v[1]) < 1e30f) || !(fabsf(v[2]) < 1e30f) || !(fabsf(v[3]) < 1e30f); }
__device__ __forceinline__ bool big4(f32x4 v) { return (fabsf(v[0]) > 1e6f) || (fabsf(v[1]) > 1e6f) || (fabsf(v[2]) > 1e6f) || (fabsf(v[3]) > 1e6f); }
#define DBGFLAG(cond, bit) do { if (cond) atomicOr((unsigned*)(DBGW), 1u << (bit)); } while (0)
__device__ __forceinline__ bool gt4(f32x4 v, float th) { return !(fabsf(v[0]) <= th) || !(fabsf(v[1]) <= th) || !(fabsf(v[2]) <= th) || !(fabsf(v[3]) <= th); }
template <int J> __device__ __forceinline__ void rw_offdiag(const float* MF, char* TTb, int fr, int fq) {
    f32x4 Tb[3];
#pragma unroll
    for (int I = J - 1; I >= 0; --I) {
        f32x4 acc = {0.f, 0.f, 0.f, 0.f};
#pragma unroll
        for (int L = I + 1; L <= J; ++L) {
#pragma unroll
            for (int kk = 0; kk < 4; ++kk) {
                const float a = MF[(16 * I + fr) * 68 + 16 * L + 4 * fq + kk];
                const float b = (L == J) ? MF[(16 * J + 4 * fq + kk) * 68 + 16 * J + fr] : Tb[L < 3 ? L : 0][kk];
                acc = __builtin_amdgcn_mfma_f32_16x16x4f32(a, b, acc, 0, 0, 0);
            }
        }
        f32x4 res = {0.f, 0.f, 0.f, 0.f};
#pragma unroll
        for (int kk = 0; kk < 4; ++kk) { const float a = MF[(16 * I + fr) * 68 + 16 * I + 4 * fq + kk]; res = __builtin_amdgcn_mfma_f32_16x16x4f32(a, acc[kk], res, 0, 0, 0); }
        Tb[I] = res;         u32x2 o; o[0] = pk_bf16(res[0], res[1]); o[1] = pk_bf16(res[2], res[3]);
        *(u32x2*)(TTb + ((16 * J + fr) * RS + 16 * I + 4 * fq) * 2) = o;
    }
}

typedef float f32x2_t __attribute__((ext_vector_type(2)));
__device__ __forceinline__ unsigned pk4_fp8s(f32x4 v) {
    float a = fminf(fmaxf(v[0] * 8.f, -448.f), 448.f), b = fminf(fmaxf(v[1] * 8.f, -448.f), 448.f), c = fminf(fmaxf(v[2] * 8.f, -448.f), 448.f), d = fminf(fmaxf(v[3] * 8.f, -448.f), 448.f);
    return pk4_fp8(a, b, c, d);
}
__device__ __forceinline__ bf16x8 fp8x8_to_bf16(unsigned lo, unsigned hi) {
    const f32x2_t a = __builtin_amdgcn_cvt_pk_f32_fp8((int)lo, false), b = __builtin_amdgcn_cvt_pk_f32_fp8((int)lo, true), c = __builtin_amdgcn_cvt_pk_f32_fp8((int)hi, false), d = __builtin_amdgcn_cvt_pk_f32_fp8((int)hi, true);
    const u32x4 t = {pk_bf16(a[0], a[1]), pk_bf16(b[0], b[1]), pk_bf16(c[0], c[1]), pk_bf16(d[0], d[1])};
    return __builtin_bit_cast(bf16x8, t);
}
__device__ __forceinline__ unsigned char* rw_rec(unsigned char* ws, size_t uidx) {
    return ws + R_REC_A + uidx * 16384;
}
__device__ __forceinline__ void phase_rwkv_chunk_local(KP p, char* smem) {
    const int bid = blockIdx.x, G = gridDim.x, tid = tid_();
    const bf16_t* RR = (const bf16_t*)(p->ws + R_RR); const bf16_t* KK = (const bf16_t*)(p->ws + R_KK); const bf16_t* VV = (const bf16_t*)(p->ws + R_VV);
    const bf16_t* AAp = (const bf16_t*)(p->ws + R_AA); const bf16_t* LOGW = (const bf16_t*)(p->ws + R_LOGW);
    const float* k_k = p->in[19]; const float* k_a = p->in[20]; const float* r_kp = p->in[21];
    float* CS = (float*)(smem + RW_MF); float* MF = CS; float* SEG = (float*)(smem + RW_SEG); float* PC = (float*)(smem + RW_PC); float* EM = PC + 64;
#define RBUFP(i) (smem + (i) * RBUF)
    const f32x4 zero4 = {0.f, 0.f, 0.f, 0.f};
    const int tau = tid >> 3, k8 = (tid & 7) * 8;
    f32x4 in_lw[2], in_a[2]; u32x4 in_rb, in_kb, in_vb, in_lwb, in_ab;
#define RW_LOAD(uu) do { const int z_ = (uu) & 1, h_ = ((uu) >> 1) & 15, t0_ = ((uu) >> 5) * 64; const int tok_ = z_ ? t0_ + 63 - tau : t0_ + tau; \
        const size_t o_ = (size_t)tok_ * 1024 + h_ * 64 + k8; \
        in_lwb = *(const u32x4*)(LOGW + (size_t)z_ * S * 1024 + o_); in_rb = *(const u32x4*)(RR + o_); \
        in_kb = *(const u32x4*)(KK + o_); in_ab = *(const u32x4*)(AAp + o_); \
        in_vb = *(const u32x4*)(VV + o_); } while (0)
    if (bid < 8192) RW_LOAD(bid);
    for (int u = bid; u < 8192; u += G) {
        const int z = u & 1, h = (u >> 1) & 15, cseq = u >> 5, cproc = z ? 255 - cseq : cseq;
        const size_t uidx = (size_t)(z * 16 + h) * 256 + cproc;
        u32x4* REC = (u32x4*)rw_rec(p->ws, uidx);
        const int tl = tid_(), lane = tl & 63, wv = tl >> 6, fr = lane & 15, fq = lane >> 4, yt = wv & 3, xp = wv >> 2;
        f32x4 cvq[2] = {{0.f, 0.f, 0.f, 0.f}, {0.f, 0.f, 0.f, 0.f}};
        if (u < RW_CVT_TILES) cv1_request(p, 1, 0, u, cvq);
        { const u32x2 l0 = {in_lwb[0], in_lwb[1]}, l1 = {in_lwb[2], in_lwb[3]}, a0 = {in_ab[0], in_ab[1]}, a1 = {in_ab[2], in_ab[3]};
          in_lw[0] = bf4_to_f32(l0); in_lw[1] = bf4_to_f32(l1); in_a[0] = bf4_to_f32(a0); in_a[1] = bf4_to_f32(a1); }
        *(f32x4*)(CS + tau * 68 + k8) = in_lw[0]; *(f32x4*)(CS + tau * 68 + k8 + 4) = in_lw[1];
        __syncthreads();
        { const int k = tid & 63, seg = tid >> 6; float loc[8]; float run = 0.f;
#pragma unroll
          for (int j = 0; j < 8; ++j) { run += CS[(seg * 8 + j) * 68 + k]; loc[j] = run; }
          SEG[seg * 64 + k] = run;
          __syncthreads();
          float off = 0.f;
          for (int s2 = 0; s2 < seg; ++s2) off += SEG[s2 * 64 + k];
#pragma unroll
          for (int j = 0; j < 8; ++j) CS[(seg * 8 + j) * 68 + k] = off + loc[j];
        }
        __syncthreads();
        {
            f32x4 kn4[2], kx4[2], b4[2], in_r[2], in_k[2], in_v[2];
            { const u32x2 r0 = {in_rb[0], in_rb[1]}, r1 = {in_rb[2], in_rb[3]}, q0 = {in_kb[0], in_kb[1]}, q1 = {in_kb[2], in_kb[3]}, w0 = {in_vb[0], in_vb[1]}, w1 = {in_vb[2], in_vb[3]};
              in_r[0] = bf4_to_f32(r0); in_r[1] = bf4_to_f32(r1); in_k[0] = bf4_to_f32(q0); in_k[1] = bf4_to_f32(q1); in_v[0] = bf4_to_f32(w0); in_v[1] = bf4_to_f32(w1); }
            {
                const f32x4 kk0 = *(const f32x4*)(k_k + h * 64 + k8), kk1 = *(const f32x4*)(k_k + h * 64 + k8 + 4), ka0 = *(const f32x4*)(k_a + h * 64 + k8), ka1 = *(const f32x4*)(k_a + h * 64 + k8 + 4);
                f32x4 q0 = in_k[0] * kk0, q1 = in_k[1] * kk1;
                float ss = q0[0] * q0[0] + q0[1] * q0[1] + q0[2] * q0[2] + q0[3] * q0[3] + q1[0] * q1[0] + q1[1] * q1[1] + q1[2] * q1[2] + q1[3] * q1[3];
                ss += __shfl_xor(ss, 1); ss += __shfl_xor(ss, 2); ss += __shfl_xor(ss, 4);
                const float inv = 1.f / fmaxf(sqrtf(ss), 1e-12f);
                kn4[0] = q0 * inv; kn4[1] = q1 * inv;
#pragma unroll
                for (int j = 0; j < 4; ++j) { kx4[0][j] = in_k[0][j] * (1.f + (in_a[0][j] - 1.f) * ka0[j]); kx4[1][j] = in_k[1][j] * (1.f + (in_a[1][j] - 1.f) * ka1[j]);
                    b4[0][j] = kn4[0][j] * in_a[0][j]; b4[1][j] = kn4[1][j] * in_a[1][j]; }
                if (z == 0) {
                    const f32x4 rk0 = *(const f32x4*)(r_kp + h * 64 + k8), rk1 = *(const f32x4*)(r_kp + h * 64 + k8 + 4);
                    float bn = 0.f;
#pragma unroll
                    for (int j = 0; j < 4; ++j) bn += in_r[0][j] * kx4[0][j] * rk0[j] + in_r[1][j] * kx4[1][j] * rk1[j];
                    bn += __shfl_xor(bn, 1); bn += __shfl_xor(bn, 2); bn += __shfl_xor(bn, 4);
                    if ((tid & 7) == 0) ((float*)(p->ws + WS_AFF))[(size_t)(cseq * 64 + tau) * 16 + h] = bn;
                }
            }
#pragma unroll
            for (int hh2 = 0; hh2 < 2; ++hh2) {
                const f32x4 cst = *(const f32x4*)(CS + tau * 68 + k8 + 4 * hh2);
                f32x4 csp = {0.f, 0.f, 0.f, 0.f}; if (tau > 0) csp = *(const f32x4*)(CS + (tau - 1) * 68 + k8 + 4 * hh2);
                const f32x4 m = *(const f32x4*)(CS + 31 * 68 + k8 + 4 * hh2), cl = *(const f32x4*)(CS + 63 * 68 + k8 + 4 * hh2);
                float at[4], bt[4], kt[4], rt[4], att4[4], bh4[4], kh4[4], vv4[4];
#pragma unroll
                for (int j = 0; j < 4; ++j) {
                    const int k = k8 + 4 * hh2 + j;
                    const float r = in_r[hh2][j], kx = kx4[hh2][j], kn = kn4[hh2][j], b = b4[hh2][j], v = in_v[hh2][j];
                    const float att = -kn * __expf(csp[j]); at[j] = -kn * __expf(csp[j] - m[j]);
                    const float e2 = __expf(m[j] - cst[j]); bt[j] = b * e2; kt[j] = kx * e2;
                    rt[j] = r * __expf(cst[j] - m[j]);
                    const float e4 = __expf(cl[j] - cst[j]);
                    att4[j] = att; bh4[j] = b * e4; kh4[j] = kx * e4; vv4[j] = v;
                    if (tau == 0) { PC[k] = __expf(cl[j]); EM[k] = __expf(m[j]); }
                }
                const int ob = (tau * RS + k8 + 4 * hh2) * 2;
#define RW_ST4(bufi, w) do { u32x2 o_ = {pk_bf16(w[0], w[1]), pk_bf16(w[2], w[3])}; *(u32x2*)(RBUFP(bufi) + ob) = o_; } while (0)
                RW_ST4(B_AT, at); RW_ST4(B_BT, bt); RW_ST4(B_KT, kt); RW_ST4(B_RT, rt);
                RW_ST4(B_MAK, att4); RW_ST4(B_TT, bh4); RW_ST4(B_NBRT, kh4); RW_ST4(B_W2, vv4);
#undef RW_ST4
            }
        }
        if (u + G < 8192) RW_LOAD(u + G);
        __syncthreads();
#pragma unroll 1
        for (int q = 0; q < 4; ++q) {
            const int it = tid + q * 512, k = it & 63, tp = it >> 6;
            const bf16_t* n0 = (const bf16_t*)RBUFP(B_MAK) + (2 * tp) * RS + k; const bf16_t* n1 = (const bf16_t*)RBUFP(B_TT) + (2 * tp) * RS + k;
            const bf16_t* n2 = (const bf16_t*)RBUFP(B_NBRT) + (2 * tp) * RS + k; const bf16_t* n3 = (const bf16_t*)RBUFP(B_W2) + (2 * tp) * RS + k;
            const unsigned w0 = (unsigned)n0[0] | ((unsigned)n0[RS] << 16), w1 = (unsigned)n1[0] | ((unsigned)n1[RS] << 16), w2 = (unsigned)n2[0] | ((unsigned)n2[RS] << 16), w3 = (unsigned)n3[0] | ((unsigned)n3[RS] << 16);
            ((unsigned*)RBUFP(B_ATT))[k * (RS / 2) + tp] = w0; ((unsigned*)RBUFP(B_BHT))[k * (RS / 2) + tp] = w1;
            ((unsigned*)RBUFP(B_KHT))[k * (RS / 2) + tp] = w2; ((unsigned*)RBUFP(B_VT))[k * (RS / 2) + tp] = w3;
        }
        __syncthreads();
        f32x4 nkr[2];
        {
            const Frag2 yA = rw_frag2(RBUFP(B_AT), yt, fr, fq), yK = rw_frag2(RBUFP(B_KT), yt, fr, fq), yR = rw_frag2(RBUFP(B_RT), yt, fr, fq);
#pragma unroll
            for (int a = 0; a < 2; ++a) {
                const int xt = 2 * xp + a;
                const Frag2 xB = rw_frag2(RBUFP(B_BT), xt, fr, fq), xA = rw_frag2(RBUFP(B_AT), xt, fr, fq), xK = rw_frag2(RBUFP(B_KT), xt, fr, fq);
                if (xt <= yt) {
                    const f32x4 d = rw_mm(xB, yA, zero4);
#pragma unroll
                    for (int i = 0; i < 4; ++i) { const int i_ = 16 * xt + 4 * fq + i, j_ = 16 * yt + fr; MF[i_ * 68 + j_] = (i_ < j_) ? d[i] : 0.f; }
                }
                {
                    f32x4 d = rw_mm(xA, yK, zero4);
#pragma unroll
                    for (int i = 0; i < 4; ++i) { const int l_ = 16 * xt + 4 * fq + i, i_ = 16 * yt + fr; d[i] = (i_ < l_) ? d[i] : 0.f; }
                    rw_store_t(RBUFP(B_MAK), xt, yt, d, fr, fq);
                }
                {
                    f32x4 d = rw_mm(xB, yR, zero4);
#pragma unroll
                    for (int i = 0; i < 4; ++i) { const int j_ = 16 * xt + 4 * fq + i, t_ = 16 * yt + fr; d[i] = (j_ <= t_) ? d[i] : 0.f; }
                    rw_store_t(RBUFP(B_NBRT), xt, yt, d, fr, fq);
                }
                {
                    f32x4 d = rw_mm(xK, yR, zero4);
#pragma unroll
                    for (int i = 0; i < 4; ++i) { const int i_ = 16 * xt + 4 * fq + i, t_ = 16 * yt + fr; d[i] = (i_ <= t_) ? d[i] : 0.f; }
                    nkr[a] = d;
                }
            }
        }
        __syncthreads();
#if RW_SIMPLE_INV
        if (wv == 0) {
            float t[64];
#pragma unroll
            for (int l = 0; l < 64; ++l) t[l] = (l == lane) ? 1.f : 0.f;
#pragma unroll
            for (int ii = 62; ii >= 0; --ii) { float acc = 0.f; asm volatile("" ::: "memory");
#pragma unroll
                for (int l = ii + 1; l < 64; ++l) acc += MF[ii * 68 + l] * t[l];
                t[ii] += acc; }
            char* row = RBUFP(B_TT) + (lane * RS) * 2;
#pragma unroll
            for (int g4 = 0; g4 < 16; ++g4) { u32x2 o; o[0] = pk_bf16(t[4 * g4], t[4 * g4 + 1]); o[1] = pk_bf16(t[4 * g4 + 2], t[4 * g4 + 3]); *(u32x2*)(row + g4 * 8) = o; }
        }
        __syncthreads();
#else
        if (wv == 0) {
            const int I = lane >> 4, jj = lane & 15; float t[16];
#pragma unroll
            for (int l = 0; l < 16; ++l) t[l] = (l == jj) ? 1.f : 0.f;
#pragma unroll
            for (int ii = 14; ii >= 0; --ii) { float acc = 0.f;
#pragma unroll
                for (int l = ii + 1; l < 16; ++l) acc += MF[(16 * I + ii) * 68 + 16 * I + l] * t[l];
                t[ii] += acc; }
#pragma unroll
            for (int ii = 0; ii < 16; ++ii) { MF[(16 * I + ii) * 68 + 16 * I + jj] = t[ii]; }
            char* row = RBUFP(B_TT) + ((16 * I + jj) * RS + 16 * I) * 2;
#pragma unroll
            for (int g4 = 0; g4 < 4; ++g4) { u32x2 o; o[0] = pk_bf16(t[4 * g4], t[4 * g4 + 1]); o[1] = pk_bf16(t[4 * g4 + 2], t[4 * g4 + 3]); *(u32x2*)(row + g4 * 8) = o; }
        } else if (wv >= 4) {
            for (int q = tid - 256; q < 768; q += 256) { const int blk = q >> 7, w = q & 127; const int J = blk < 3 ? 0 : blk < 5 ? 1 : 2; const int I = blk < 3 ? blk + 1 : blk < 5 ? blk - 1 : 3;
                ((unsigned*)RBUFP(B_TT))[(16 * J + (w >> 3)) * (RS / 2) + 8 * I + (w & 7)] = 0u; }
        }
        __syncthreads();
        if (wv == 1) rw_offdiag<1>(MF, RBUFP(B_TT), fr, fq); else if (wv == 2) rw_offdiag<2>(MF, RBUFP(B_TT), fr, fq); else if (wv == 3) rw_offdiag<3>(MF, RBUFP(B_TT), fr, fq);
        __syncthreads();
#endif
        {
            const Frag2 yAT = rw_frag2(RBUFP(B_ATT), yt, fr, fq), yM = rw_frag2(RBUFP(B_MAK), yt, fr, fq);
#pragma unroll
            for (int a = 0; a < 2; ++a) {
                const int xt = 2 * xp + a;
                const Frag2 xT = rw_frag2(RBUFP(B_TT), xt, fr, fq);
                rw_store_t(RBUFP(B_AT), xt, yt, rw_mm(xT, yAT, zero4), fr, fq);
                rw_store_t(RBUFP(B_W2), xt, yt, rw_mm(xT, yM, zero4), fr, fq);
            }
        }
        __syncthreads();
        {
            const Frag2 yB = rw_frag2(RBUFP(B_BHT), yt, fr, fq), yN = rw_frag2(RBUFP(B_NBRT), yt, fr, fq);
            f32x4 g[2], qe[2];
#pragma unroll
            for (int a = 0; a < 2; ++a) {
                const int kt = 2 * xp + a;
                const Frag2 x1 = rw_frag2(RBUFP(B_AT), kt, fr, fq);
                f32x4 d = rw_mm(x1, yB, zero4);
                if (kt == yt) {
#pragma unroll
                    for (int i = 0; i < 4; ++i) d[i] += (4 * fq + i == fr) ? PC[16 * kt + fr] : 0.f;
                }
                g[a] = d;
                const u32x2 rv = *(const u32x2*)(RBUFP(B_RT) + ((16 * yt + fr) * RS + 16 * kt + 4 * fq) * 2);
                f32x4 init = bf4_to_f32(rv); const f32x4 em = *(const f32x4*)(EM + 16 * kt + 4 * fq);
                init = init * em;
                qe[a] = rw_mm(x1, yN, init);
            }
            { const u32x2 qq = {pk4_fp8s(qe[0]), pk4_fp8s(qe[1])};
              { const u32x2 gq = {pk4_fp8s(g[0]), pk4_fp8s(g[1])}; *(u32x2*)(p->ws + R_GREC + uidx * 4096 + (yt * 64 + lane) * 16 + xp * 8) = gq; }
              *(u32x2*)((char*)REC + (yt * 64 + lane) * 16 + xp * 8) = qq; }
#pragma unroll
            for (int a = 0; a < 2; ++a) {
                const int it = 2 * xp + a;
                const Frag2 x2 = rw_frag2(RBUFP(B_W2), it, fr, fq);
                const u32x2 kv = *(const u32x2*)(RBUFP(B_KHT) + ((16 * yt + fr) * RS + 16 * it + 4 * fq) * 2);
                rw_store_t(RBUFP(B_BT), it, yt, rw_mm(x2, yB, bf4_to_f32(kv)), fr, fq);
                rw_store_t(RBUFP(B_KT), it, yt, rw_mm(x2, yN, nkr[a]), fr, fq);
            }
        }
        if (u < RW_CVT_TILES) cv1_to_lds(cvq, (float*)(smem + RW_CVT));
        __syncthreads();
        {
            const Frag2 fV = rw_frag2(RBUFP(B_VT), yt, fr, fq);
            f32x4 hd[2], yd[2];
#pragma unroll
            for (int a = 0; a < 2; ++a) {
                const Frag2 fX = rw_frag2(RBUFP(B_BT), 2 * xp + a, fr, fq), fZ = rw_frag2(RBUFP(B_KT), 2 * xp + a, fr, fq);
                hd[a] = rw_mm(fX, fV, zero4);
                yd[a] = rw_mm(fV, fZ, zero4);
            }
            { const u32x2 hq = {pk4_fp8s(hd[0]), pk4_fp8s(hd[1])}; *(u32x2*)((char*)REC + ((4 + yt) * 64 + lane) * 16 + xp * 8) = hq; }
            REC[(8 + yt * 2 + xp) * 64 + lane] = pk8(yd[0], yd[1]);
        }
        if (u < RW_CVT_TILES) cv1_store(p, 1, 0, u, (const float*)(smem + RW_CVT));
        __syncthreads();
    }
#undef RW_LOAD
#undef RBUFP
}
constexpr int RW2_SLOT = 8192, RW2_NS = 17;
__device__ __forceinline__ void phase_rwkv_state_scan(KP p, char* smem) {
    const int bid = blockIdx.x, G = gridDim.x, tid = tid_(), lane = tid & 63;
    const int wvu = __builtin_amdgcn_readfirstlane(tid >> 6);
    for (int ch = bid; ch < 32; ch += G) {
        unsigned char* srec0 = p->ws + R_SREC + (size_t)ch * 256 * 8192;
        const unsigned char* grec0 = p->ws + R_GREC + (size_t)ch * 256 * 4096 + lane * 16; const unsigned char* hrec0 = rw_rec(p->ws, (size_t)ch * 256) + lane * 16;
#define RW_DMA(cc) do { char* dst_ = smem + ((cc) % RW2_NS) * RW2_SLOT; \
        _Pragma("unroll") for (int q_ = 0; q_ < 2; ++q_) { const int j_ = (wvu - 4) * 2 + q_; \
            const unsigned char* src_ = j_ < 4 ? grec0 + (size_t)(cc) * 4096 + j_ * 1024 : hrec0 + (size_t)(cc) * 16384 + j_ * 1024; \
            __builtin_amdgcn_global_load_lds((const unsigned*)src_, (unsigned LAS*)(dst_ + j_ * 1024), 16, 0, 0); } } while (0)
#define RW_RD(cc, R) do { const u32x4* sl_ = (const u32x4*)(smem + ((cc) % RW2_NS) * RW2_SLOT) + lane; \
        _Pragma("unroll") for (int i_ = 0; i_ < 4; ++i_) R[i_] = sl_[i_ * 64]; R[4] = sl_[(4 + wvu) * 64]; } while (0)
        __syncthreads();
        if (wvu >= 4) {
#pragma unroll
            for (int cc = 0; cc < RW2_NS; ++cc) RW_DMA(cc);
            asm volatile("s_waitcnt vmcnt(32)" ::: "memory");
            __builtin_amdgcn_s_barrier();
#pragma unroll 1
            for (int c = 0; c < 256; ++c) {
                if (c < 255) { const int yg = 254 - c < RW2_NS - 2 ? 254 - c : RW2_NS - 2;
                    if (yg == 15) asm volatile("s_waitcnt vmcnt(30)" ::: "memory"); else if (yg == 14) asm volatile("s_waitcnt vmcnt(28)" ::: "memory"); else if (yg == 13) asm volatile("s_waitcnt vmcnt(26)" ::: "memory"); else if (yg == 12) asm volatile("s_waitcnt vmcnt(24)" ::: "memory"); else if (yg == 11) asm volatile("s_waitcnt vmcnt(22)" ::: "memory"); else if (yg == 10) asm volatile("s_waitcnt vmcnt(20)" ::: "memory"); else if (yg == 9) asm volatile("s_waitcnt vmcnt(18)" ::: "memory"); else if (yg == 8) asm volatile("s_waitcnt vmcnt(16)" ::: "memory"); else if (yg == 7) asm volatile("s_waitcnt vmcnt(14)" ::: "memory"); else if (yg == 6) asm volatile("s_waitcnt vmcnt(12)" ::: "memory"); else if (yg == 5) asm volatile("s_waitcnt vmcnt(10)" ::: "memory"); else if (yg == 4) asm volatile("s_waitcnt vmcnt(8)" ::: "memory"); else if (yg == 3) asm volatile("s_waitcnt vmcnt(6)" ::: "memory"); else if (yg == 2) asm volatile("s_waitcnt vmcnt(4)" ::: "memory"); else if (yg == 1) asm volatile("s_waitcnt vmcnt(2)" ::: "memory"); else asm volatile("s_waitcnt vmcnt(0)" ::: "memory"); }
                __builtin_amdgcn_s_barrier();
                asm volatile("" ::: "memory");
                if (c + RW2_NS < 256) RW_DMA(c + RW2_NS);
            }
        } else {
#define RW_STEP(c, CUR, NXT) do { \
            asm volatile("s_waitcnt lgkmcnt(0)" ::: "memory"); \
            __builtin_amdgcn_s_barrier(); \
            asm volatile("" ::: "memory"); \
            if ((c) < 255) RW_RD((c) + 1, NXT); \
            u32x4 sfu0_ = {pk_bf16(sacc[0][0] * 0.125f, sacc[0][1] * 0.125f), pk_bf16(sacc[0][2] * 0.125f, sacc[0][3] * 0.125f), pk_bf16(sacc[1][0] * 0.125f, sacc[1][1] * 0.125f), pk_bf16(sacc[1][2] * 0.125f, sacc[1][3] * 0.125f)}; \
            u32x4 sfu1_ = {pk_bf16(sacc[2][0] * 0.125f, sacc[2][1] * 0.125f), pk_bf16(sacc[2][2] * 0.125f, sacc[2][3] * 0.125f), pk_bf16(sacc[3][0] * 0.125f, sacc[3][1] * 0.125f), pk_bf16(sacc[3][2] * 0.125f, sacc[3][3] * 0.125f)}; \
            { u32x4* sr_ = (u32x4*)(srec0 + (size_t)(c) * 8192 + wvu * 2048); sr_[lane] = sfu0_; sr_[64 + lane] = sfu1_; } \
            const bf16x8 sf0_ = __builtin_bit_cast(bf16x8, sfu0_), sf1_ = __builtin_bit_cast(bf16x8, sfu1_); \
            _Pragma("unroll") for (int mt = 0; mt < 4; ++mt) { \
                const f32x2_t ha_ = __builtin_amdgcn_cvt_pk_f32_fp8((int)CUR[4][mt], false), hb_ = __builtin_amdgcn_cvt_pk_f32_fp8((int)CUR[4][mt], true); \
                f32x4 s2_ = {ha_[0] * 0.125f, ha_[1] * 0.125f, hb_[0] * 0.125f, hb_[1] * 0.125f};         \
                s2_ = mfma16(fp8x8_to_bf16(CUR[mt][0], CUR[mt][1]), sf0_, s2_);         \
                s2_ = mfma16(fp8x8_to_bf16(CUR[mt][2], CUR[mt][3]), sf1_, s2_); \
                sacc[mt] = s2_; } } while (0)
            __builtin_amdgcn_s_barrier();
            asm volatile("" ::: "memory");
            u32x4 ra[5], rb[5];
            RW_RD(0, ra);
            f32x4 sacc[4];
#pragma unroll
            for (int mt = 0; mt < 4; ++mt) sacc[mt] = (f32x4){0.f, 0.f, 0.f, 0.f};
#pragma unroll 1
            for (int c = 0; c < 256; c += 2) { RW_STEP(c, ra, rb); RW_STEP(c + 1, rb, ra); }
#undef RW_STEP
        }
        asm volatile("s_waitcnt vmcnt(0)" ::: "memory");
        __syncthreads();
#undef RW_DMA
#undef RW_RD
    }
}
__device__ __forceinline__ void phase_rwkv_post(KP p, char* smem) {
    const int bid = blockIdx.x, G = gridDim.x;
    const bf16_t* VV = (const bf16_t*)(p->ws + R_VV); const bf16_t* GG = (const bf16_t*)(p->ws + R_G); bf16_t* YG = (bf16_t*)(p->ws + R_YG);
    const float* ln_w = p->in[22]; const float* ln_b = p->in[23]; const float* BN = (const float*)(p->ws + WS_AFF);
    float* YS = (float*)smem;
    u32x4 a_sf0[2], a_sf1[2], a_yl[2], a_qa[2], a_qb[2];
#define PO_LOAD(uu) do { const int cs_ = (uu) >> 4, h_ = (uu) & 15; const int tl_ = tid_(), ln_ = tl_ & 63, wv_ = tl_ >> 6, vt_ = wv_ & 3, xp_ = wv_ >> 2; \
        _Pragma("unroll") for (int z_ = 0; z_ < 2; ++z_) { const size_t ui_ = (size_t)(z_ * 16 + h_) * 256 + (z_ ? 255 - cs_ : cs_); \
            const unsigned char* rec_ = rw_rec(p->ws, ui_) + ln_ * 16; const unsigned char* sr_ = p->ws + R_SREC + ui_ * 8192 + vt_ * 2048 + ln_ * 16; \
            a_sf0[z_] = *(const u32x4*)sr_; a_sf1[z_] = *(const u32x4*)(sr_ + 1024); a_yl[z_] = *(const u32x4*)(rec_ + (8 + vt_ * 2 + xp_) * 1024); \
            a_qa[z_] = *(const u32x4*)(rec_ + (2 * xp_) * 1024); a_qb[z_] = *(const u32x4*)(rec_ + (1 + 2 * xp_) * 1024); } } while (0)
    if (bid < 4096) PO_LOAD(bid);
    for (int u = bid; u < 4096; u += G) {
        const int cseq = u >> 4, h = u & 15;
        const int tl = tid_(), lane = tl & 63, wv = tl >> 6, fr = lane & 15, fq = lane >> 4, vt = wv & 3, xp = wv >> 2;
        const int c4 = (tl & 15) * 4, cc = h * 64 + c4;
        u32x2 vv[2], gg[2]; float bnq[2];
#pragma unroll
        for (int q = 0; q < 2; ++q) { const int tok = cseq * 64 + (tl >> 4) + q * 32; const size_t o = (size_t)tok * 1024 + cc;
            vv[q] = *(const u32x2*)(VV + o); gg[q] = *(const u32x2*)(GG + o); bnq[q] = BN[(size_t)tok * 16 + h]; }
        const f32x4 lwq = *(const f32x4*)(ln_w + cc), lbq = *(const f32x4*)(ln_b + cc);
#pragma unroll
        for (int z = 0; z < 2; ++z) {
            const bf16x8 sf0 = __builtin_bit_cast(bf16x8, a_sf0[z]), sf1 = __builtin_bit_cast(bf16x8, a_sf1[z]);
#pragma unroll
            for (int a = 0; a < 2; ++a) {
                const u32x2 yi = {a_yl[z][2 * a], a_yl[z][2 * a + 1]}; const u32x4 q8 = a ? a_qb[z] : a_qa[z];
                f32x4 y = bf4_to_f32(yi);
                y = mfma16(sf0, fp8x8_to_bf16(q8[0], q8[1]), y);
                y = mfma16(sf1, fp8x8_to_bf16(q8[2], q8[3]), y);
                const int tau = 16 * (2 * xp + a) + fr, sl = z ? 63 - tau : tau;
                *(f32x4*)(YS + (z * 64 + sl) * 68 + 16 * vt + 4 * fq) = y;
            }
        }
        if (u + G < 4096) PO_LOAD(u + G);
        __syncthreads();
#pragma unroll
        for (int q = 0; q < 2; ++q) {
            const int sl = (tl >> 4) + q * 32; const size_t o = (size_t)(cseq * 64 + sl) * 1024 + cc;
            const f32x4 y = *(const f32x4*)(YS + sl * 68 + c4) + *(const f32x4*)(YS + (64 + sl) * 68 + c4);
            float sm = y[0] + y[1] + y[2] + y[3];
            sm += __shfl_xor(sm, 1); sm += __shfl_xor(sm, 2); sm += __shfl_xor(sm, 4); sm += __shfl_xor(sm, 8);
            const float mean = sm * (1.f / 64.f);
            const f32x4 dlt = y - mean;
            float vs = dlt[0] * dlt[0] + dlt[1] * dlt[1] + dlt[2] * dlt[2] + dlt[3] * dlt[3];
            vs += __shfl_xor(vs, 1); vs += __shfl_xor(vs, 2); vs += __shfl_xor(vs, 4); vs += __shfl_xor(vs, 8);
            const float rs = rsqrtf(vs * (1.f / 64.f) + 64e-5f);
            const f32x4 v = bf4_to_f32(vv[q]); const float bn = bnq[q];
            const float g0 = bf_lo(gg[q][0]), g1 = bf_hi(gg[q][0]), g2 = bf_lo(gg[q][1]), g3 = bf_hi(gg[q][1]);
            f32x4 out;
#pragma unroll
            for (int j = 0; j < 4; ++j) out[j] = dlt[j] * rs * lwq[j] + lbq[j] + bn * v[j];
            u32x2 w; w[0] = pk_bf16(out[0] * g0, out[1] * g1); w[1] = pk_bf16(out[2] * g2, out[3] * g3);
            *(u32x2*)(YG + o) = w;
        }
        __syncthreads();
    }
#undef PO_LOAD
}

__global__ void __launch_bounds__(NTHR, 2) fwd_kernel(Params p_) {
    KP p = (KP)__builtin_amdgcn_kernarg_segment_ptr();
    extern __shared__ __attribute__((aligned(16))) char smem[];
    __shared__ uint4 xb_words;
    const int lo = p_.lo, hi = p_.hi;
    const bool multi = (hi - lo) > 1;
    XcdBarrier bar; bar.bar = (unsigned*)(p->ws + WS_BAR); bar.x = 0; bar.st = (volatile LAS unsigned*)&xb_words;
    if (multi) {
        if (tid_() == 0) xb_words = make_uint4(0u, 0u, 0u, 0u);
        __syncthreads();
        bar = xcd_barrier_post((unsigned*)(p->ws + WS_BAR), (volatile LAS unsigned*)&xb_words);
    }
#if defined(PHASE_MASK)
#define IN(k) (((PHASE_MASK >> (k)) & 1) && lo <= (k) && (k) < hi)
#elif defined(ONLY_PHASE)
#define IN(k) ((k) == ONLY_PHASE && lo <= (k) && (k) < hi)
#else
#define IN(k) (lo <= (k) && (k) < hi)
#endif
#define SEAM(k) do { if (IN(k) && IN((k) + 1)) xcd_barrier(bar); asm volatile("" : "+s"(p) :: "memory"); } while (0)
#define XA ((float*)(p->ws + WS_XA))
#define XB ((float*)(p->ws + WS_XB))

    if (IN(0)) { phase_prologue(p, smem); } SEAM(0);
    if (IN(1)) {
        EpiProj E{(bf16_t*)(p->ws + A_Q), (bf16_t*)(p->ws + A_V), (bf16_t*)(p->ws + A_KF), (bf16_t*)(p->ws + A_AQ), (bf16_t*)(p->ws + A_AK), (bf16_t*)(p->ws + A_AV), (float*)(p->ws + A_LOGF), (bf16_t*)(p->ws + A_GATE), (const float*)(p->ws + WS_LB)};
        int pre = 0;
        for (int L = blockIdx.x; L < 64 * 16; L += gridDim.x) { int pm, pn; tile_order(L, 64, 16, pm, pn);
            const int Ln = L + gridDim.x; GemmNext nx{(const bf16_t*)(p->ws + A_H0), (const bf16_t*)(p->ws + WS_WT_IN), nullptr, 0, 0, Ln < 64 * 16 ? 1 : 0};
            if (nx.valid) { int pm2, pn2; tile_order(Ln, 64, 16, pm2, pn2); nx.brow = pm2 * 256; nx.bcol = pn2 * 256; }
            gemm_tile((const bf16_t*)(p->ws + A_H0), (const bf16_t*)(p->ws + WS_WT_IN), 1024, pm * 256, pn * 256, (bf16_t*)smem, E, nullptr, pre, nx); pre = nx.valid; }
    } SEAM(1);
    if (IN(2)) { phase_hgrn_local(p, smem); phase_attention(p, smem); } SEAM(2);
    if (IN(3)) { phase_hgrn_scan(p); phase_attn_merge(p); } SEAM(3);
    if (IN(4)) { phase_hgrn_out(p, smem); } SEAM(4);
    if (IN(5)) {
        EpiResid E{p->in[0], XA, (bf16_t*)(p->ws + M_HB)};
        for (int L = blockIdx.x; L < 64 * 4; L += gridDim.x) { int pm, pn; tile_order(L, 64, 4, pm, pn);
            gemm_tile((const bf16_t*)(p->ws + A_YAB), (const bf16_t*)(p->ws + WS_WT_OUT), 1024, pm * 256, pn * 256, (bf16_t*)smem, E); }
    } SEAM(5);
    if (IN(6)) { phase_moe_router(p, 0, XA, smem); } SEAM(6);
    if (IN(7)) { phase_moe_select(p, smem);
        { int cb = (int)blockIdx.x - 16, cG = (int)gridDim.x - 16; if (cG <= 0) { cb = blockIdx.x; cG = gridDim.x; }
          if (cb >= 0) { int rot = 0; __syncthreads(); cvt_moe_layer(p, 0, 12, 16, rot, cb, cG, (float*)smem); } }
    } SEAM(7);
    if (IN(9)) { moe_gemms_gateup(p, smem); } SEAM(9);
    if (IN(10)) { moe_gemms_down(p, smem); } SEAM(10);
    if (IN(11)) { phase_combine_mix(p, XA, XB, p->in[7], smem); } SEAM(11);
    if (IN(13)) {
        const bf16_t* MIX = (const bf16_t*)(p->ws + R_MIX);
        int pre = 0;
        for (int L = blockIdx.x; L < 1024; L += gridDim.x) {
            EpiRkvLora E; const bf16_t* Ap; const bf16_t* Bp; int pm, pn;
            if (L < 768) { const int job = L >> 8; tile_order(L & 255, 64, 4, pm, pn);
                E.isl = 0; E.outb = (bf16_t*)(p->ws + (job == 0 ? R_RR : job == 1 ? R_KK : R_VV)); E.out = nullptr; E.al = E.be = E.ga = E.de = 0.f;
                Ap = MIX + (size_t)job * S * 1024; Bp = (const bf16_t*)(p->ws + WS_WT_RKV) + (size_t)job * 1024 * 1024; }
            else { const int job = (L - 768) >> 6; pm = (L - 768) & 63; pn = 0;
                const int mi = job == 0 ? 5 : job == 1 ? 6 : job == 2 ? 3 : 4;
                E.isl = 1; E.outb = nullptr; E.out = (bf16_t*)(p->ws + R_L1O) + (size_t)job * S * 128;
                E.al = job < 2 ? 2.f : job == 2 ? 0.f : 1.f; E.be = job < 2 ? 2.f : 1.f; E.ga = job < 2 ? -1.f : 0.f; E.de = job == 2 ? 1.f : 0.f;
                Ap = MIX + (size_t)mi * S * 1024; Bp = (const bf16_t*)(p->ws + WS_WT_L1) + (size_t)job * 256 * 1024; }
            const int Ln = L + gridDim.x; GemmNext nx{nullptr, nullptr, nullptr, 0, 0, Ln < 1024 ? 1 : 0};
            if (nx.valid) {
                if (Ln < 768) { const int job2 = Ln >> 8; int pm2, pn2; tile_order(Ln & 255, 64, 4, pm2, pn2);
                    nx.A = MIX + (size_t)job2 * S * 1024; nx.Bt = (const bf16_t*)(p->ws + WS_WT_RKV) + (size_t)job2 * 1024 * 1024; nx.brow = pm2 * 256; nx.bcol = pn2 * 256; }
                else { const int job2 = (Ln - 768) >> 6; const int mi2 = job2 == 0 ? 5 : job2 == 1 ? 6 : job2 == 2 ? 3 : 4;
                    nx.A = MIX + (size_t)mi2 * S * 1024; nx.Bt = (const bf16_t*)(p->ws + WS_WT_L1) + (size_t)job2 * 256 * 1024; nx.brow = ((Ln - 768) & 63) * 256; nx.bcol = 0; }
            }
            gemm_tile(Ap, Bp, 1024, pm * 256, pn * 256, (bf16_t*)smem, E, nullptr, pre, nx); pre = nx.valid;
        }
    } SEAM(13);
    if (IN(14)) {
        int pre = 0;
        for (int L = blockIdx.x; L < 4 * 256; L += gridDim.x) { const int job = L >> 8; int pm, pn; tile_order(L & 255, 64, 4, pm, pn);
            const int Ln = L + gridDim.x; GemmNext nx{nullptr, nullptr, nullptr, 0, 0, Ln < 4 * 256 ? 1 : 0};
            if (nx.valid) { const int job2 = Ln >> 8; int pm2, pn2; tile_order(Ln & 255, 64, 4, pm2, pn2);
                nx.A = (const bf16_t*)(p->ws + R_L1O) + (size_t)job2 * S * 128; nx.Bt = (const bf16_t*)(p->ws + WS_WT_L2) + (size_t)job2 * 1024 * 128; nx.brow = pm2 * 256; nx.bcol = pn2 * 256; }
            EpiLora2 E;
            if (job < 2) { E.isg = 0; E.scale = -0.6065306597126334f; E.bias = p->in[11] + job * 1024; E.outb = (bf16_t*)(p->ws + R_LOGW) + (size_t)job * S * 1024; }
            else if (job == 2) { E.isg = 0; E.scale = 1.f; E.bias = p->in[14]; E.outb = (bf16_t*)(p->ws + R_AA); }
            else { E.isg = 1; E.scale = 0.f; E.bias = p->in[14]; E.outb = (bf16_t*)(p->ws + R_G); }
            gemm_tile((const bf16_t*)(p->ws + R_L1O) + (size_t)job * S * 128, (const bf16_t*)(p->ws + WS_WT_L2) + (size_t)job * 1024 * 128, 128, pm * 256, pn * 256, (bf16_t*)smem, E, nullptr, pre, nx); pre = nx.valid; }
    } SEAM(14);
    if (IN(16)) { phase_rwkv_chunk_local(p, smem); } SEAM(16);
    if (IN(17)) {
        phase_rwkv_state_scan(p, smem);
        int cb = (int)blockIdx.x - 32, cG = (int)gridDim.x - 32; if (cG <= 0) { cb = blockIdx.x; cG = gridDim.x; }
        if (cb >= 0) { int rot = 0; __syncthreads(); cvt_moe_layer(p, 1, 4, 12, rot, cb, cG, (float*)smem); }
    } SEAM(17);
    if (IN(18)) { phase_rwkv_post(p, smem); } SEAM(18);
    if (IN(19)) {
        EpiResid E{XB, XA, (bf16_t*)(p->ws + M_HB)};
        for (int L = blockIdx.x; L < 64 * 4; L += gridDim.x) { int pm, pn; tile_order(L, 64, 4, pm, pn);
            gemm_tile((const bf16_t*)(p->ws + R_YG), (const bf16_t*)(p->ws + WS_WT_COUT), 1024, pm * 256, pn * 256, (bf16_t*)smem, E); }
    } SEAM(19);
    if (IN(20)) { phase_moe_router(p, 1, XA, smem); } SEAM(20);
    if (IN(21)) { phase_moe_select(p, smem);
        { int cb = (int)blockIdx.x - 16, cG = (int)gridDim.x - 16; if (cG <= 0) { cb = blockIdx.x; cG = gridDim.x; }
          if (cb >= 0) { int rot = 0; __syncthreads(); cvt_moe_layer(p, 1, 12, 16, rot, cb, cG, (float*)smem); } }
    } SEAM(21);
    if (IN(23)) { moe_gemms_gateup(p, smem); } SEAM(23);
    if (IN(24)) { moe_gemms_down(p, smem); } SEAM(24);
    if (IN(25)) { phase_moe_combine(p, XA, nullptr, p->in[30], p->out); }
#undef IN
#undef SEAM
#undef XA
#undef XB
}

extern "C" void kernel_launch(void* const* d_in, const int* in_sizes, int n_in, void* d_out, int out_size, void* d_ws, size_t ws_size, hipStream_t stream) {
    static int grid = 0;
    if (grid == 0) {
        if (n_in != 31 || ws_size < WS_END) { fprintf(stderr, "kernel_launch: unexpected n_in %d or ws_size %zu (< %zu)\n", n_in, ws_size, (size_t)WS_END); grid = -1; return; }
        int dev = 0, cus = 0;
        if (hipGetDevice(&dev) != hipSuccess || hipDeviceGetAttribute(&cus, hipDeviceAttributeMultiprocessorCount, dev) != hipSuccess) { grid = -1; return; }
        if (hipFuncSetAttribute((const void*)fwd_kernel, hipFuncAttributeMaxDynamicSharedMemorySize, LDS_BYTES) != hipSuccess) { fprintf(stderr, "kernel_launch: hipFuncSetAttribute failed\n"); grid = -1; return; }
        int per_cu = 0;
        if (hipOccupancyMaxActiveBlocksPerMultiprocessor(&per_cu, (const void*)fwd_kernel, NTHR, LDS_BYTES) != hipSuccess || per_cu < 1) fprintf(stderr, "kernel_launch: occupancy query says %d\n", per_cu);
        (void)hipGetLastError();
        grid = cus;
    }
    if (grid < 0) return;
    (void)hipMemsetAsync((char*)d_ws + WS_BAR, 0, 16384, stream);
    Params p{};
    for (int i = 0; i < 31; ++i) p.in[i] = (const float*)d_in[i];
    p.out = (float*)d_out; p.ws = (unsigned char*)d_ws;
    if (PROBE_LO >= 0) {
        const int cuts[4] = {0, PROBE_HI, PROBE_LO, NPH}; const int ends[3] = {PROBE_HI, PROBE_HI, NPH};
        for (int li = 0; li < 3; ++li) { p.lo = cuts[li == 0 ? 0 : li == 1 ? 2 : 1]; p.hi = ends[li];
            if (li) (void)hipMemsetAsync((char*)d_ws + WS_BAR, 0, XCD_BAR_WORDS * sizeof(unsigned), stream);
            if (p.lo < p.hi) hipLaunchKernelGGL(fwd_kernel, dim3(grid), dim3(NTHR), LDS_BYTES, stream, p); }
    } else if (kSingleLaunch) {
        p.lo = 0; p.hi = NPH;
        hipLaunchKernelGGL(fwd_kernel, dim3(grid), dim3(NTHR), LDS_BYTES, stream, p);
    } else {
        for (int ph = 0; ph < NPH; ++ph) { p.lo = ph; p.hi = ph + 1; hipLaunchKernelGGL(fwd_kernel, dim3(grid), dim3(NTHR), LDS_BYTES, stream, p); }
    }
}
```

```cpp
#include <hip/hip_runtime.h>
#include <cstdio>
#include <cstdint>

#define XB_TMO      128
#define XB_XCNT(j)  (256  + 64 * (j))
#define XB_XSUB(j)  (1280 + 64 * (j))
#define XB_XGEN(j)  (2304 + 64 * (j))
#define XB_TOP      3328
#define XB_TOPGEN   3392
#define XCD_BAR_WORDS 3456
#define XB_SPIN_CAP (1u << 22)
#define LAS __attribute__((address_space(3)))

__device__ __forceinline__ unsigned xb_ld(unsigned* p)              { return __hip_atomic_load(p, __ATOMIC_RELAXED, __HIP_MEMORY_SCOPE_AGENT); }
__device__ __forceinline__ unsigned xb_add(unsigned* p, unsigned v) { return __hip_atomic_fetch_add(p, v, __ATOMIC_RELAXED, __HIP_MEMORY_SCOPE_AGENT); }
__device__ __forceinline__ unsigned xb_xcc_id() { return (unsigned)__builtin_amdgcn_s_getreg((3 << 11) | 20) & 0xFu; }
#define XB_SPIN(cond, bar) do { unsigned _sp = 0; while (cond) { __builtin_amdgcn_s_sleep(1); \
    if ((++_sp & 255u) == 0u) { if (xb_ld(&(bar)[XB_TMO])) break; if (_sp > XB_SPIN_CAP) { atomicAdd(&(bar)[XB_TMO], 1u); break; } } } } while (0)

struct XcdBarrier { unsigned* bar; unsigned x; volatile LAS unsigned* st; };

__device__ __forceinline__ XcdBarrier xcd_barrier_post(unsigned* bar, volatile LAS unsigned* st) {
    XcdBarrier b; b.bar = bar; b.x = xb_xcc_id(); b.st = st;
    if (threadIdx.x == 0) (void)xb_add(&bar[XB_XCNT(b.x)], 1u);
    return b;
}
__device__ __forceinline__ void xcd_barrier_complete(unsigned* bar, unsigned x, unsigned& nloc, unsigned& nx) {
    const unsigned G = gridDim.x * gridDim.y * gridDim.z;
    unsigned sum, cnt, mine, sp = 0u;
    for (;;) {
        sum = 0u; cnt = 0u; mine = 0u;
#pragma unroll
        for (unsigned j = 0; j < 16; ++j) { const unsigned c = xb_ld(&bar[XB_XCNT(j)]); sum += c; cnt += (c > 0u) ? 1u : 0u; mine = (j == x) ? c : mine; }
        if (sum == G) break;
        __builtin_amdgcn_s_sleep(1);
        if ((++sp & 255u) == 0u) { if (xb_ld(&bar[XB_TMO])) break; if (sp > XB_SPIN_CAP) { atomicAdd(&bar[XB_TMO], 1u); break; } }
    }
    nloc = mine > 0u ? mine : 1u; nx = cnt > 0u ? cnt : 1u;
}
__device__ __forceinline__ void xcd_barrier(const XcdBarrier& b) {
    asm volatile("s_waitcnt vmcnt(0)" ::: "memory");
    __syncthreads();
    if (threadIdx.x == 0) {
        unsigned* bar = b.bar;
        __builtin_amdgcn_s_waitcnt(0);
        unsigned nloc = b.st[0], nx = b.st[1];
        if (nloc == 0u) { xcd_barrier_complete(bar, b.x, nloc, nx); b.st[0] = nloc; b.st[1] = nx; }
        const unsigned old = xb_add(&bar[XB_XSUB(b.x)], 1u);
        const unsigned gen = old / nloc;
        if (old + 1u == (gen + 1u) * nloc) {
            __builtin_amdgcn_fence(__ATOMIC_RELEASE, "agent");
            asm volatile("s_waitcnt vmcnt(0)" ::: "memory");
            const unsigned og = xb_add(&bar[XB_TOP], 1u);
            const unsigned tg = og / nx;
            if (og + 1u == (tg + 1u) * nx) xb_add(&bar[XB_TOPGEN], 1u);
            else XB_SPIN(xb_ld(&bar[XB_TOPGEN]) == tg, bar);
            __builtin_amdgcn_fence(__ATOMIC_ACQUIRE, "agent");
            xb_add(&bar[XB_XGEN(b.x)], 1u);
            asm volatile("s_waitcnt vmcnt(0)" ::: "memory");
        } else {
            XB_SPIN(xb_ld(&bar[XB_XGEN(b.x)]) == gen, bar);
            __builtin_amdgcn_fence(__ATOMIC_ACQUIRE, "agent");
            asm volatile("s_waitcnt vmcnt(0)" ::: "memory");
        }
    }
    __syncthreads();
}

typedef unsigned short bf16_t;
typedef short bf16x8 __attribute__((ext_vector_type(8)));
typedef float f32x4 __attribute__((ext_vector_type(4)));
typedef unsigned u32x2 __attribute__((ext_vector_type(2)));
typedef unsigned u32x4 __attribute__((ext_vector_type(4)));
typedef int v8i_t __attribute__((ext_vector_type(8)));

constexpr int S = 16384, D = 1024;
constexpr int NTHR = 512;
constexpr int LDS_BYTES = 147456;
constexpr int NPH = 26;
constexpr bool kSingleLaunch = true;
#ifndef PROBE_LO
#define PROBE_LO -1
#define PROBE_HI -1
#endif

typedef __bf16 bf2_t __attribute__((ext_vector_type(2)));
__device__ __forceinline__ unsigned pk_bf16(float lo, float hi) { bf2_t v = {(__bf16)lo, (__bf16)hi}; return __builtin_bit_cast(unsigned, v); }
__device__ __forceinline__ unsigned pk4_fp8(float a, float b, float c, float d) { int w = __builtin_amdgcn_cvt_pk_fp8_f32(a, b, 0, false); w = __builtin_amdgcn_cvt_pk_fp8_f32(c, d, w, true); return (unsigned)w; }
__device__ __forceinline__ float bf_lo(unsigned u) { return __uint_as_float(u << 16); }
__device__ __forceinline__ float bf_hi(unsigned u) { return __uint_as_float(u & 0xffff0000u); }
__device__ __forceinline__ float bf2f(bf16_t b) { return __uint_as_float(((unsigned)b) << 16); }
__device__ __forceinline__ f32x4 bf4_to_f32(u32x2 v) { f32x4 r = {bf_lo(v[0]), bf_hi(v[0]), bf_lo(v[1]), bf_hi(v[1])}; return r; }
__device__ __forceinline__ float wave_sum(float x) {
#pragma unroll
    for (int o = 32; o >= 1; o >>= 1) x += __shfl_xor(x, o);
    return x;
}
__device__ __forceinline__ float sigmoidf_(float z) { return __builtin_amdgcn_rcpf(1.f + __expf(-z)); }
__device__ __forceinline__ f32x4 mfma16(bf16x8 a, bf16x8 b, f32x4 c) { return __builtin_amdgcn_mfma_f32_16x16x32_bf16(a, b, c, 0, 0, 0); }

constexpr size_t MiB = 1ull << 20;
constexpr size_t WS_WT_IN = 0, WS_WT_OUT = 8 * MiB, WS_WT_RKV = 10 * MiB, WS_WT_COUT = 16 * MiB, WS_WT_L1 = 18 * MiB, WS_WT_L2 = 20 * MiB;
constexpr size_t WS_BT_GU = 22 * MiB, WS_BT_DN = 150 * MiB, WS_SMALL = 214 * MiB;
constexpr size_t WS_BAR = WS_SMALL, WS_LB = WS_SMALL + 16384, WS_BIAS = WS_SMALL + 20480, WS_DTOT = WS_SMALL + 65536;
constexpr size_t WS_AFF = WS_DTOT + MiB, WS_SLOT = WS_AFF + MiB, WS_IDX = WS_SLOT + MiB, WS_GATEW = WS_IDX + 131072, WS_ATTL = WS_GATEW + 131072;
constexpr size_t WS_RSTD = WS_SMALL + 5 * MiB, WS_RSTDE = WS_RSTD + 65536;
constexpr size_t WS_XA = 222 * MiB, WS_XB = 286 * MiB, WS_ACT = 350 * MiB;
constexpr size_t HH = 32 * MiB;
constexpr size_t WS_END = WS_ACT + 21 * HH;
constexpr size_t A_H0 = WS_ACT, A_Q = WS_ACT + HH, A_V = WS_ACT + HH + HH / 2, A_KF = WS_ACT + 2 * HH, A_LOGF = WS_ACT + 3 * HH, A_GATE = WS_ACT + 5 * HH;
constexpr size_t A_AQ = WS_ACT + 6 * HH, A_AK = A_AQ + HH / 2, A_AV = A_AK + HH / 2, A_YAB = A_AV + HH / 2, A_U = A_YAB + HH, A_SC = A_U + 4 * HH, A_ATTO = A_SC + 2 * HH;
constexpr size_t M_HB = WS_ACT, M_XE = WS_ACT + HH, M_HID = WS_ACT + 3 * HH, M_YE = WS_ACT + 9 * HH;
constexpr size_t R_H1 = WS_ACT, R_MIX = WS_ACT + 2 * HH, R_RR = WS_ACT + 9 * HH, R_KK = WS_ACT + 11 * HH, R_VV = WS_ACT + 13 * HH, R_L1O = WS_ACT + 15 * HH;
constexpr size_t R_SREC = WS_ACT + 2 * HH;
constexpr size_t R_REC_A = WS_ACT + 15 * HH;
constexpr size_t R_GREC = WS_ACT + 4 * HH;
constexpr size_t R_KKN = R_H1;
constexpr size_t R_LOGW = R_MIX;
constexpr size_t R_AA = R_MIX + 4 * HH;
constexpr size_t R_G = R_MIX + 6 * HH;
constexpr size_t R_YG = WS_ACT + HH;

struct Params { const float* in[31]; float* out; unsigned char* ws; int lo, hi; };
typedef const __attribute__((address_space(4))) Params* KP;

__device__ __forceinline__ int tid_() { int t = threadIdx.x; asm volatile("" : "+v"(t)); return t; }

constexpr int BM = 256, BK = 64, HALF = 128, HT = HALF * BK;
__device__ __forceinline__ int lds_byte(int r, int c) { int st = (r >> 4) * 2 + (c >> 5), rr = r & 15, cc = c & 31, ob = rr * 64 + cc * 2; return st * 1024 + (ob ^ (((ob >> 9) & 1) << 5)); }
__device__ __forceinline__ void stage_rc(int b, int& R, int& C) { int st = b / 1024, sb = b % 1024, swz = sb ^ (((sb >> 9) & 1) << 5); R = (st >> 1) * 16 + swz / 64; C = (st & 1) * 32 + (swz % 64) / 2; }

__device__ __forceinline__ void tile_order(int L, int nM, int nN, int& pm, int& pn) {
    const int nwg = nM * nN, q = nwg / 8, xcd = L % 8, off = L / 8, wgid = xcd * q + off;
    const int nig = 8 * nN, gid = wgid / nig, w = wgid % nig;
    pm = gid * 8 + (w % 8); pn = w / 8;
}
template <class T> __device__ __forceinline__ T* uni_ptr(T* p) {
    const unsigned long long u = (unsigned long long)p;
    const unsigned lo = __builtin_amdgcn_readfirstlane((unsigned)u), hi = __builtin_amdgcn_readfirstlane((unsigned)(u >> 32));
    return (T*)(((unsigned long long)hi << 32) | lo);
}

struct GemmNext { const bf16_t* A; const bf16_t* Bt; const int* gidx; int brow, bcol, valid; };
template <class Epi, bool GATHER = false, bool F8 = false>
__device__ __forceinline__ void gemm_tile(const bf16_t* __restrict__ A, const bf16_t* __restrict__ Bt, int K, int brow, int bcol, bf16_t* shm, const Epi& epi, const int* __restrict__ gidx = nullptr,
                                          int pre = 0, GemmNext nx = GemmNext{nullptr, nullptr, nullptr, 0, 0, 0}) {
#define SA(b,h) (shm+((b)*2+(h))*HT)
#define SB(b,h) (shm+(4+(b)*2+(h))*HT)
#define STAGE_X(P,BASE,br,kt) do{ const char* _gb = (const char*)((BASE) + (long)(br)*K + (long)(kt)*BK); \
    __builtin_amdgcn_global_load_lds((const unsigned*)(_gb + voff), (unsigned LAS*)((char*)(P) + wvu*1024), 16, 0, 0); \
    __builtin_amdgcn_global_load_lds((const unsigned*)(_gb + (size_t)K*128 + voff), (unsigned LAS*)((char*)(P) + wvu*1024 + 8192), 16, 0, 0);}while(0)
#define STAGE_A(P,br,kt) do { if constexpr (GATHER) { const char* _ga = (const char*)(A + (long)(kt)*BK); \
    __builtin_amdgcn_global_load_lds((const unsigned*)(_ga + (((br) != brow) ? vA2 : vA0)), (unsigned LAS*)((char*)(P) + wvu*1024), 16, 0, 0); \
    __builtin_amdgcn_global_load_lds((const unsigned*)(_ga + (((br) != brow) ? vA3 : vA1)), (unsigned LAS*)((char*)(P) + wvu*1024 + 8192), 16, 0, 0); } \
    else { STAGE_X(P,A,br,kt); } } while(0)
#define STAGE_B(P,br,kt) STAGE_X(P,Bt,br,kt)
typedef int i32x4_t __attribute__((ext_vector_type(4)));
#define LDA(dst,b,h) do { if constexpr (F8) { for(int m=0;m<4;++m) { \
      const i32x4_t _l = *reinterpret_cast<const i32x4_t*>((char*)SA(b,h)+lds_byte(wr*64+m*16+fr,fq*8)), _h = *reinterpret_cast<const i32x4_t*>((char*)SA(b,h)+lds_byte(wr*64+m*16+fr,32+fq*8)); \
      dst##8[m] = __builtin_shufflevector(_l, _h, 0, 1, 2, 3, 4, 5, 6, 7); } } \
    else { for(int m=0;m<4;++m)for(int k=0;k<2;++k) dst[m][k]=*reinterpret_cast<const bf16x8*>((char*)SA(b,h)+lds_byte(wr*64+m*16+fr,k*32+fq*8)); } } while(0)
#define LDB(dst,b,h) do { if constexpr (F8) { for(int n=0;n<2;++n) { \
      const i32x4_t _l = *reinterpret_cast<const i32x4_t*>((char*)SB(b,h)+lds_byte(wc*32+n*16+fr,fq*8)), _h = *reinterpret_cast<const i32x4_t*>((char*)SB(b,h)+lds_byte(wc*32+n*16+fr,32+fq*8)); \
      dst##8[n] = __builtin_shufflevector(_l, _h, 0, 1, 2, 3, 4, 5, 6, 7); } } \
    else { for(int n=0;n<2;++n)for(int k=0;k<2;++k) dst[n][k]=*reinterpret_cast<const bf16x8*>((char*)SB(b,h)+lds_byte(wc*32+n*16+fr,k*32+fq*8)); } } while(0)
#define MMA(ai,bj,At,Bq) do{__builtin_amdgcn_s_setprio(1); \
    if constexpr (F8) { for(int m=0;m<4;++m)for(int n=0;n<2;++n) \
        asm volatile("v_mfma_scale_f32_16x16x128_f8f6f4 %0, %1, %2, %0, %3, %3 op_sel_hi:[0,0,0]" : "+v"(acc[ai][bj][m][n]) : "v"(Bq##8[n]), "v"(At##8[m]), "v"(f8one)); } \
    else { for(int m=0;m<4;++m)for(int n=0;n<2;++n)for(int k=0;k<2;++k) \
      acc[ai][bj][m][n]=__builtin_amdgcn_mfma_f32_16x16x32_bf16(Bq[n][k],At[m][k],acc[ai][bj][m][n],0,0,0); } \
    __builtin_amdgcn_s_setprio(0);}while(0)
#define WAIT_V(n) asm volatile("s_waitcnt vmcnt(" #n ")":::"memory")
#define WAIT_L(n) asm volatile("s_waitcnt lgkmcnt(" #n ")":::"memory")
#define BAR __builtin_amdgcn_s_barrier()
#define SCHED __builtin_amdgcn_sched_barrier(0)
    int tz = tid_();
    int wid = tz >> 6, lane = tz & 63, wr = wid >> 2, wc = wid & 3, fr = lane & 15, fq = lane >> 4;
    const int wvu = __builtin_amdgcn_readfirstlane(tz >> 6);
    unsigned voff, vA0 = 0, vA1 = 0, vA2 = 0, vA3 = 0; { int _r, _c; stage_rc(tz * 16, _r, _c); voff = (unsigned)((_r * K + _c) * 2);
        if constexpr (GATHER) { const int* gi = gidx + brow + _r; vA0 = (unsigned)((gi[0] * K + _c) * 2); vA1 = (unsigned)((gi[64] * K + _c) * 2); vA2 = (unsigned)((gi[128] * K + _c) * 2); vA3 = (unsigned)((gi[192] * K + _c) * 2); } }
    f32x4 acc[2][2][4][2] = {};
    bf16x8 At[4][2], B0[2][2], B1[2][2];
    v8i_t At8[4], B08[2], B18[2];
    const int f8one = 0x7F7F7F7F;
    const int nt = K / BK;
    if (!pre) {
        STAGE_B(SB(0,0),bcol,0); STAGE_A(SA(0,0),brow,0);
        STAGE_B(SB(0,1),bcol+HALF,0); STAGE_A(SA(0,1),brow+HALF,0);
    }
    if (wr == 1) BAR;
    WAIT_V(4); BAR;
    STAGE_B(SB(1,0),bcol,1); STAGE_A(SA(1,0),brow,1); STAGE_B(SB(1,1),bcol+HALF,1);
    WAIT_V(6); BAR;
    for (int t = 0; t < nt - 2; t += 2) {
        LDB(B0,0,0); SCHED; LDA(At,0,0); STAGE_A(SA(1,1),brow+HALF,t+1);
        WAIT_L(8); BAR; WAIT_L(0); MMA(0,0,At,B0); BAR; SCHED;
        LDB(B1,0,1); STAGE_B(SB(0,0),bcol,t+2);
        BAR; WAIT_L(0); MMA(0,1,At,B1); BAR;
        LDA(At,0,1); STAGE_A(SA(0,0),brow,t+2);
        BAR; WAIT_L(0); MMA(1,0,At,B0); BAR; SCHED;
        STAGE_B(SB(0,1),bcol+HALF,t+2);
        WAIT_V(6); BAR; MMA(1,1,At,B1); BAR;
        LDB(B0,1,0); SCHED; LDA(At,1,0); STAGE_A(SA(0,1),brow+HALF,t+2);
        WAIT_L(8); BAR; WAIT_L(0); MMA(0,0,At,B0); BAR; SCHED;
        LDB(B1,1,1); STAGE_B(SB(1,0),bcol,t+3);
        BAR; WAIT_L(0); MMA(0,1,At,B1); BAR;
        LDA(At,1,1); STAGE_A(SA(1,0),brow,t+3);
        BAR; WAIT_L(0); MMA(1,0,At,B0); BAR; SCHED;
        STAGE_B(SB(1,1),bcol+HALF,t+3);
        WAIT_V(6); BAR; MMA(1,1,At,B1); BAR;
    }
    asm volatile("" : "+v"(tz)); wid = tz >> 6; lane = tz & 63; wr = wid >> 2; wc = wid & 3; fr = lane & 15; fq = lane >> 4;
    const int nxv = __builtin_amdgcn_readfirstlane(nx.valid);
    float rv[8] = {0.f, 0.f, 0.f, 0.f, 0.f, 0.f, 0.f, 0.f};
    if constexpr (Epi::kRowVec) { const float* rp_ = epi.rowvec() + brow + wr * 64 + fr;
#pragma unroll
        for (int q_ = 0; q_ < 8; ++q_) rv[q_] = rp_[(q_ >> 2) * 128 + (q_ & 3) * 16]; }
    int n0 = 0, n1 = 0, n2 = 0, n3 = 0;
    if constexpr (GATHER) { if (nxv) { int _r, _c; stage_rc(tz * 16, _r, _c); const int* gi = nx.gidx + nx.brow + _r; n0 = gi[0]; n1 = gi[64]; n2 = gi[128]; n3 = gi[192]; } }
    { LDB(B0,0,0); WAIT_V(0); LDA(At,0,0); STAGE_A(SA(1,1),brow+HALF,nt-1);
      BAR; WAIT_L(0); MMA(0,0,At,B0); BAR;
      LDB(B1,0,1); BAR; WAIT_L(0); MMA(0,1,At,B1); BAR;
      LDA(At,0,1); WAIT_V(4); BAR; WAIT_L(0); MMA(1,0,At,B0); MMA(1,1,At,B1); BAR; }
    { LDB(B0,1,0); LDA(At,1,0);
      WAIT_V(2);
      BAR;
      if (nxv) {
          const int wvu2 = __builtin_amdgcn_readfirstlane(tz >> 6);
          unsigned vo2; int _c2; { int _r, _c; stage_rc(tz * 16, _r, _c); vo2 = (unsigned)((_r * K + _c) * 2); _c2 = _c; }
          const char* gb0 = (const char*)(nx.Bt + (long)nx.bcol * K); const char* gb1 = (const char*)(nx.Bt + (long)(nx.bcol + HALF) * K);
          __builtin_amdgcn_global_load_lds((const unsigned*)(gb0 + vo2), (unsigned LAS*)((char*)SB(0,0) + wvu2*1024), 16, 0, 0);
          __builtin_amdgcn_global_load_lds((const unsigned*)(gb0 + (size_t)K*128 + vo2), (unsigned LAS*)((char*)SB(0,0) + wvu2*1024 + 8192), 16, 0, 0);
          if constexpr (GATHER) {
              const char* ga = (const char*)nx.A;
              __builtin_amdgcn_global_load_lds((const unsigned*)(ga + (unsigned)((n0 * K + _c2) * 2)), (unsigned LAS*)((char*)SA(0,0) + wvu2*1024), 16, 0, 0);
              __builtin_amdgcn_global_load_lds((const unsigned*)(ga + (unsigned)((n1 * K + _c2) * 2)), (unsigned LAS*)((char*)SA(0,0) + wvu2*1024 + 8192), 16, 0, 0);
          } else {
              const char* ga0 = (const char*)(nx.A + (long)nx.brow * K);
              __builtin_amdgcn_global_load_lds((const unsigned*)(ga0 + vo2), (unsigned LAS*)((char*)SA(0,0) + wvu2*1024), 16, 0, 0);
              __builtin_amdgcn_global_load_lds((const unsigned*)(ga0 + (size_t)K*128 + vo2), (unsigned LAS*)((char*)SA(0,0) + wvu2*1024 + 8192), 16, 0, 0);
          }
          __builtin_amdgcn_global_load_lds((const unsigned*)(gb1 + vo2), (unsigned LAS*)((char*)SB(0,1) + wvu2*1024), 16, 0, 0);
          __builtin_amdgcn_global_load_lds((const unsigned*)(gb1 + (size_t)K*128 + vo2), (unsigned LAS*)((char*)SB(0,1) + wvu2*1024 + 8192), 16, 0, 0);
          if constexpr (GATHER) {
              const char* ga = (const char*)nx.A;
              __builtin_amdgcn_global_load_lds((const unsigned*)(ga + (unsigned)((n2 * K + _c2) * 2)), (unsigned LAS*)((char*)SA(0,1) + wvu2*1024), 16, 0, 0);
              __builtin_amdgcn_global_load_lds((const unsigned*)(ga + (unsigned)((n3 * K + _c2) * 2)), (unsigned LAS*)((char*)SA(0,1) + wvu2*1024 + 8192), 16, 0, 0);
          } else {
              const char* ga1 = (const char*)(nx.A + (long)(nx.brow + HALF) * K);
              __builtin_amdgcn_global_load_lds((const unsigned*)(ga1 + vo2), (unsigned LAS*)((char*)SA(0,1) + wvu2*1024), 16, 0, 0);
              __builtin_amdgcn_global_load_lds((const unsigned*)(ga1 + (size_t)K*128 + vo2), (unsigned LAS*)((char*)SA(0,1) + wvu2*1024 + 8192), 16, 0, 0);
          }
      }
      WAIT_L(0); MMA(0,0,At,B0); BAR;
      LDB(B1,1,1);
      if (nxv) WAIT_V(8); else WAIT_V(0);
      BAR; WAIT_L(0); MMA(0,1,At,B1); BAR;
      LDA(At,1,1); BAR; WAIT_L(0); MMA(1,0,At,B0); MMA(1,1,At,B1); BAR; }
    if (wr == 0) BAR;
    if constexpr (F8) asm volatile("s_nop 15\n\ts_nop 15" ::: "memory");
    if constexpr (Epi::kRowVec) epi(acc, brow + wr * 64 + fr, bcol + wc * 32 + 8 * fq, rv); else epi(acc, brow + wr * 64 + fr, bcol + wc * 32 + 8 * fq);
    __syncthreads();
#undef SA
#undef SB
#undef STAGE_X
#undef STAGE_A
#undef STAGE_B
#undef LDA
#undef LDB
#undef MMA
#undef WAIT_V
#undef WAIT_L
#undef BAR
#undef SCHED
}
#define EPI_FOR3 _Pragma("unroll") for (int ai = 0; ai < 2; ++ai) _Pragma("unroll") for (int m = 0; m < 4; ++m) _Pragma("unroll") for (int bj = 0; bj < 2; ++bj)
typedef f32x4 AccT[2][2][4][2];
__device__ __forceinline__ u32x4 pk8(f32x4 a, f32x4 b) { u32x4 o = {pk_bf16(a[0], a[1]), pk_bf16(a[2], a[3]), pk_bf16(b[0], b[1]), pk_bf16(b[2], b[3])}; return o; }

struct EpiProj {
    static constexpr bool kRowVec = false;
    bf16_t *Q, *V, *KF, *AQ, *AK, *AV; float *LOGF; bf16_t *GATE; const float* LB;
    __device__ __forceinline__ void operator()(const AccT& acc, int row0, int col0) const {
        const int seg = col0 >> 9; const int cb = col0 & 511;
        EPI_FOR3 {
            const int r = row0 + ai * 128 + m * 16, c = cb + bj * 128;
            const f32x4 v0 = acc[ai][bj][m][0], v1 = acc[ai][bj][m][1];
            if (seg == 1 || seg == 2) {
                const int dir = seg - 1;
                const f32x4 lb0 = *(const f32x4*)(LB + dir * 512 + c), lb1 = *(const f32x4*)(LB + dir * 512 + c + 4);
                f32x4 lf0, lf1, k0, k1;
#pragma unroll
                for (int i = 0; i < 4; ++i) {
                    { const float sg = sigmoidf_(v0[i]), sgn = __builtin_amdgcn_rcpf(1.f + __expf(v0[i])); lf0[i] = __logf(lb0[i] + (1.f - lb0[i]) * sg); k0[i] = (1.f - lb0[i]) * sgn; }
                    { const float sg = sigmoidf_(v1[i]), sgn = __builtin_amdgcn_rcpf(1.f + __expf(v1[i])); lf1[i] = __logf(lb1[i] + (1.f - lb1[i]) * sg); k1[i] = (1.f - lb1[i]) * sgn; }
                }
                float* lp = LOGF + ((size_t)dir * S + r) * 512 + c; *(f32x4*)lp = lf0; *(f32x4*)(lp + 4) = lf1;
                *(u32x4*)(KF + ((size_t)dir * S + r) * 512 + c) = pk8(k0, k1);
            } else if (seg == 4) {
                f32x4 g0, g1;
#pragma unroll
                for (int i = 0; i < 4; ++i) { g0[i] = v0[i] * sigmoidf_(v0[i]); g1[i] = v1[i] * sigmoidf_(v1[i]); }
                *(u32x4*)(GATE + (size_t)r * 512 + c) = pk8(g0, g1);
            } else {
                bf16_t* dst = seg == 0 ? Q : seg == 3 ? V : seg == 5 ? AQ : seg == 6 ? AK : AV;
                const float sc = seg == 5 ? 0.125f : 1.f;
                *(u32x4*)(dst + (size_t)r * 512 + c) = pk8(v0 * sc, v1 * sc);
            }
        }
    }
};
struct EpiResid {
    const float* res; float* out; bf16_t* xh;
    static constexpr bool kRowVec = false;
    __device__ __forceinline__ void operator()(const AccT& acc, int row0, int col0) const {
        EPI_FOR3 { const int r = row0 + ai * 128 + m * 16, c = col0 + bj * 128;
            const float* rp = res + (size_t)r * 1024 + c; float* op = out + (size_t)r * 1024 + c;
            const f32x4 x0 = *(const f32x4*)rp + acc[ai][bj][m][0], x1 = *(const f32x4*)(rp + 4) + acc[ai][bj][m][1];
            *(f32x4*)op = x0; *(f32x4*)(op + 4) = x1;
            { u32x2 o8; o8[0] = pk4_fp8(x0[0], x0[1], x0[2], x0[3]); o8[1] = pk4_fp8(x1[0], x1[1], x1[2], x1[3]); *(u32x2*)((unsigned char*)xh + (size_t)r * 1024 + c) = o8; } }
    }
};
struct EpiSwiglu {
    bf16_t* hid;
    const float* rse;
    static constexpr bool kRowVec = true;
    __device__ __forceinline__ const float* rowvec() const { return rse; }
    __device__ __forceinline__ void operator()(const AccT& acc, int row0, int col0, const float (&rv)[8]) const {
        const int fb = (col0 >> 8) * 128 + (col0 & 255);
#pragma unroll
        for (int ai = 0; ai < 2; ++ai)
#pragma unroll
            for (int m = 0; m < 4; ++m) {
                const int r = row0 + ai * 128 + m * 16; const float rs = rv[ai * 4 + m] * (1.f / 32.f);
                f32x4 h0, h1;
#pragma unroll
                for (int i = 0; i < 4; ++i) { const float g0 = rs * acc[ai][0][m][0][i], g1 = rs * acc[ai][0][m][1][i];
                    h0[i] = g0 * sigmoidf_(g0) * (rs * acc[ai][1][m][0][i]); h1[i] = g1 * sigmoidf_(g1) * (rs * acc[ai][1][m][1][i]); }
                { u32x2 o8; o8[0] = pk4_fp8(h0[0], h0[1], h0[2], h0[3]); o8[1] = pk4_fp8(h1[0], h1[1], h1[2], h1[3]); *(u32x2*)((unsigned char*)hid + (size_t)r * 2048 + fb) = o8; }
            }
    }
};
struct EpiDown {
    bf16_t* ye; const float* gw;
    static constexpr bool kRowVec = true;
    __device__ __forceinline__ const float* rowvec() const { return gw; }
    __device__ __forceinline__ void operator()(const AccT& acc, int row0, int col0, const float (&rv)[8]) const {
        EPI_FOR3 { const int r = row0 + ai * 128 + m * 16, c = col0 + bj * 128;
            const float g = rv[ai * 4 + m] * (1.f / 64.f);
            *(u32x4*)(ye + (size_t)r * 1024 + c) = pk8(acc[ai][bj][m][0] * g, acc[ai][bj][m][1] * g); }
    }
};
struct EpiRkvLora {
    int isl; bf16_t* outb; bf16_t* out; float al, be, ga, de;
    static constexpr bool kRowVec = false;
    __device__ __forceinline__ void operator()(const AccT& acc, int row0, int col0) const {
        if (isl) {
#pragma unroll
            for (int ai = 0; ai < 2; ++ai)
#pragma unroll
                for (int m = 0; m < 4; ++m) { const int r = row0 + ai * 128 + m * 16, c = col0;
                    const f32x4 v0 = acc[ai][0][m][0], v1 = acc[ai][0][m][1]; f32x4 h0, h1;
#pragma unroll
                    for (int i = 0; i < 4; ++i) { h0[i] = al * sigmoidf_(be * v0[i]) + ga + de * v0[i]; h1[i] = al * sigmoidf_(be * v1[i]) + ga + de * v1[i]; }
                    *(u32x4*)(out + (size_t)r * 128 + c) = pk8(h0, h1); }
        } else {
            EPI_FOR3 { const int r = row0 + ai * 128 + m * 16, c = col0 + bj * 128;
                *(u32x4*)(outb + (size_t)r * 1024 + c) = pk8(acc[ai][bj][m][0], acc[ai][bj][m][1]); }
        }
    }
};
struct EpiLora2 {
    int isg; float scale; const float* bias; bf16_t* outb;
    static constexpr bool kRowVec = false;
    __device__ __forceinline__ void operator()(const AccT& acc, int row0, int col0) const {
        if (isg) {
            EPI_FOR3 { const int r = row0 + ai * 128 + m * 16, c = col0 + bj * 128;
                *(u32x4*)(outb + (size_t)r * 1024 + c) = pk8(acc[ai][bj][m][0], acc[ai][bj][m][1]); }
        } else {
            EPI_FOR3 { const int r = row0 + ai * 128 + m * 16, c = col0 + bj * 128;
                const f32x4 b0 = *(const f32x4*)(bias + c), b1 = *(const f32x4*)(bias + c + 4); f32x4 o0, o1;
#pragma unroll
                for (int i = 0; i < 4; ++i) { o0[i] = scale * sigmoidf_(b0[i] + acc[ai][bj][m][0][i]); o1[i] = scale * sigmoidf_(b1[i] + acc[ai][bj][m][1][i]); }
                *(u32x4*)(outb + (size_t)r * 1024 + c) = pk8(o0, o1); }
        }
    }
};

__device__ __forceinline__ void cvt_tile(const float* __restrict__ src, int ldsrc, int k0, int n0, bf16_t* __restrict__ dst, int lddst, int drow0, float* tile, const float* __restrict__ kscale = nullptr, float f8scale = 0.f) {
    const int tid = tid_();
#pragma unroll
    for (int i = 0; i < 2; ++i) {
        const int idx = tid + i * 512, kk = idx >> 4, n4 = (idx & 15) * 4;
        const float4 v = *(const float4*)(src + (size_t)(k0 + kk) * ldsrc + n0 + n4);
        float* t = tile + kk * 65 + n4; t[0] = v.x; t[1] = v.y; t[2] = v.z; t[3] = v.w;
    }
    __syncthreads();
    const int n = tid >> 3, kq = (tid & 7) * 8;
    float f[8];
#pragma unroll
    for (int j = 0; j < 8; ++j) f[j] = tile[(kq + j) * 65 + n];
    if (kscale) {
#pragma unroll
        for (int j = 0; j < 8; ++j) f[j] *= kscale[k0 + kq + j];
    }
    const size_t drow = (size_t)(drow0 + (n & 32) + 16 * ((n >> 2) & 1) + 4 * ((n & 31) >> 3) + (n & 3));
    if (f8scale != 0.f) {
        u32x2 o8; o8[0] = pk4_fp8(f[0] * f8scale, f[1] * f8scale, f[2] * f8scale, f[3] * f8scale); o8[1] = pk4_fp8(f[4] * f8scale, f[5] * f8scale, f[6] * f8scale, f[7] * f8scale);
        *(u32x2*)((unsigned char*)dst + drow * lddst + k0 + kq) = o8;
    } else {
        u32x4 o; o[0] = pk_bf16(f[0], f[1]); o[1] = pk_bf16(f[2], f[3]); o[2] = pk_bf16(f[4], f[5]); o[3] = pk_bf16(f[6], f[7]);
        *(u32x4*)(dst + drow * lddst + k0 + kq) = o;
    }
    __syncthreads();
}
__device__ __forceinline__ void cvt_job(const float* src, int K, int N, bf16_t* dst, int lddst, int mode, int& rot, int bid, int G, float* tile, const float* kscale = nullptr, float f8scale = 0.f) {
    const int nkt = K / 64, nnt = N / 64, nt = nkt * nnt;
    int start = (bid - rot) % G; if (start < 0) start += G;
    for (int t = start; t < nt; t += G) {
        const int kt = t % nkt, ntile = t / nkt, n0 = ntile * 64;
        int drow0 = n0;
        if (mode == 1) drow0 = (n0 >> 7) * 256 + (n0 & 127); else if (mode == 2) drow0 = (n0 >> 7) * 256 + 128 + (n0 & 127);
        cvt_tile(src, N, kt * 64, n0, dst, lddst, drow0, tile, kscale, f8scale);
    }
    rot = (rot + nt) % G;
}
__device__ __forceinline__ void cvt_moe_layer(KP p, int layer, int e_lo, int e_hi, int& rot, int bid, int G, float* tile) {
    bf16_t* gu = (bf16_t*)(p->ws + WS_BT_GU); bf16_t* dn = (bf16_t*)(p->ws + WS_BT_DN);
    for (int e = e_lo; e < e_hi; ++e) {
        const size_t wo = ((size_t)layer * 16 + e) * 1024 * 2048;
        cvt_job(p->in[27] + wo, 1024, 2048, (bf16_t*)((unsigned char*)gu + (size_t)e * 4096 * 1024), 1024, 1, rot, bid, G, tile, p->in[25] + (size_t)layer * 1024, 32.f);
        cvt_job(p->in[28] + wo, 1024, 2048, (bf16_t*)((unsigned char*)gu + (size_t)e * 4096 * 1024), 1024, 2, rot, bid, G, tile, p->in[25] + (size_t)layer * 1024, 32.f);
        cvt_job(p->in[29] + wo, 2048, 1024, (bf16_t*)((unsigned char*)dn + (size_t)e * 1024 * 2048), 2048, 0, rot, bid, G, tile, nullptr, 64.f);
    }
}
struct CvGroup { const float* src; int lds, e, mat, kt, ng; };
__device__ __forceinline__ CvGroup cv_decode(KP p, int layer, int e_lo, int g) {
    CvGroup d; d.e = e_lo + g / 384; const int r = g % 384; d.mat = r >> 7; const int t = r & 127;
    const size_t wo = ((size_t)layer * 16 + d.e) * 1024 * 2048;
    d.kt = d.mat < 2 ? (t & 15) : (t & 31); d.ng = d.mat < 2 ? (t >> 4) : (t >> 5); d.lds = d.mat < 2 ? 2048 : 1024;
    d.src = (d.mat == 0 ? p->in[27] : d.mat == 1 ? p->in[28] : p->in[29]) + wo + (size_t)(d.kt * 64) * d.lds + d.ng * 256;
    return d;
}
__device__ __forceinline__ void cv_request(KP p, int layer, int e_lo, int g, f32x4 (&pf)[8]) {
    const CvGroup d = cv_decode(p, layer, e_lo, g); const int td = tid_();
#pragma unroll
    for (int c = 0; c < 4; ++c)
#pragma unroll
        for (int i = 0; i < 2; ++i) { const int idx = td + i * 512, kk = idx >> 4, n4 = (idx & 15) * 4; pf[c * 2 + i] = *(const f32x4*)(d.src + (size_t)kk * d.lds + 64 * c + n4); }
}
__device__ __forceinline__ void cv_to_lds(const f32x4 (&pf)[8], float* tile) {
    const int td = tid_();
#pragma unroll
    for (int c = 0; c < 4; ++c)
#pragma unroll
        for (int i = 0; i < 2; ++i) { const int idx = td + i * 512, kk = idx >> 4, n4 = (idx & 15) * 4; const f32x4 v = pf[c * 2 + i];
            float* t = tile + c * 4160 + kk * 65 + n4; t[0] = v[0]; t[1] = v[1]; t[2] = v[2]; t[3] = v[3]; }
}
__device__ __forceinline__ void cv_store(KP p, int layer, int e_lo, int g, const float* tile) {
    const CvGroup d = cv_decode(p, layer, e_lo, g); const int td = tid_();
    const int n = td >> 3, kq = (td & 7) * 8, k0 = d.kt * 64;
    const float f8scale = d.mat < 2 ? 32.f : 64.f;
    const float* gainp = p->in[25] + (size_t)layer * 1024;
    unsigned char* dst = d.mat < 2 ? p->ws + WS_BT_GU + (size_t)d.e * 4096 * 1024 : p->ws + WS_BT_DN + (size_t)d.e * 1024 * 2048;
    const int lddst = d.mat < 2 ? 1024 : 2048;
    float ks[8];
#pragma unroll
    for (int j = 0; j < 8; ++j) ks[j] = d.mat < 2 ? gainp[k0 + kq + j] * f8scale : f8scale;
#pragma unroll
    for (int c = 0; c < 4; ++c) {
        const int n0 = d.ng * 256 + 64 * c;
        const int drow0 = d.mat == 0 ? (n0 >> 7) * 256 + (n0 & 127) : d.mat == 1 ? (n0 >> 7) * 256 + 128 + (n0 & 127) : n0;
        float f[8];
#pragma unroll
        for (int j = 0; j < 8; ++j) f[j] = tile[c * 4160 + (kq + j) * 65 + n] * ks[j];
        const size_t drow = (size_t)(drow0 + (n & 32) + 16 * ((n >> 2) & 1) + 4 * ((n & 31) >> 3) + (n & 3));
        u32x2 o8; o8[0] = pk4_fp8(f[0], f[1], f[2], f[3]); o8[1] = pk4_fp8(f[4], f[5], f[6], f[7]);
        *(u32x2*)(dst + drow * lddst + k0 + kq) = o8;
    }
}
__device__ __forceinline__ void rms_rows_bf16(const float* __restrict__ x, const float* __restrict__ gain, bf16_t* __restrict__ out, int bid, int G) {
    const int lane = tid_() & 63, wv = tid_() >> 6;
    for (int r = bid * 8 + wv; r < S; r += G * 8) {
        float4 v[4]; float ss = 0.f;
#pragma unroll
        for (int i = 0; i < 4; ++i) { v[i] = *(const float4*)(x + (size_t)r * 1024 + (i * 64 + lane) * 4); ss += v[i].x * v[i].x + v[i].y * v[i].y + v[i].z * v[i].z + v[i].w * v[i].w; }
        ss = wave_sum(ss);
        const float rs = rsqrtf(ss * (1.f / 1024.f) + 1e-6f);
#pragma unroll
        for (int i = 0; i < 4; ++i) { const float4 g = *(const float4*)(gain + (i * 64 + lane) * 4);
            u32x2 o; o[0] = pk_bf16(v[i].x * rs * g.x, v[i].y * rs * g.y); o[1] = pk_bf16(v[i].z * rs * g.z, v[i].w * rs * g.w);
            *(u32x2*)(out + (size_t)r * 1024 + (i * 64 + lane) * 4) = o; }
    }
}
__device__ __forceinline__ int t5_bucket(int rel) {
    const int n = rel < 0 ? -rel : rel;
    int b;
    if (n < 8) b = n; else b = n >= 559 ? 15 : n >= 305 ? 14 : n >= 166 ? 13 : n >= 91 ? 12 : n >= 50 ? 11 : n >= 27 ? 10 : n >= 15 ? 9 : 8;
    return (rel > 0 ? 16 : 0) + b;
}
__device__ __forceinline__ void phase_prologue(KP p, char* smem) {
    const int bid = blockIdx.x, G = gridDim.x, tid = tid_();
    float* tile = (float*)smem;
    rms_rows_bf16(p->in[0], p->in[3], (bf16_t*)(p->ws + A_H0), bid, G);
    if (bid == 0) {
        float* LB = (float*)(p->ws + WS_LB);
        for (int i = tid; i < 1024; i += NTHR) { const float a = p->in[2][i], b = p->in[2][1024 + i], c = p->in[2][2048 + i]; const float mx = fmaxf(a, fmaxf(b, c));
            const float ea = __expf(a - mx), eb = __expf(b - mx), ec = __expf(c - mx); LB[i] = ea / (ea + eb + ec); }
    }
    if (bid == 1 % G) {
        float* BI = (float*)(p->ws + WS_BIAS);
        for (int i = tid; i < 3 * 8 * 129; i += NTHR) { const int g = i / (8 * 129), h = (i / 129) % 8, ri = i % 129; const int dil = g == 0 ? 1 : g == 1 ? 4 : 16;
            BI[(g * 8 + h) * 132 + ri] = p->in[1][t5_bucket((ri - 64) * dil) * 8 + h]; }
    }
    {
        bf16_t* l1 = (bf16_t*)(p->ws + WS_WT_L1); bf16_t* l2 = (bf16_t*)(p->ws + WS_WT_L2);
        const u32x4 z = {0u, 0u, 0u, 0u};
        for (int j = 0; j < 4; ++j) {
            const int nv = j == 3 ? 128 : 64;
            const int n16 = (256 - nv) * 1024 / 8;
            for (int i = bid * NTHR + tid; i < n16; i += G * NTHR) *(u32x4*)(l1 + (size_t)j * 256 * 1024 + (size_t)nv * 1024 + (size_t)i * 8) = z;
            const int cpr = (128 - nv) / 8;
            for (int i = bid * NTHR + tid; i < 1024 * cpr; i += G * NTHR) { const int r = i / cpr, c = nv + (i % cpr) * 8; *(u32x4*)(l2 + (size_t)j * 1024 * 128 + (size_t)r * 128 + c) = z; }
        }
    }
    int rot = 0;
    cvt_job(p->in[4], 1024, 4096, (bf16_t*)(p->ws + WS_WT_IN), 1024, 0, rot, bid, G, tile);
    cvt_job(p->in[6], 1024, 1024, (bf16_t*)(p->ws + WS_WT_OUT), 1024, 0, rot, bid, G, tile);
    for (int i = 0; i < 3; ++i) cvt_job(p->in[10] + (size_t)i * 1024 * 1024, 1024, 1024, (bf16_t*)(p->ws + WS_WT_RKV) + (size_t)i * 1024 * 1024, 1024, 0, rot, bid, G, tile);
    cvt_job(p->in[24], 1024, 1024, (bf16_t*)(p->ws + WS_WT_COUT), 1024, 0, rot, bid, G, tile);
    {
        bf16_t* l1 = (bf16_t*)(p->ws + WS_WT_L1); bf16_t* l2 = (bf16_t*)(p->ws + WS_WT_L2);
        cvt_job(p->in[12], 1024, 64, l1, 1024, 0, rot, bid, G, tile);
        cvt_job(p->in[12] + 1024 * 64, 1024, 64, l1 + 256 * 1024, 1024, 0, rot, bid, G, tile);
        cvt_job(p->in[15], 1024, 64, l1 + 2 * 256 * 1024, 1024, 0, rot, bid, G, tile);
        cvt_job(p->in[17], 1024, 128, l1 + 3 * 256 * 1024, 1024, 0, rot, bid, G, tile);
        cvt_job(p->in[13], 64, 1024, l2, 128, 0, rot, bid, G, tile);
        cvt_job(p->in[13] + 64 * 1024, 64, 1024, l2 + 1024 * 128, 128, 0, rot, bid, G, tile);
        cvt_job(p->in[16], 64, 1024, l2 + 2 * 1024 * 128, 128, 0, rot, bid, G, tile);
        cvt_job(p->in[18], 128, 1024, l2 + 3 * 1024 * 128, 128, 0, rot, bid, G, tile);
    }
    cvt_moe_layer(p, 0, 0, 4, rot, bid, G, tile);
}

constexpr int H_CUM = 0, H_TOT = 65536, H_KT = 66560, H_VT = 101376, H_END = 118784;
__device__ __forceinline__ void hgrn_load_cum(KP p, int c, int h, char* smem) {
    float* CUM = (float*)(smem + H_CUM); float* TOT = (float*)(smem + H_TOT);
    const float* LOGF = (const float*)(p->ws + A_LOGF);
    const int tid = tid_(), t0 = c * 64;
    for (int i = tid; i < 2 * 64 * 32; i += NTHR) {
        const int dir = i >> 11, s = (i >> 5) & 63, k4 = (i & 31) * 4;
        *(float4*)(CUM + (dir * 64 + s) * 128 + k4) = *(const float4*)(LOGF + ((size_t)dir * S + t0 + s) * 512 + h * 128 + k4);
    }
    __syncthreads();
    if (tid < 256) {
        const int dir = tid >> 7, k = tid & 127; float* col = CUM + dir * 64 * 128 + k; float v[64];
#pragma unroll
        for (int s = 0; s < 64; ++s) v[s] = col[s * 128];
        float run = 0.f;
#pragma unroll
        for (int s = 0; s < 64; ++s) { const float x = v[s]; if (dir == 0) { run += x; v[s] = run; } else { v[s] = run; run += x; } }
#pragma unroll
        for (int s = 0; s < 64; ++s) col[s * 128] = v[s];
        TOT[dir * 128 + k] = run;
    }
    __syncthreads();
}
__device__ __forceinline__ void hgrn_load_vt(KP p, int c, int h, char* smem) {
    const bf16_t* V = (const bf16_t*)(p->ws + A_V); unsigned* VT = (unsigned*)(smem + H_VT);
    const int tid = tid_(), t0 = c * 64;
    for (int i = tid; i < 32 * 128; i += NTHR) { const int sp = i >> 7, v = i & 127;
        const unsigned a = V[(size_t)(t0 + 2 * sp) * 512 + h * 128 + v], b = V[(size_t)(t0 + 2 * sp + 1) * 512 + h * 128 + v];
        VT[v * 34 + sp] = a | (b << 16); }
}
__device__ __forceinline__ void phase_hgrn_local(KP p, char* smem) {
    const int bid = blockIdx.x, G = gridDim.x, tid = tid_(), lane = tid & 63, wv = tid >> 6, fr = lane & 15, fq = lane >> 4;
    float* CUM = (float*)(smem + H_CUM); float* TOT = (float*)(smem + H_TOT); unsigned* KT = (unsigned*)(smem + H_KT); unsigned* VT = (unsigned*)(smem + H_VT);
    const bf16_t* KF = (const bf16_t*)(p->ws + A_KF); const bf16_t* V = (const bf16_t*)(p->ws + A_V); const float* LOGF = (const float*)(p->ws + A_LOGF);
    bf16_t* U = (bf16_t*)(p->ws + A_U); float* DTOT = (float*)(p->ws + WS_DTOT);
    f32x4 lf[8]; unsigned va[4], vb[4], ka[8], kb[8];
    const int kp = tid & 63, spb = tid >> 6;
#define HL_LOAD_LF(uu) do { const int c_ = (uu) >> 2, h_ = (uu) & 3; _Pragma("unroll") for (int q = 0; q < 8; ++q) { const int dir = q >> 2, s_ = ((tid >> 5) + q * 16) & 63; \
        lf[q] = *(const f32x4*)(LOGF + ((size_t)dir * S + c_ * 64 + s_) * 512 + h_ * 128 + (tid & 31) * 4); } } while (0)
#define HL_LOAD_KV(uu) do { const int c_ = (uu) >> 2, h_ = (uu) & 3; \
        _Pragma("unroll") for (int q = 0; q < 4; ++q) { const bf16_t* vp_ = V + (size_t)(c_ * 64 + 2 * (spb + q * 8)) * 512 + h_ * 128 + 2 * kp; va[q] = *(const unsigned*)vp_; vb[q] = *(const unsigned*)(vp_ + 512); } \
        _Pragma("unroll") for (int q = 0; q < 8; ++q) { const bf16_t* kp_ = KF + ((size_t)(q >> 2) * S + c_ * 64 + 2 * (spb + (q & 3) * 8)) * 512 + h_ * 128 + 2 * kp; ka[q] = *(const unsigned*)kp_; kb[q] = *(const unsigned*)(kp_ + 512); } } while (0)
    if (bid < 1024) { HL_LOAD_LF(bid); HL_LOAD_KV(bid); }
    for (int u = bid; u < 1024; u += G) {
        const int c = u >> 2, h = u & 3;
#pragma unroll
        for (int q = 0; q < 8; ++q) { const int dir = q >> 2, s_ = ((tid >> 5) + q * 16) & 63; *(f32x4*)(CUM + (dir * 64 + s_) * 128 + (tid & 31) * 4) = lf[q]; }
        if (u + G < 1024) HL_LOAD_LF(u + G);
        __syncthreads();
        if (tid < 256) {
            const int dir = tid >> 7, k = tid & 127; float* col = CUM + dir * 64 * 128 + k; float v[64];
#pragma unroll
            for (int s2 = 0; s2 < 64; ++s2) v[s2] = col[s2 * 128];
            float run = 0.f;
#pragma unroll
            for (int s2 = 0; s2 < 64; ++s2) { const float x = v[s2]; if (dir == 0) { run += x; v[s2] = run; } else { v[s2] = run; run += x; } }
#pragma unroll
            for (int s2 = 0; s2 < 64; ++s2) col[s2 * 128] = v[s2];
            TOT[dir * 128 + k] = run;
            DTOT[((size_t)dir * 256 + c) * 512 + h * 128 + k] = __expf(run);
        }
        __syncthreads();
#pragma unroll
        for (int q = 0; q < 4; ++q) { const int sp = spb + q * 8;
            VT[(2 * kp) * 34 + sp] = (va[q] & 0xffffu) | (vb[q] << 16); VT[(2 * kp + 1) * 34 + sp] = (va[q] >> 16) | (vb[q] & 0xffff0000u); }
#pragma unroll
        for (int q = 0; q < 8; ++q) { const int dir = q >> 2, sp = spb + (q & 3) * 8, s0 = 2 * sp;
            const float2 c0 = *(const float2*)(CUM + (dir * 64 + s0) * 128 + 2 * kp), c1 = *(const float2*)(CUM + (dir * 64 + s0 + 1) * 128 + 2 * kp);
            float w00, w01, w10, w11;
            if (dir == 0) { const float2 L = *(const float2*)(TOT + 2 * kp); w00 = __expf(L.x - c0.x); w01 = __expf(L.y - c0.y); w10 = __expf(L.x - c1.x); w11 = __expf(L.y - c1.y); }
            else { w00 = __expf(c0.x); w01 = __expf(c0.y); w10 = __expf(c1.x); w11 = __expf(c1.y); }
            KT[(dir * 128 + 2 * kp) * 34 + sp] = pk_bf16(bf_lo(ka[q]) * w00, bf_lo(kb[q]) * w10);
            KT[(dir * 128 + 2 * kp + 1) * 34 + sp] = pk_bf16(bf_hi(ka[q]) * w01, bf_hi(kb[q]) * w11); }
        if (u + G < 1024) HL_LOAD_KV(u + G);
        __syncthreads();
        {
            const int dir = wv >> 2, kt0 = (wv & 3) * 2;
            const char* ktb = smem + H_KT; const char* vtb = smem + H_VT;
            bf16x8 xf[2][2];
#pragma unroll
            for (int a = 0; a < 2; ++a)
#pragma unroll
                for (int ks = 0; ks < 2; ++ks) {
                    const char* ad = ktb + ((dir * 128 + (kt0 + a) * 16 + fr) * 68 + ks * 32 + fq * 8) * 2;
                    u32x2 lo = *(const u32x2*)ad, hi = *(const u32x2*)(ad + 8); u32x4 t = {lo[0], lo[1], hi[0], hi[1]}; xf[a][ks] = __builtin_bit_cast(bf16x8, t);
                }
            bf16_t* Ub = U + ((size_t)((c * 4 + h) * 2 + dir)) * 16384;
#pragma unroll
            for (int vt = 0; vt < 8; ++vt) {
                bf16x8 yf[2];
#pragma unroll
                for (int ks = 0; ks < 2; ++ks) { const char* ad = vtb + ((vt * 16 + fr) * 68 + ks * 32 + fq * 8) * 2;
                    u32x2 lo = *(const u32x2*)ad, hi = *(const u32x2*)(ad + 8); u32x4 t = {lo[0], lo[1], hi[0], hi[1]}; yf[ks] = __builtin_bit_cast(bf16x8, t); }
#pragma unroll
                for (int a = 0; a < 2; ++a) {
                    f32x4 d = {0.f, 0.f, 0.f, 0.f};
                    d = mfma16(xf[a][0], yf[0], d); d = mfma16(xf[a][1], yf[1], d);
                    { u32x2 o; o[0] = pk_bf16(d[0], d[1]); o[1] = pk_bf16(d[2], d[3]); *(u32x2*)(Ub + (size_t)(vt * 16 + fr) * 128 + (kt0 + a) * 16 + 4 * fq) = o; }
                }
            }
        }
        __syncthreads();
    }
#undef HL_LOAD_LF
#undef HL_LOAD_KV
}
__device__ __forceinline__ void phase_hgrn_scan(KP p) {
    const int G = gridDim.x;
    const bf16_t* U = (const bf16_t*)(p->ws + A_U); const float* DTOT = (const float*)(p->ws + WS_DTOT); bf16_t* SC = (bf16_t*)(p->ws + A_SC);
    for (int e = blockIdx.x * NTHR + tid_(); e < 2 * 4 * 16384; e += G * NTHR) {
        const int dir = e >> 16, h = (e >> 14) & 3, vk = e & 16383, k = vk & 127;
        float st = 0.f;
        bf16_t ua[16], ub[16]; float da[16], db[16];
#define HS_LOAD(UU, DD, cc_) do { _Pragma("unroll") for (int j = 0; j < 16; ++j) { const int c = dir == 0 ? (cc_) + j : 255 - ((cc_) + j); \
            UU[j] = U[((size_t)((c * 4 + h) * 2 + dir)) * 16384 + vk]; DD[j] = DTOT[((size_t)dir * 256 + c) * 512 + h * 128 + k]; } } while (0)
#define HS_PROC(UU, DD, cc_) do { _Pragma("unroll") for (int j = 0; j < 16; ++j) { const int c = dir == 0 ? (cc_) + j : 255 - ((cc_) + j); \
            SC[((size_t)((c * 4 + h) * 2 + dir)) * 16384 + vk] = (bf16_t)(pk_bf16(st, 0.f) & 0xffffu); \
            st = DD[j] * st + bf2f(UU[j]); } } while (0)
        HS_LOAD(ua, da, 0);
#pragma unroll 1
        for (int cc = 0; cc < 256; cc += 32) {
            HS_LOAD(ub, db, cc + 16);
            HS_PROC(ua, da, cc);
            if (cc + 32 < 256) HS_LOAD(ua, da, cc + 32);
            HS_PROC(ub, db, cc + 16);
        }
#undef HS_LOAD
#undef HS_PROC
    }
}
__device__ __forceinline__ float clamp60(float x) { return fminf(fmaxf(x, -60.f), 60.f); }
__device__ __forceinline__ void phase_hgrn_out(KP p, char* smem) {
    const int bid = blockIdx.x, G = gridDim.x;
    float* CUM = (float*)(smem + H_CUM); float* TOT = (float*)(smem + H_TOT);
    float* OB = (float*)(smem + H_KT);
    const bf16_t* Qp = (const bf16_t*)(p->ws + A_Q); const bf16_t* KF = (const bf16_t*)(p->ws + A_KF); const bf16_t* SC = (const bf16_t*)(p->ws + A_SC);
    const bf16_t* GATE = (const bf16_t*)(p->ws + A_GATE); bf16_t* YAB = (bf16_t*)(p->ws + A_YAB); const float* ONORM = p->in[5];
    const bf16_t* V = (const bf16_t*)(p->ws + A_V); const float* LOGF = (const float*)(p->ws + A_LOGF); unsigned* VT = (unsigned*)(smem + H_VT);
    f32x4 lf[8]; unsigned va[4], vb[4];
#define HO_LOAD(uu) do { const int c_ = (uu) >> 2, h_ = (uu) & 3; const int t_ = tid_(); _Pragma("unroll") for (int q = 0; q < 8; ++q) { const int dr_ = q >> 2, s_ = ((t_ >> 5) + q * 16) & 63; \
        lf[q] = *(const f32x4*)(LOGF + ((size_t)dr_ * S + c_ * 64 + s_) * 512 + h_ * 128 + (t_ & 31) * 4); } \
        _Pragma("unroll") for (int q = 0; q < 4; ++q) { const bf16_t* vp_ = V + (size_t)(c_ * 64 + 2 * ((t_ >> 6) + q * 8)) * 512 + h_ * 128 + 2 * (t_ & 63); va[q] = *(const unsigned*)vp_; vb[q] = *(const unsigned*)(vp_ + 512); } } while (0)
    if (bid < 1024) HO_LOAD(bid);
    for (int u = bid; u < 1024; u += G) {
        const int c = u >> 2, h = u & 3, t0 = c * 64;
        const int tid = tid_(), lane = tid & 63, wv = tid >> 6, fr = lane & 15, fq = lane >> 4, kp = tid & 63, spb = tid >> 6;
        const int tt = wv & 3, dir = wv >> 2;
        const float* cum = CUM + dir * 64 * 128;
        const int midrow = dir == 0 ? 31 : 32;
        const int trow = tt * 16 + fr;
#pragma unroll
        for (int q = 0; q < 8; ++q) { const int dr_ = q >> 2, s_ = ((tid >> 5) + q * 16) & 63; *(f32x4*)(CUM + (dr_ * 64 + s_) * 128 + (tid & 31) * 4) = lf[q]; }
#pragma unroll
        for (int q = 0; q < 4; ++q) { const int sp = spb + q * 8;
            VT[(2 * kp) * 34 + sp] = (va[q] & 0xffffu) | (vb[q] << 16); VT[(2 * kp + 1) * 34 + sp] = (va[q] >> 16) | (vb[q] & 0xffff0000u); }
        u32x4 qvr[4];
#pragma unroll
        for (int ks = 0; ks < 4; ++ks) qvr[ks] = *(const u32x4*)(Qp + (size_t)(t0 + trow) * 512 + h * 128 + ks * 32 + fq * 8);
        __syncthreads();
        if (tid < 256) {
            const int dr = tid >> 7, k = tid & 127; float* col = CUM + dr * 64 * 128 + k; float run = 0.f;
#pragma unroll
            for (int b4 = 0; b4 < 4; ++b4) { float v[16];
#pragma unroll
                for (int s2 = 0; s2 < 16; ++s2) v[s2] = col[(b4 * 16 + s2) * 128];
#pragma unroll
                for (int s2 = 0; s2 < 16; ++s2) { const float x = v[s2]; if (dr == 0) { run += x; v[s2] = run; } else { v[s2] = run; run += x; } }
#pragma unroll
                for (int s2 = 0; s2 < 16; ++s2) col[(b4 * 16 + s2) * 128] = v[s2]; }
            TOT[dr * 128 + k] = run;
        }
        __syncthreads();
        bf16x8 qm[4], qi[4];
#pragma unroll
        for (int ks = 0; ks < 4; ++ks) {
            const int k0 = ks * 32 + fq * 8;
            const u32x4 qv = qvr[ks];
            unsigned om[4], oi[4];
#pragma unroll
            for (int jj = 0; jj < 4; ++jj) {
                const float q0 = bf_lo(qv[jj]), q1 = bf_hi(qv[jj]);
                const int ka = k0 + 2 * jj, kb = ka + 1;
                const float ca = cum[trow * 128 + ka], cb = cum[trow * 128 + kb], ma = cum[midrow * 128 + ka], mb = cum[midrow * 128 + kb];
                float em0, em1, ei0, ei1;
                if (dir == 0) { em0 = __expf(clamp60(ca - ma)); em1 = __expf(clamp60(cb - mb)); ei0 = __expf(ca); ei1 = __expf(cb); }
                else { em0 = __expf(clamp60(ma - ca)); em1 = __expf(clamp60(mb - cb)); ei0 = __expf(TOT[128 + ka] - ca); ei1 = __expf(TOT[128 + kb] - cb); }
                om[jj] = pk_bf16(q0 * em0, q1 * em1); oi[jj] = pk_bf16(q0 * ei0, q1 * ei1);
            }
            u32x4 tm = {om[0], om[1], om[2], om[3]}, ti = {oi[0], oi[1], oi[2], oi[3]};
            qm[ks] = __builtin_bit_cast(bf16x8, tm); qi[ks] = __builtin_bit_cast(bf16x8, ti);
        }
        f32x4 acc[8];
#pragma unroll
        for (int vt = 0; vt < 8; ++vt) acc[vt] = (f32x4){0.f, 0.f, 0.f, 0.f};
        unsigned pst[4][2];
#pragma unroll
        for (int st = 0; st < 4; ++st) {
            f32x4 sc = {0.f, 0.f, 0.f, 0.f};
            const bool need = dir == 0 ? (st <= tt) : (st >= tt);
            if (need) {
                const int srow = st * 16 + fr;
#pragma unroll
                for (int ks = 0; ks < 4; ++ks) {
                    const int k0 = ks * 32 + fq * 8;
                    const u32x4 kv = *(const u32x4*)(KF + ((size_t)dir * S + t0 + srow) * 512 + h * 128 + k0);
                    unsigned ok[4];
#pragma unroll
                    for (int jj = 0; jj < 4; ++jj) {
                        const int ka = k0 + 2 * jj, kb = ka + 1;
                        const float ca = cum[srow * 128 + ka], cb = cum[srow * 128 + kb], ma = cum[midrow * 128 + ka], mb = cum[midrow * 128 + kb];
                        float e0, e1;
                        if (dir == 0) { e0 = __expf(clamp60(ma - ca)); e1 = __expf(clamp60(mb - cb)); } else { e0 = __expf(clamp60(ca - ma)); e1 = __expf(clamp60(cb - mb)); }
                        ok[jj] = pk_bf16(bf_lo(kv[jj]) * e0, bf_hi(kv[jj]) * e1);
                    }
                    u32x4 tk = {ok[0], ok[1], ok[2], ok[3]};
                    sc = mfma16(__builtin_bit_cast(bf16x8, tk), qm[ks], sc);
                }
            }
            float pv[4];
#pragma unroll
            for (int i = 0; i < 4; ++i) { const int s = st * 16 + 4 * fq + i; const bool ok2 = need && (dir == 0 ? (s <= trow) : (s >= trow)); pv[i] = ok2 ? sc[i] : 0.f; }
            pst[st][0] = pk_bf16(pv[0], pv[1]); pst[st][1] = pk_bf16(pv[2], pv[3]);
        }
        {
            const char* vtb = smem + H_VT;
#pragma unroll
            for (int pp = 0; pp < 2; ++pp) {
                const int a = 2 * pp, b = 2 * pp + 1;
                u32x4 ty = {pst[a][0], pst[a][1], pst[b][0], pst[b][1]};
                const bf16x8 yf = __builtin_bit_cast(bf16x8, ty);
#pragma unroll
                for (int vt = 0; vt < 8; ++vt) {
                    const char* r0 = vtb + ((vt * 16 + fr) * 68) * 2;
                    const u32x2 lo = *(const u32x2*)(r0 + (16 * a + 4 * fq) * 2), hi = *(const u32x2*)(r0 + (16 * b + 4 * fq) * 2);
                    u32x4 tx = {lo[0], lo[1], hi[0], hi[1]};
                    acc[vt] = mfma16(__builtin_bit_cast(bf16x8, tx), yf, acc[vt]);
                }
            }
        }
        {
            const bf16_t* scb = SC + ((size_t)((c * 4 + h) * 2 + dir)) * 16384;
#pragma unroll
            for (int ks = 0; ks < 4; ++ks)
#pragma unroll
                for (int vt = 0; vt < 8; ++vt) {
                    const u32x4 sv = *(const u32x4*)(scb + (size_t)(vt * 16 + fr) * 128 + ks * 32 + fq * 8);
                    acc[vt] = mfma16(__builtin_bit_cast(bf16x8, sv), qi[ks], acc[vt]);
                }
        }
        if (u + G < 1024) HO_LOAD(u + G);
        __syncthreads();
        if (dir == 1) {
#pragma unroll
            for (int vt = 0; vt < 8; ++vt) *(f32x4*)(OB + ((tt * 64 + lane) * 32 + vt * 4)) = acc[vt];
        }
        __syncthreads();
        if (dir == 0) {
            float ss = 0.f;
#pragma unroll
            for (int vt = 0; vt < 8; ++vt) { const f32x4 o = *(const f32x4*)(OB + ((tt * 64 + lane) * 32 + vt * 4)); acc[vt] += o;
                ss += acc[vt][0] * acc[vt][0] + acc[vt][1] * acc[vt][1] + acc[vt][2] * acc[vt][2] + acc[vt][3] * acc[vt][3]; }
            ss += __shfl_xor(ss, 16); ss += __shfl_xor(ss, 32);
            const float rs = rsqrtf(ss * (1.f / 128.f) + 1e-6f);
            const int t = t0 + trow;
#pragma unroll
            for (int vt = 0; vt < 8; ++vt) {
                const int v = vt * 16 + 4 * fq;
                const f32x4 on = *(const f32x4*)(ONORM + h * 128 + v); const f32x4 g = bf4_to_f32(*(const u32x2*)(GATE + (size_t)t * 512 + h * 128 + v));
                u32x2 o; o[0] = pk_bf16(acc[vt][0] * rs * on[0] * g[0], acc[vt][1] * rs * on[1] * g[1]); o[1] = pk_bf16(acc[vt][2] * rs * on[2] * g[2], acc[vt][3] * rs * on[3] * g[3]);
                *(u32x2*)(YAB + (size_t)t * 1024 + h * 128 + v) = o;
            }
        }
        __syncthreads();
    }
#undef HO_LOAD
}

constexpr int AT_VT = 0;
constexpr int AT_VTS = 274;
constexpr int AT_BIAS = 35072;
constexpr int AT_CVT = 77824;
constexpr int AT_KL = 36864;
__device__ __forceinline__ void phase_attention(KP p, char* smem) {
    const int bid = blockIdx.x, G = gridDim.x, tid = tid_(), lane = tid & 63, wv = tid >> 6, fr = lane & 15, fq = lane >> 4;
    const bf16_t* AQ = (const bf16_t*)(p->ws + A_AQ); const bf16_t* AK = (const bf16_t*)(p->ws + A_AK); const bf16_t* AV = (const bf16_t*)(p->ws + A_AV);
    bf16_t* ATTO = (bf16_t*)(p->ws + A_ATTO); float* ATTL = (float*)(p->ws + WS_ATTL); const float* BI = (const float*)(p->ws + WS_BIAS);
    bf16_t* VT = (bf16_t*)(smem + AT_VT); float* BS = (float*)(smem + AT_BIAS);
    float* cvtile = (float*)(smem + AT_CVT);
    f32x4 cvpf[8]; int cvprev = -1;
    for (int u = bid; u < 3072; u += G) {
        cv_request(p, 0, 4, u, cvpf);
        if (cvprev >= 0) cv_store(p, 0, 4, cvprev, cvtile);
        const int g = u >> 10, rem = u & 1023, h = rem & 7, blk = rem >> 3;
        const int dil = g == 0 ? 1 : g == 1 ? 4 : 16, L = S / dil;
        const int r = blk % dil, jb = blk / dil, j0 = jb * 128, jw0 = j0 - 64;
        const int jq = j0 + 16 * wv + fr;
        const size_t qtok = (size_t)jq * dil + r;
        f32x4 sc[9];
        bf16x8 qf[2];
        {
            const int s = tid & 255, dq = tid >> 8;
            const int j = jw0 + s; const bool ok = (j >= 0 && j < L);
            const size_t tok = ok ? (size_t)j * dil + r : 0;
            u32x4 vreg[4], kreg[4];
#pragma unroll
            for (int cch = 0; cch < 4; ++cch) { vreg[cch] = (u32x4){0u, 0u, 0u, 0u}; kreg[cch] = (u32x4){0u, 0u, 0u, 0u};
                if (ok) { vreg[cch] = *(const u32x4*)(AV + tok * 512 + h * 64 + dq * 32 + cch * 8); kreg[cch] = *(const u32x4*)(AK + tok * 512 + h * 64 + dq * 32 + cch * 8); } }
#pragma unroll
            for (int ks = 0; ks < 2; ++ks) { const u32x4 t = *(const u32x4*)(AQ + qtok * 512 + h * 64 + ks * 32 + fq * 8); qf[ks] = __builtin_bit_cast(bf16x8, t); }
#pragma unroll
            for (int cch = 0; cch < 4; ++cch) {
                const int dh0 = dq * 32 + cch * 8; const u32x4 v = vreg[cch];
                *(u32x4*)(smem + AT_KL + s * 144 + dh0 * 2) = kreg[cch];
#pragma unroll
                for (int i = 0; i < 4; ++i) { VT[(dh0 + 2 * i) * AT_VTS + s] = (bf16_t)(v[i] & 0xffffu); VT[(dh0 + 2 * i + 1) * AT_VTS + s] = (bf16_t)(v[i] >> 16); }
            }
            for (int i = tid; i < 64 * 18; i += NTHR) { const int dh = i / 18, ss = 256 + (i % 18); VT[dh * AT_VTS + ss] = 0; }
            if (tid < 160) BS[tid] = (tid >= 16 && tid <= 144) ? BI[(g * 8 + h) * 132 + tid - 16] : -1e30f;
        }
        __syncthreads();
#pragma unroll
        for (int st = 0; st < 9; ++st) {
            f32x4 d = {0.f, 0.f, 0.f, 0.f};
#pragma unroll
            for (int ks = 0; ks < 2; ++ks) { const u32x4 t = *(const u32x4*)(smem + AT_KL + (16 * wv + 16 * st + fr) * 144 + ks * 64 + fq * 16); d = mfma16(__builtin_bit_cast(bf16x8, t), qf[ks], d); }
            sc[st] = d;
        }
        {
            float mx = -1e30f;
            const float* bsl = BS + 16 + 4 * fq - fr;
#pragma unroll
            for (int st = 0; st < 9; ++st)
#pragma unroll
                for (int i = 0; i < 4; ++i) sc[st][i] += bsl[16 * st + i];
            if (jw0 < 0 || jw0 + 256 > L) {
#pragma unroll
                for (int st = 0; st < 9; ++st)
#pragma unroll
                    for (int i = 0; i < 4; ++i) { const int jk = j0 + 16 * wv - 64 + 16 * st + 4 * fq + i; if (jk < 0 || jk >= L) sc[st][i] = -1e30f; }
            }
#pragma unroll
            for (int st = 0; st < 9; ++st)
#pragma unroll
                for (int i = 0; i < 4; ++i) mx = fmaxf(mx, sc[st][i]);
            mx = fmaxf(mx, __shfl_xor(mx, 16)); mx = fmaxf(mx, __shfl_xor(mx, 32));
            float sum = 0.f; unsigned pst[10][2];
#pragma unroll
            for (int st = 0; st < 9; ++st) {
                float pv[4];
#pragma unroll
                for (int i = 0; i < 4; ++i) { pv[i] = __expf(sc[st][i] - mx); sum += pv[i]; }
                pst[st][0] = pk_bf16(pv[0], pv[1]); pst[st][1] = pk_bf16(pv[2], pv[3]);
            }
            pst[9][0] = 0u; pst[9][1] = 0u;
            sum += __shfl_xor(sum, 16); sum += __shfl_xor(sum, 32);
            f32x4 o[4];
#pragma unroll
            for (int dt = 0; dt < 4; ++dt) o[dt] = (f32x4){0.f, 0.f, 0.f, 0.f};
#pragma unroll
            for (int pp = 0; pp < 5; ++pp) {
                const int a = 2 * pp, b = 2 * pp + 1;
                u32x4 ty = {pst[a][0], pst[a][1], pst[b][0], pst[b][1]};
                const bf16x8 yf = __builtin_bit_cast(bf16x8, ty);
#pragma unroll
                for (int dt = 0; dt < 4; ++dt) {
                    const bf16_t* row = VT + (dt * 16 + fr) * AT_VTS + 16 * wv + 4 * fq;
                    const unsigned a0 = *(const unsigned*)(row + 16 * a), a1 = *(const unsigned*)(row + 16 * a + 2);
                    const unsigned b0 = *(const unsigned*)(row + 16 * b), b1 = *(const unsigned*)(row + 16 * b + 2);
                    u32x4 tx = {a0, a1, b0, b1};
                    o[dt] = mfma16(__builtin_bit_cast(bf16x8, tx), yf, o[dt]);
                }
            }
            const float inv = 1.f / sum;
            bf16_t* ob = ATTO + ((size_t)g * S + qtok) * 512 + h * 64;
#pragma unroll
            for (int dt = 0; dt < 4; ++dt) { const f32x4 ov = o[dt] * inv; u32x2 oo = {pk_bf16(ov[0], ov[1]), pk_bf16(ov[2], ov[3])}; *(u32x2*)(ob + dt * 16 + 4 * fq) = oo; }
            if (fq == 0) ATTL[((size_t)g * S + qtok) * 8 + h] = mx + __logf(sum);
        }
        cv_to_lds(cvpf, cvtile); cvprev = u;
        __syncthreads();
    }
    if (cvprev >= 0) cv_store(p, 0, 4, cvprev, cvtile);
    __syncthreads();
}
__device__ __forceinline__ void phase_attn_merge(KP p) {
    const int G = gridDim.x;
    const bf16_t* ATTO = (const bf16_t*)(p->ws + A_ATTO); const float* ATTL = (const float*)(p->ws + WS_ATTL); bf16_t* YAB = (bf16_t*)(p->ws + A_YAB);
    for (int i = blockIdx.x * NTHR + tid_(); i < S * 128; i += G * NTHR) {
        const int t = i >> 7, c = (i & 127) * 4, h = c >> 6;
        const float l0 = ATTL[((size_t)0 * S + t) * 8 + h], l1 = ATTL[((size_t)1 * S + t) * 8 + h], l2 = ATTL[((size_t)2 * S + t) * 8 + h];
        const float mx = fmaxf(l0, fmaxf(l1, l2)); const float e0 = __expf(l0 - mx), e1 = __expf(l1 - mx), e2 = __expf(l2 - mx); const float inv = 1.f / (e0 + e1 + e2);
        const f32x4 a = bf4_to_f32(*(const u32x2*)(ATTO + ((size_t)0 * S + t) * 512 + c)), b = bf4_to_f32(*(const u32x2*)(ATTO + ((size_t)1 * S + t) * 512 + c)), d = bf4_to_f32(*(const u32x2*)(ATTO + ((size_t)2 * S + t) * 512 + c));
        const f32x4 y = (a * e0 + b * e1 + d * e2) * inv;
        u32x2 o; o[0] = pk_bf16(y[0], y[1]); o[1] = pk_bf16(y[2], y[3]);
        *(u32x2*)(YAB + (size_t)t * 1024 + 512 + c) = o;
    }
}

__device__ __forceinline__ void phase_moe_router(KP p, int layer, const float* __restrict__ X, char* smem) {
    const int bid = blockIdx.x, G = gridDim.x, tid = tid_(), lane = tid & 63, wv = tid >> 6, fr = lane & 15, fq = lane >> 4;
    float* RT = (float*)smem;
    float* XCH = (float*)(smem + 65536);
    const float* R = p->in[26] + (size_t)layer * 1024 * 16; const float* gain = p->in[25] + (size_t)layer * 1024;
    for (int i = tid; i < 16384; i += NTHR) { const int k = i >> 4, e = i & 15; RT[e * 1024 + k] = R[i] * gain[k]; }
    __syncthreads();
    float* AFF = (float*)(p->ws + WS_AFF); int* SLOT = (int*)(p->ws + WS_SLOT); float* RSTD = (float*)(p->ws + WS_RSTD);
    const int tw = wv & 3, kh = wv >> 2;
    for (int T = bid * 4 + tw; T < S / 16; T += G * 4) {
        const int t0 = T * 16;
        f32x4 acc = {0.f, 0.f, 0.f, 0.f}; float ssq = 0.f;
        const float* xr = X + (size_t)(t0 + fr) * 1024 + kh * 512 + 4 * fq;
        const float* rr = RT + fr * 1024 + kh * 512 + 4 * fq;
#pragma unroll 1
        for (int jb = 0; jb < 4; ++jb) {
            f32x4 xa[8];
#pragma unroll
            for (int j = 0; j < 8; ++j) xa[j] = *(const f32x4*)(xr + (jb * 8 + j) * 16);
#pragma unroll
            for (int j = 0; j < 8; ++j) {
                const f32x4 rb = *(const f32x4*)(rr + (jb * 8 + j) * 16);
#pragma unroll
                for (int i = 0; i < 4; ++i) { acc = __builtin_amdgcn_mfma_f32_16x16x4f32(xa[j][i], rb[i], acc, 0, 0, 0); ssq += xa[j][i] * xa[j][i]; }
            }
        }
        ssq += __shfl_xor(ssq, 16); ssq += __shfl_xor(ssq, 32);
        if (kh == 1) { float* o = XCH + (tw * 64 + lane) * 5; o[0] = acc[0]; o[1] = acc[1]; o[2] = acc[2]; o[3] = acc[3]; o[4] = ssq; }
        __syncthreads();
        if (kh == 0) {
            const float* o = XCH + (tw * 64 + lane) * 5;
            acc[0] += o[0]; acc[1] += o[1]; acc[2] += o[2]; acc[3] += o[3]; ssq += o[4];
            const float rs_own = rsqrtf(ssq * (1.f / 1024.f) + 1e-6f);
            if (fq == 0) RSTD[t0 + fr] = rs_own;
            float aff[4];
#pragma unroll
            for (int r = 0; r < 4; ++r) {
                const float rs = __shfl(rs_own, 4 * fq + r);
                const float lg = acc[r] * rs;
                float mx = lg;
                mx = fmaxf(mx, __shfl_xor(mx, 1)); mx = fmaxf(mx, __shfl_xor(mx, 2)); mx = fmaxf(mx, __shfl_xor(mx, 4)); mx = fmaxf(mx, __shfl_xor(mx, 8));
                const float ex = expf(lg - mx);
                float sm = ex;
                sm += __shfl_xor(sm, 1); sm += __shfl_xor(sm, 2); sm += __shfl_xor(sm, 4); sm += __shfl_xor(sm, 8);
                aff[r] = ex / sm;
                SLOT[(size_t)(t0 + 4 * fq + r) * 16 + fr] = -1;
            }
            const f32x4 av = {aff[0], aff[1], aff[2], aff[3]};
            *(f32x4*)(AFF + (size_t)fr * S + t0 + 4 * fq) = av;
        }
        __syncthreads();
    }
}
__device__ __forceinline__ void phase_moe_select(KP p, char* smem) {
    const int bid = blockIdx.x, G = gridDim.x, tid = tid_(), lane = tid & 63, wv = tid >> 6;
    unsigned* vals = (unsigned*)smem; unsigned* hist = vals + 16384; unsigned* misc = hist + 256; unsigned* wsum = misc + 16;
    const float* AFF = (const float*)(p->ws + WS_AFF); int* SLOT = (int*)(p->ws + WS_SLOT); int* IDX = (int*)(p->ws + WS_IDX); float* GW = (float*)(p->ws + WS_GATEW);
    const float* RSTD = (const float*)(p->ws + WS_RSTD); float* RSE = (float*)(p->ws + WS_RSTDE);
    for (int e = bid; e < 16; e += G) {
        for (int i = tid; i < 16384; i += NTHR) vals[i] = __float_as_uint(AFF[(size_t)e * S + i]);
        unsigned long long prefix = 0ull; unsigned remaining = 2048u;
        for (int pass = 0; pass < 6; ++pass) {
            const int shift = 40 - 8 * pass;
            if (tid < 256) hist[tid] = 0u;
            __syncthreads();
            {
                unsigned cur = 0u, cn = 0u;
                for (int i = tid; i < 16384; i += NTHR) {
                    const unsigned long long key = ((unsigned long long)vals[i] << 14) | (unsigned long long)(16383 - i);
                    if ((key >> (shift + 8)) == prefix) { const unsigned d = (unsigned)(key >> shift) & 255u;
                        if (cn != 0u && d == cur) ++cn; else { if (cn != 0u) atomicAdd(&hist[cur], cn); cur = d; cn = 1u; } }
                }
                if (cn != 0u) atomicAdd(&hist[cur], cn);
            }
            __syncthreads();
            if (wv == 0) {
                unsigned cj[4]; unsigned loc = 0u;
#pragma unroll
                for (int j = 0; j < 4; ++j) { cj[j] = hist[255 - (4 * lane + j)]; loc += cj[j]; }
                unsigned inc = loc;
#pragma unroll
                for (int o = 1; o < 64; o <<= 1) { const unsigned t = __shfl_up(inc, o); if (lane >= o) inc += t; }
                unsigned before = inc - loc;
#pragma unroll
                for (int j = 0; j < 4; ++j) { if (before < remaining && remaining <= before + cj[j]) { misc[0] = 255u - (unsigned)(4 * lane + j); misc[1] = remaining - before; } before += cj[j]; }
            }
            __syncthreads();
            prefix = (prefix << 8) | (unsigned long long)misc[0]; remaining = misc[1];
            __syncthreads();
        }
        const int tb = tid * 32; unsigned sel = 0u; unsigned cnt = 0u;
#pragma unroll 4
        for (int i = 0; i < 32; ++i) { const int t = tb + i; const unsigned long long key = ((unsigned long long)vals[t] << 14) | (unsigned long long)(16383 - t); if (key >= prefix) { sel |= 1u << i; ++cnt; } }
        unsigned inc = cnt;
#pragma unroll
        for (int o = 1; o < 64; o <<= 1) { const unsigned t = __shfl_up(inc, o); if (lane >= o) inc += t; }
        if (lane == 63) wsum[wv] = inc;
        __syncthreads();
        unsigned base = inc - cnt;
        for (int w = 0; w < wv; ++w) base += wsum[w];
        for (int i = 0; i < 32; ++i) if (sel & (1u << i)) { const int t = tb + i; if (base < 2048u) { IDX[e * 2048 + base] = t; GW[e * 2048 + base] = __uint_as_float(vals[t]); RSE[e * 2048 + base] = RSTD[t]; SLOT[(size_t)t * 16 + e] = (int)base; } ++base; }
        __syncthreads();
    }
}
__device__ __forceinline__ void phase_moe_gather(KP p) {
    const int G = gridDim.x, lane = tid_() & 63, wv = tid_() >> 6;
    const bf16_t* HB = (const bf16_t*)(p->ws + M_HB); bf16_t* XE = (bf16_t*)(p->ws + M_XE); const int* IDX = (const int*)(p->ws + WS_IDX);
    for (int r = blockIdx.x * 8 + wv; r < 32768; r += G * 8) {
        const int t = IDX[r];
        const u32x4 a = *(const u32x4*)(HB + (size_t)t * 1024 + lane * 8), b = *(const u32x4*)(HB + (size_t)t * 1024 + 512 + lane * 8);
        *(u32x4*)(XE + (size_t)r * 1024 + lane * 8) = a; *(u32x4*)(XE + (size_t)r * 1024 + 512 + lane * 8) = b;
    }
}
__device__ __forceinline__ void moe_add_rows(float4 (&v)[4], const bf16_t* __restrict__ YE, int myslot, int lane) {
    unsigned mask = (unsigned)(__ballot(lane < 16 && myslot >= 0) & 0xFFFFull);
    while (mask) {
        u32x2 a[4][4]; int cnt = 0;
#pragma unroll
        for (int k = 0; k < 4; ++k) {
            if (mask) { const int e = __builtin_ctz(mask); mask &= mask - 1; const int sl = __shfl(myslot, e); ++cnt;
                const bf16_t* y = YE + ((size_t)e * 2048 + sl) * 1024;
#pragma unroll
                for (int i = 0; i < 4; ++i) a[k][i] = *(const u32x2*)(y + (i * 64 + lane) * 4); }
            else {
#pragma unroll
                for (int i = 0; i < 4; ++i) a[k][i] = (u32x2){0u, 0u}; }
        }
#pragma unroll
        for (int k = 0; k < 4; ++k)
#pragma unroll
            for (int i = 0; i < 4; ++i) { v[i].x += bf_lo(a[k][i][0]); v[i].y += bf_hi(a[k][i][0]); v[i].z += bf_lo(a[k][i][1]); v[i].w += bf_hi(a[k][i][1]); }
        (void)cnt;
    }
}
__device__ __forceinline__ void phase_moe_combine(KP p, const float* __restrict__ Xin, float* __restrict__ Xout, const float* __restrict__ gain, float* __restrict__ Hout) {
    const int G = gridDim.x, lane = tid_() & 63, wv = tid_() >> 6;
    const bf16_t* YE = (const bf16_t*)(p->ws + M_YE); const int* SLOT = (const int*)(p->ws + WS_SLOT);
    float4 vn[4]; int slotn = -1;
    { const int r0 = blockIdx.x * 8 + wv;
      if (r0 < S) {
#pragma unroll
          for (int i = 0; i < 4; ++i) vn[i] = *(const float4*)(Xin + (size_t)r0 * 1024 + (i * 64 + lane) * 4);
          slotn = lane < 16 ? SLOT[(size_t)r0 * 16 + lane] : -1; } }
    for (int r = blockIdx.x * 8 + wv; r < S; r += G * 8) {
        float4 v[4];
#pragma unroll
        for (int i = 0; i < 4; ++i) v[i] = vn[i];
        const int myslot = slotn;
        { const int rn = r + G * 8;
          if (rn < S) {
#pragma unroll
              for (int i = 0; i < 4; ++i) vn[i] = *(const float4*)(Xin + (size_t)rn * 1024 + (i * 64 + lane) * 4);
              slotn = lane < 16 ? SLOT[(size_t)rn * 16 + lane] : -1; } }
        moe_add_rows(v, YE, myslot, lane);
        float ss = 0.f;
#pragma unroll
        for (int i = 0; i < 4; ++i) { if (Xout) *(float4*)(Xout + (size_t)r * 1024 + (i * 64 + lane) * 4) = v[i]; ss += v[i].x * v[i].x + v[i].y * v[i].y + v[i].z * v[i].z + v[i].w * v[i].w; }
        ss = wave_sum(ss);
        const float rs = rsqrtf(ss * (1.f / 1024.f) + 1e-6f);
#pragma unroll
        for (int i = 0; i < 4; ++i) { const float4 g = *(const float4*)(gain + (i * 64 + lane) * 4);
            float4 o; o.x = v[i].x * rs * g.x; o.y = v[i].y * rs * g.y; o.z = v[i].z * rs * g.z; o.w = v[i].w * rs * g.w;
            *(float4*)(Hout + (size_t)r * 1024 + (i * 64 + lane) * 4) = o; }
    }
}
__device__ __forceinline__ void phase_combine_mix(KP p, const float* __restrict__ Xin, float* __restrict__ Xout, const float* __restrict__ gain, char* smem) {
    const int G = gridDim.x, tid = tid_(), lane = tid & 63, wv = tid >> 6;
    const bf16_t* YE = (const bf16_t*)(p->ws + M_YE); const int* SLOT = (const int*)(p->ws + WS_SLOT);
    bf16_t* MIX = (bf16_t*)(p->ws + R_MIX); const float* mu = p->in[8]; const float* muw = p->in[9];
    for (int u = blockIdx.x; u < 256; u += G) {
        const int r0 = u * 64 - 1;
        float4 vn[4]; int slotn = -1;
        { const int rf = r0 + wv;
          if (rf >= 0 && rf < S) {
#pragma unroll
              for (int i = 0; i < 4; ++i) vn[i] = *(const float4*)(Xin + (size_t)rf * 1024 + (i * 64 + lane) * 4);
              slotn = lane < 16 ? SLOT[(size_t)rf * 16 + lane] : -1; } }
        for (int j = wv; j < 66; j += 8) {
            const int r = r0 + j;
            u32x2* hrow = (u32x2*)(smem + j * 2048);
            float4 v[4];
#pragma unroll
            for (int i = 0; i < 4; ++i) v[i] = vn[i];
            const int myslot = slotn;
            { const int rn = r + 8;
              if (j + 8 < 66 && rn >= 0 && rn < S) {
#pragma unroll
                  for (int i = 0; i < 4; ++i) vn[i] = *(const float4*)(Xin + (size_t)rn * 1024 + (i * 64 + lane) * 4);
                  slotn = lane < 16 ? SLOT[(size_t)rn * 16 + lane] : -1; } }
            if (r < 0 || r >= S) {
#pragma unroll
                for (int i = 0; i < 4; ++i) { u32x2 zz = {0u, 0u}; hrow[i * 64 + lane] = zz; }
                continue;
            }
            moe_add_rows(v, YE, myslot, lane);
            float ss = 0.f;
#pragma unroll
            for (int i = 0; i < 4; ++i) { if (j >= 1 && j <= 64) *(float4*)(Xout + (size_t)r * 1024 + (i * 64 + lane) * 4) = v[i]; ss += v[i].x * v[i].x + v[i].y * v[i].y + v[i].z * v[i].z + v[i].w * v[i].w; }
            ss = wave_sum(ss);
            const float rs = rsqrtf(ss * (1.f / 1024.f) + 1e-6f);
#pragma unroll
            for (int i = 0; i < 4; ++i) { const float4 g = *(const float4*)(gain + (i * 64 + lane) * 4);
                u32x2 o; o[0] = pk_bf16(v[i].x * rs * g.x, v[i].y * rs * g.y); o[1] = pk_bf16(v[i].z * rs * g.z, v[i].w * rs * g.w); hrow[i * 64 + lane] = o; }
        }
        __syncthreads();
        for (int j = 1 + wv; j <= 64; j += 8) {
            const int r = r0 + j;
#pragma unroll
            for (int i = 0; i < 2; ++i) {
                const int c = (i * 64 + lane) * 8;
                const u32x4 hb = ((const u32x4*)(smem + j * 2048))[i * 64 + lane], pb = ((const u32x4*)(smem + (j - 1) * 2048))[i * 64 + lane], nb = ((const u32x4*)(smem + (j + 1) * 2048))[i * 64 + lane];
                const u32x2 hb0 = {hb[0], hb[1]}, hb1 = {hb[2], hb[3]}, pb0 = {pb[0], pb[1]}, pb1 = {pb[2], pb[3]}, nb0 = {nb[0], nb[1]}, nb1 = {nb[2], nb[3]};
                const f32x4 h0 = bf4_to_f32(hb0), h1 = bf4_to_f32(hb1);
                const f32x4 xx0 = (bf4_to_f32(pb0) + bf4_to_f32(nb0)) * 0.5f - h0, xx1 = (bf4_to_f32(pb1) + bf4_to_f32(nb1)) * 0.5f - h1;
#pragma unroll
                for (int q = 0; q < 7; ++q) {
                    const float* mp = (q < 5 ? mu + q * 1024 : muw + (q - 5) * 1024) + c;
                    const f32x4 m0 = *(const f32x4*)mp, m1 = *(const f32x4*)(mp + 4);
                    *(u32x4*)(MIX + ((size_t)q * S + r) * 1024 + c) = pk8(h0 + xx0 * m0, h1 + xx1 * m1);
                }
            }
        }
        __syncthreads();
    }
}
__device__ __forceinline__ void moe_gemms_gateup(KP p, char* smem) {
    const bf16_t* HB = (const bf16_t*)(p->ws + M_HB); const int* IDX = (const int*)(p->ws + WS_IDX); const bf16_t* GU = (const bf16_t*)(p->ws + WS_BT_GU); bf16_t* HID = (bf16_t*)(p->ws + M_HID);
    int pre = 0;
    for (int L = blockIdx.x; L < 16 * 128; L += gridDim.x) {
        const int rr = L >> 8, x = L & 7, i = (L >> 3) & 31, e = 2 * rr + (x >> 2), pm = (x & 1) * 4 + (i & 3), pn = ((x >> 1) & 1) * 8 + (i >> 2);
        const int Ln = L + gridDim.x; GemmNext nx{HB, nullptr, nullptr, 0, 0, Ln < 16 * 128 ? 1 : 0};
        if (nx.valid) { const int rr2 = Ln >> 8, x2 = Ln & 7, i2 = (Ln >> 3) & 31, e2 = 2 * rr2 + (x2 >> 2);
            nx.Bt = GU + (size_t)e2 * 4096 * 512; nx.gidx = IDX + e2 * 2048; nx.brow = ((x2 & 1) * 4 + (i2 & 3)) * 256; nx.bcol = (((x2 >> 1) & 1) * 8 + (i2 >> 2)) * 256; }
        EpiSwiglu E{HID + (size_t)e * 2048 * 1024, (const float*)(p->ws + WS_RSTDE) + e * 2048};
        gemm_tile<EpiSwiglu, true, true>(HB, GU + (size_t)e * 4096 * 512, 512, pm * 256, pn * 256, (bf16_t*)smem, E, IDX + e * 2048, pre, nx);
        pre = nx.valid;
    }
}
__device__ __forceinline__ void moe_gemms_down(KP p, char* smem) {
    const bf16_t* HID = (const bf16_t*)(p->ws + M_HID); const bf16_t* DN = (const bf16_t*)(p->ws + WS_BT_DN); bf16_t* YE = (bf16_t*)(p->ws + M_YE); const float* GW = (const float*)(p->ws + WS_GATEW);
    int pre = 0;
    for (int L = blockIdx.x; L < 16 * 32; L += gridDim.x) {
        const int rr = L >> 8, x = L & 7, i = (L >> 3) & 31, e = 8 * rr + x, pm = i & 7, pn = i >> 3;
        const int Ln = L + gridDim.x; GemmNext nx{nullptr, nullptr, nullptr, 0, 0, Ln < 16 * 32 ? 1 : 0};
        if (nx.valid) { const int e2 = 8 * (Ln >> 8) + (Ln & 7), i2 = (Ln >> 3) & 31; nx.A = HID + (size_t)e2 * 2048 * 1024; nx.Bt = DN + (size_t)e2 * 1024 * 1024; nx.brow = (i2 & 7) * 256; nx.bcol = (i2 >> 3) * 256; }
        EpiDown E{YE + (size_t)e * 2048 * 1024, GW + e * 2048};
        gemm_tile<EpiDown, false, true>(HID + (size_t)e * 2048 * 1024, DN + (size_t)e * 1024 * 1024, 1024, pm * 256, pn * 256, (bf16_t*)smem, E, nullptr, pre, nx);
        pre = nx.valid;
    }
}

__device__ __forceinline__ void phase_rwkv_mix(KP p) {
    const int G = gridDim.x, lane = tid_() & 63, wv = tid_() >> 6;
    const float* H1 = (const float*)(p->ws + R_H1); bf16_t* MIX = (bf16_t*)(p->ws + R_MIX);
    const float* mu = p->in[8]; const float* muw = p->in[9];
    for (int r = blockIdx.x * 8 + wv; r < S; r += G * 8) {
#pragma unroll
        for (int i = 0; i < 4; ++i) {
            const int c = (i * 64 + lane) * 4;
            const f32x4 h = *(const f32x4*)(H1 + (size_t)r * 1024 + c);
            f32x4 hp = {0.f, 0.f, 0.f, 0.f}, hn = {0.f, 0.f, 0.f, 0.f};
            if (r > 0) hp = *(const f32x4*)(H1 + (size_t)(r - 1) * 1024 + c);
            if (r < S - 1) hn = *(const f32x4*)(H1 + (size_t)(r + 1) * 1024 + c);
            const f32x4 xx = (hp + hn) * 0.5f - h;
#pragma unroll
            for (int j = 0; j < 7; ++j) {
                const f32x4 m = *(const f32x4*)((j < 5 ? mu + j * 1024 : muw + (j - 5) * 1024) + c);
                const f32x4 o = h + xx * m;
                u32x2 w; w[0] = pk_bf16(o[0], o[1]); w[1] = pk_bf16(o[2], o[3]);
                *(u32x2*)(MIX + ((size_t)j * S + r) * 1024 + c) = w;
            }
        }
    }
}
__device__ __forceinline__ void phase_rwkv_prep(KP p) {
    const int G = gridDim.x;
    float* KK = (float*)(p->ws + R_KK); float* AA = (float*)(p->ws + R_AA); float* KKN = (float*)(p->ws + R_KKN);
    const float* k_k = p->in[19]; const float* k_a = p->in[20];
    for (int i = blockIdx.x * NTHR + tid_(); i < S * 256; i += G * NTHR) {
        const int t = i >> 8, c = (i & 255) * 4;
        const f32x4 k = *(const f32x4*)(KK + (size_t)t * 1024 + c), a = *(const f32x4*)(AA + (size_t)t * 1024 + c);
        const f32x4 kkw = *(const f32x4*)(k_k + c), kaw = *(const f32x4*)(k_a + c);
        f32x4 kk = k * kkw;
        float ss = kk[0] * kk[0] + kk[1] * kk[1] + kk[2] * kk[2] + kk[3] * kk[3];
        ss += __shfl_xor(ss, 1); ss += __shfl_xor(ss, 2); ss += __shfl_xor(ss, 4); ss += __shfl_xor(ss, 8);
        const float inv = 1.f / fmaxf(sqrtf(ss), 1e-12f);
        kk = kk * inv;
        f32x4 kn, b;
#pragma unroll
        for (int j = 0; j < 4; ++j) { kn[j] = k[j] * (1.f + (a[j] - 1.f) * kaw[j]); b[j] = kk[j] * a[j]; }
        *(f32x4*)(KKN + (size_t)t * 1024 + c) = kk; *(f32x4*)(KK + (size_t)t * 1024 + c) = kn; *(f32x4*)(AA + (size_t)t * 1024 + c) = b;
    }
}
#ifndef RW_SIMPLE_INV
#define RW_SIMPLE_INV 0
#endif
constexpr int RS = 68;
constexpr int RBUF = 64 * RS * 2;
constexpr int RW_MF = 12 * RBUF;
constexpr int RW_SEG = RW_MF + 64 * 68 * 4;
constexpr int RW_PC = RW_SEG + 2048;
enum { B_AT = 0  , B_ATT = 1, B_BT = 2  , B_KT = 3  , B_RT = 4, B_BHT = 5, B_KHT = 6, B_VT = 7, B_MAK = 8, B_TT = 9, B_NBRT = 10, B_W2 = 11 };

__device__ __forceinline__ bf16x8 rw_frag(const char* buf, int row, int col) {
    const char* ad = buf + (row * RS + col) * 2;
    const u32x2 lo = *(const u32x2*)ad, hi = *(const u32x2*)(ad + 8);
    u32x4 t = {lo[0], lo[1], hi[0], hi[1]};
    return __builtin_bit_cast(bf16x8, t);
}
typedef short s16x4_t __attribute__((ext_vector_type(4)));
__device__ __forceinline__ u32x2 rw_tr4(const char* ad) {
    const s16x4_t v = __builtin_amdgcn_ds_read_tr16_b64_v4i16((s16x4_t LAS*)(unsigned)(size_t)ad);
    return __builtin_bit_cast(u32x2, v);
}
__device__ __forceinline__ bf16x8 rw_frag_tr(const char* img, int ntile, int c0, int lane) {
    const int g = lane >> 4, q = (lane & 15) >> 2, pp = lane & 3;
    const char* a0 = img + ((c0 + 8 * g + q) * RS + 16 * ntile + 4 * pp) * 2;
    const u32x2 lo = rw_tr4(a0), hi = rw_tr4(a0 + 4 * RS * 2);
    u32x4 t = {lo[0], lo[1], hi[0], hi[1]};
    return __builtin_bit_cast(bf16x8, t);
}
struct Frag2 { bf16x8 f[2]; };
__device__ __forceinline__ Frag2 rw_frag2(const char* buf, int tile, int fr, int fq) { Frag2 r; r.f[0] = rw_frag(buf, tile * 16 + fr, fq * 8); r.f[1] = rw_frag(buf, tile * 16 + fr, 32 + fq * 8); return r; }
__device__ __forceinline__ Frag2 rw_frag2_tr(const char* img, int ntile, int lane) { Frag2 r; r.f[0] = rw_frag_tr(img, ntile, 0, lane); r.f[1] = rw_frag_tr(img, ntile, 32, lane); return r; }
__device__ __forceinline__ f32x4 rw_mm(const Frag2& x, const Frag2& y, f32x4 acc) { acc = mfma16(x.f[0], y.f[0], acc); return mfma16(x.f[1], y.f[1], acc); }
__device__ __forceinline__ f32x4 rw_tile(const char* xbuf, int xt, const char* ybuf, int yt, f32x4 acc, int fr, int fq) {
#pragma unroll
    for (int ks = 0; ks < 2; ++ks) acc = mfma16(rw_frag(xbuf, xt * 16 + fr, ks * 32 + fq * 8), rw_frag(ybuf, yt * 16 + fr, ks * 32 + fq * 8), acc);
    return acc;
}
__device__ __forceinline__ void rw_store_t(char* buf, int xt, int yt, f32x4 d, int fr, int fq) {
    u32x2 o; o[0] = pk_bf16(d[0], d[1]); o[1] = pk_bf16(d[2], d[3]);
    *(u32x2*)(buf + ((yt * 16 + fr) * RS + xt * 16 + 4 * fq) * 2) = o;
}
__device__ __forceinline__ bool nf4(f32x4 v) { return !(fabsf(v[0]) < 1e30f) || !(fabsf(v[1]) < 1e30f) || !(fabsf(v[2]) < 1e30f) || !(fabsf(v[3]) < 1e30f); }
__device__ __forceinline__ bool big4(f32x4 v) { return (fabsf(v[0]) > 1e6f) || (fabsf(v[1]) > 1e6f) || (fabsf(v[2]) > 1e6f) || (fabsf(v[3]) > 1e6f); }
#define DBGFLAG(cond, bit) do { if (cond) atomicOr((unsigned*)(DBGW), 1u << (bit)); } while (0)
__device__ __forceinline__ bool gt4(f32x4 v, float th) { return !(fabsf(v[0]) <= th) || !(fabsf(v[1]) <= th) || !(fabsf(v[2]) <= th) || !(fabsf(v[3]) <= th); }
template <int J> __device__ __forceinline__ void rw_offdiag(const float* MF, char* TTb, int fr, int fq) {
    f32x4 Tb[3];
#pragma unroll
    for (int I = J - 1; I >= 0; --I) {
        f32x4 acc = {0.f, 0.f, 0.f, 0.f};
#pragma unroll
        for (int L = I + 1; L <= J; ++L) {
#pragma unroll
            for (int kk = 0; kk < 4; ++kk) {
                const float a = MF[(16 * I + fr) * 68 + 16 * L + 4 * fq + kk];
                const float b = (L == J) ? MF[(16 * J + 4 * fq + kk) * 68 + 16 * J + fr] : Tb[L < 3 ? L : 0][kk];
                acc = __builtin_amdgcn_mfma_f32_16x16x4f32(a, b, acc, 0, 0, 0);
            }
        }
        f32x4 res = {0.f, 0.f, 0.f, 0.f};
#pragma unroll
        for (int kk = 0; kk < 4; ++kk) { const float a = MF[(16 * I + fr) * 68 + 16 * I + 4 * fq + kk]; res = __builtin_amdgcn_mfma_f32_16x16x4f32(a, acc[kk], res, 0, 0, 0); }
        Tb[I] = res;         u32x2 o; o[0] = pk_bf16(res[0], res[1]); o[1] = pk_bf16(res[2], res[3]);
        *(u32x2*)(TTb + ((16 * J + fr) * RS + 16 * I + 4 * fq) * 2) = o;
    }
}

typedef float f32x2_t __attribute__((ext_vector_type(2)));
__device__ __forceinline__ unsigned pk4_fp8s(f32x4 v) {
    float a = fminf(fmaxf(v[0] * 8.f, -448.f), 448.f), b = fminf(fmaxf(v[1] * 8.f, -448.f), 448.f), c = fminf(fmaxf(v[2] * 8.f, -448.f), 448.f), d = fminf(fmaxf(v[3] * 8.f, -448.f), 448.f);
    return pk4_fp8(a, b, c, d);
}
__device__ __forceinline__ bf16x8 fp8x8_to_bf16(unsigned lo, unsigned hi) {
    const f32x2_t a = __builtin_amdgcn_cvt_pk_f32_fp8((int)lo, false), b = __builtin_amdgcn_cvt_pk_f32_fp8((int)lo, true), c = __builtin_amdgcn_cvt_pk_f32_fp8((int)hi, false), d = __builtin_amdgcn_cvt_pk_f32_fp8((int)hi, true);
    const u32x4 t = {pk_bf16(a[0], a[1]), pk_bf16(b[0], b[1]), pk_bf16(c[0], c[1]), pk_bf16(d[0], d[1])};
    return __builtin_bit_cast(bf16x8, t);
}
__device__ __forceinline__ unsigned char* rw_rec(unsigned char* ws, size_t uidx) {
    return ws + R_REC_A + uidx * 20480;
}
__device__ __forceinline__ void phase_rwkv_chunk_local(KP p, char* smem) {
    const int bid = blockIdx.x, G = gridDim.x, tid = tid_();
    const bf16_t* RR = (const bf16_t*)(p->ws + R_RR); const bf16_t* KK = (const bf16_t*)(p->ws + R_KK); const bf16_t* VV = (const bf16_t*)(p->ws + R_VV);
    const bf16_t* AAp = (const bf16_t*)(p->ws + R_AA); const bf16_t* LOGW = (const bf16_t*)(p->ws + R_LOGW);
    const float* k_k = p->in[19]; const float* k_a = p->in[20]; const float* r_kp = p->in[21];
    float* CS = (float*)(smem + RW_MF); float* MF = CS; float* SEG = (float*)(smem + RW_SEG); float* PC = (float*)(smem + RW_PC); float* EM = PC + 64;
#define RBUFP(i) (smem + (i) * RBUF)
    const f32x4 zero4 = {0.f, 0.f, 0.f, 0.f};
    const int tau = tid >> 3, k8 = (tid & 7) * 8;
    f32x4 in_lw[2], in_a[2]; u32x4 in_rb, in_kb, in_vb, in_lwb, in_ab;
#define RW_LOAD(uu) do { const int z_ = (uu) & 1, h_ = ((uu) >> 1) & 15, t0_ = ((uu) >> 5) * 64; const int tok_ = z_ ? t0_ + 63 - tau : t0_ + tau; \
        const size_t o_ = (size_t)tok_ * 1024 + h_ * 64 + k8; \
        in_lwb = *(const u32x4*)(LOGW + (size_t)z_ * S * 1024 + o_); in_rb = *(const u32x4*)(RR + o_); \
        in_kb = *(const u32x4*)(KK + o_); in_ab = *(const u32x4*)(AAp + o_); \
        in_vb = *(const u32x4*)(VV + o_); } while (0)
    if (bid < 8192) RW_LOAD(bid);
    for (int u = bid; u < 8192; u += G) {
        const int z = u & 1, h = (u >> 1) & 15, cseq = u >> 5, cproc = z ? 255 - cseq : cseq;
        const size_t uidx = (size_t)(z * 16 + h) * 256 + cproc;
        u32x4* REC = (u32x4*)rw_rec(p->ws, uidx);
        const int tl = tid_(), lane = tl & 63, wv = tl >> 6, fr = lane & 15, fq = lane >> 4, yt = wv & 3, xp = wv >> 2;
        { const u32x2 l0 = {in_lwb[0], in_lwb[1]}, l1 = {in_lwb[2], in_lwb[3]}, a0 = {in_ab[0], in_ab[1]}, a1 = {in_ab[2], in_ab[3]};
          in_lw[0] = bf4_to_f32(l0); in_lw[1] = bf4_to_f32(l1); in_a[0] = bf4_to_f32(a0); in_a[1] = bf4_to_f32(a1); }
        *(f32x4*)(CS + tau * 68 + k8) = in_lw[0]; *(f32x4*)(CS + tau * 68 + k8 + 4) = in_lw[1];
        __syncthreads();
        { const int k = tid & 63, seg = tid >> 6; float loc[8]; float run = 0.f;
#pragma unroll
          for (int j = 0; j < 8; ++j) { run += CS[(seg * 8 + j) * 68 + k]; loc[j] = run; }
          SEG[seg * 64 + k] = run;
          __syncthreads();
          float off = 0.f;
          for (int s2 = 0; s2 < seg; ++s2) off += SEG[s2 * 64 + k];
#pragma unroll
          for (int j = 0; j < 8; ++j) CS[(seg * 8 + j) * 68 + k] = off + loc[j];
        }
        __syncthreads();
        {
            f32x4 kn4[2], kx4[2], b4[2], in_r[2], in_k[2], in_v[2];
            { const u32x2 r0 = {in_rb[0], in_rb[1]}, r1 = {in_rb[2], in_rb[3]}, q0 = {in_kb[0], in_kb[1]}, q1 = {in_kb[2], in_kb[3]}, w0 = {in_vb[0], in_vb[1]}, w1 = {in_vb[2], in_vb[3]};
              in_r[0] = bf4_to_f32(r0); in_r[1] = bf4_to_f32(r1); in_k[0] = bf4_to_f32(q0); in_k[1] = bf4_to_f32(q1); in_v[0] = bf4_to_f32(w0); in_v[1] = bf4_to_f32(w1); }
            {
                const f32x4 kk0 = *(const f32x4*)(k_k + h * 64 + k8), kk1 = *(const f32x4*)(k_k + h * 64 + k8 + 4), ka0 = *(const f32x4*)(k_a + h * 64 + k8), ka1 = *(const f32x4*)(k_a + h * 64 + k8 + 4);
                f32x4 q0 = in_k[0] * kk0, q1 = in_k[1] * kk1;
                float ss = q0[0] * q0[0] + q0[1] * q0[1] + q0[2] * q0[2] + q0[3] * q0[3] + q1[0] * q1[0] + q1[1] * q1[1] + q1[2] * q1[2] + q1[3] * q1[3];
                ss += __shfl_xor(ss, 1); ss += __shfl_xor(ss, 2); ss += __shfl_xor(ss, 4);
                const float inv = 1.f / fmaxf(sqrtf(ss), 1e-12f);
                kn4[0] = q0 * inv; kn4[1] = q1 * inv;
#pragma unroll
                for (int j = 0; j < 4; ++j) { kx4[0][j] = in_k[0][j] * (1.f + (in_a[0][j] - 1.f) * ka0[j]); kx4[1][j] = in_k[1][j] * (1.f + (in_a[1][j] - 1.f) * ka1[j]);
                    b4[0][j] = kn4[0][j] * in_a[0][j]; b4[1][j] = kn4[1][j] * in_a[1][j]; }
                if (z == 0) {
                    const f32x4 rk0 = *(const f32x4*)(r_kp + h * 64 + k8), rk1 = *(const f32x4*)(r_kp + h * 64 + k8 + 4);
                    float bn = 0.f;
#pragma unroll
                    for (int j = 0; j < 4; ++j) bn += in_r[0][j] * kx4[0][j] * rk0[j] + in_r[1][j] * kx4[1][j] * rk1[j];
                    bn += __shfl_xor(bn, 1); bn += __shfl_xor(bn, 2); bn += __shfl_xor(bn, 4);
                    if ((tid & 7) == 0) ((float*)(p->ws + WS_AFF))[(size_t)(cseq * 64 + tau) * 16 + h] = bn;
                }
            }
#pragma unroll
            for (int hh2 = 0; hh2 < 2; ++hh2) {
                const f32x4 cst = *(const f32x4*)(CS + tau * 68 + k8 + 4 * hh2);
                f32x4 csp = {0.f, 0.f, 0.f, 0.f}; if (tau > 0) csp = *(const f32x4*)(CS + (tau - 1) * 68 + k8 + 4 * hh2);
                const f32x4 m = *(const f32x4*)(CS + 31 * 68 + k8 + 4 * hh2), cl = *(const f32x4*)(CS + 63 * 68 + k8 + 4 * hh2);
                float at[4], bt[4], kt[4], rt[4], att4[4], bh4[4], kh4[4], vv4[4];
#pragma unroll
                for (int j = 0; j < 4; ++j) {
                    const int k = k8 + 4 * hh2 + j;
                    const float r = in_r[hh2][j], kx = kx4[hh2][j], kn = kn4[hh2][j], b = b4[hh2][j], v = in_v[hh2][j];
                    const float att = -kn * __expf(csp[j]); at[j] = -kn * __expf(csp[j] - m[j]);
                    const float e2 = __expf(m[j] - cst[j]); bt[j] = b * e2; kt[j] = kx * e2;
                    rt[j] = r * __expf(cst[j] - m[j]);
                    const float e4 = __expf(cl[j] - cst[j]);
                    att4[j] = att; bh4[j] = b * e4; kh4[j] = kx * e4; vv4[j] = v;
                    if (tau == 0) { PC[k] = __expf(cl[j]); EM[k] = __expf(m[j]); }
                }
                const int ob = (tau * RS + k8 + 4 * hh2) * 2;
#define RW_ST4(bufi, w) do { u32x2 o_ = {pk_bf16(w[0], w[1]), pk_bf16(w[2], w[3])}; *(u32x2*)(RBUFP(bufi) + ob) = o_; } while (0)
                RW_ST4(B_AT, at); RW_ST4(B_BT, bt); RW_ST4(B_KT, kt); RW_ST4(B_RT, rt);
                RW_ST4(B_ATT, att4); RW_ST4(B_BHT, bh4); RW_ST4(B_KHT, kh4); RW_ST4(B_VT, vv4);
#undef RW_ST4
            }
        }
        if (u + G < 8192) RW_LOAD(u + G);
        __syncthreads();
        f32x4 nkr[2];
        {
            const Frag2 yA = rw_frag2(RBUFP(B_AT), yt, fr, fq), yK = rw_frag2(RBUFP(B_KT), yt, fr, fq), yR = rw_frag2(RBUFP(B_RT), yt, fr, fq);
#pragma unroll
            for (int a = 0; a < 2; ++a) {
                const int xt = 2 * xp + a;
                const Frag2 xB = rw_frag2(RBUFP(B_BT), xt, fr, fq), xA = rw_frag2(RBUFP(B_AT), xt, fr, fq), xK = rw_frag2(RBUFP(B_KT), xt, fr, fq);
                if (xt <= yt) {
                    const f32x4 d = rw_mm(xB, yA, zero4);
#pragma unroll
                    for (int i = 0; i < 4; ++i) { const int i_ = 16 * xt + 4 * fq + i, j_ = 16 * yt + fr; MF[i_ * 68 + j_] = (i_ < j_) ? d[i] : 0.f; }
                }
                {
                    f32x4 d = rw_mm(xA, yK, zero4);
#pragma unroll
                    for (int i = 0; i < 4; ++i) { const int l_ = 16 * xt + 4 * fq + i, i_ = 16 * yt + fr; d[i] = (i_ < l_) ? d[i] : 0.f; }
                    rw_store_t(RBUFP(B_MAK), xt, yt, d, fr, fq);
                }
                {
                    f32x4 d = rw_mm(xB, yR, zero4);
#pragma unroll
                    for (int i = 0; i < 4; ++i) { const int j_ = 16 * xt + 4 * fq + i, t_ = 16 * yt + fr; d[i] = (j_ <= t_) ? d[i] : 0.f; }
                    rw_store_t(RBUFP(B_NBRT), xt, yt, d, fr, fq);
                }
                {
                    f32x4 d = rw_mm(xK, yR, zero4);
#pragma unroll
                    for (int i = 0; i < 4; ++i) { const int i_ = 16 * xt + 4 * fq + i, t_ = 16 * yt + fr; d[i] = (i_ <= t_) ? d[i] : 0.f; }
                    nkr[a] = d;
                }
            }
        }
        __syncthreads();
#if RW_SIMPLE_INV
        if (wv == 0) {
            float t[64];
#pragma unroll
            for (int l = 0; l < 64; ++l) t[l] = (l == lane) ? 1.f : 0.f;
#pragma unroll
            for (int ii = 62; ii >= 0; --ii) { float acc = 0.f; asm volatile("" ::: "memory");
#pragma unroll
                for (int l = ii + 1; l < 64; ++l) acc += MF[ii * 68 + l] * t[l];
                t[ii] += acc; }
            char* row = RBUFP(B_TT) + (lane * RS) * 2;
#pragma unroll
            for (int g4 = 0; g4 < 16; ++g4) { u32x2 o; o[0] = pk_bf16(t[4 * g4], t[4 * g4 + 1]); o[1] = pk_bf16(t[4 * g4 + 2], t[4 * g4 + 3]); *(u32x2*)(row + g4 * 8) = o; }
        }
        __syncthreads();
#else
        if (wv == 0) {
            const int I = lane >> 4, jj = lane & 15; float t[16];
#pragma unroll
            for (int l = 0; l < 16; ++l) t[l] = (l == jj) ? 1.f : 0.f;
#pragma unroll
            for (int ii = 14; ii >= 0; --ii) { float acc = 0.f;
#pragma unroll
                for (int l = ii + 1; l < 16; ++l) acc += MF[(16 * I + ii) * 68 + 16 * I + l] * t[l];
                t[ii] += acc; }
#pragma unroll
            for (int ii = 0; ii < 16; ++ii) { MF[(16 * I + ii) * 68 + 16 * I + jj] = t[ii]; }
            char* row = RBUFP(B_TT) + ((16 * I + jj) * RS + 16 * I) * 2;
#pragma unroll
            for (int g4 = 0; g4 < 4; ++g4) { u32x2 o; o[0] = pk_bf16(t[4 * g4], t[4 * g4 + 1]); o[1] = pk_bf16(t[4 * g4 + 2], t[4 * g4 + 3]); *(u32x2*)(row + g4 * 8) = o; }
        } else if (wv >= 4) {
            for (int q = tid - 256; q < 768; q += 256) { const int blk = q >> 7, w = q & 127; const int J = blk < 3 ? 0 : blk < 5 ? 1 : 2; const int I = blk < 3 ? blk + 1 : blk < 5 ? blk - 1 : 3;
                ((unsigned*)RBUFP(B_TT))[(16 * J + (w >> 3)) * (RS / 2) + 8 * I + (w & 7)] = 0u; }
        }
        __syncthreads();
        if (wv == 1) rw_offdiag<1>(MF, RBUFP(B_TT), fr, fq); else if (wv == 2) rw_offdiag<2>(MF, RBUFP(B_TT), fr, fq); else if (wv == 3) rw_offdiag<3>(MF, RBUFP(B_TT), fr, fq);
        __syncthreads();
#endif
        {
            const Frag2 yAT = rw_frag2_tr(RBUFP(B_ATT), yt, lane), yM = rw_frag2(RBUFP(B_MAK), yt, fr, fq);
#pragma unroll
            for (int a = 0; a < 2; ++a) {
                const int xt = 2 * xp + a;
                const Frag2 xT = rw_frag2(RBUFP(B_TT), xt, fr, fq);
                rw_store_t(RBUFP(B_AT), xt, yt, rw_mm(xT, yAT, zero4), fr, fq);
                rw_store_t(RBUFP(B_W2), xt, yt, rw_mm(xT, yM, zero4), fr, fq);
            }
        }
        __syncthreads();
        {
            const Frag2 yB = rw_frag2_tr(RBUFP(B_BHT), yt, lane), yN = rw_frag2(RBUFP(B_NBRT), yt, fr, fq);
            f32x4 g[2], qe[2];
#pragma unroll
            for (int a = 0; a < 2; ++a) {
                const int kt = 2 * xp + a;
                const Frag2 x1 = rw_frag2(RBUFP(B_AT), kt, fr, fq);
                f32x4 d = rw_mm(x1, yB, zero4);
                if (kt == yt) {
#pragma unroll
                    for (int i = 0; i < 4; ++i) d[i] += (4 * fq + i == fr) ? PC[16 * kt + fr] : 0.f;
                }
                g[a] = d;
                const u32x2 rv = *(const u32x2*)(RBUFP(B_RT) + ((16 * yt + fr) * RS + 16 * kt + 4 * fq) * 2);
                f32x4 init = bf4_to_f32(rv); const f32x4 em = *(const f32x4*)(EM + 16 * kt + 4 * fq);
                init = init * em;
                qe[a] = rw_mm(x1, yN, init);
            }
            { const u32x2 qq = {pk4_fp8s(qe[0]), pk4_fp8s(qe[1])};
              { const u32x2 gq = {pk4_fp8s(g[0]), pk4_fp8s(g[1])}; *(u32x2*)(p->ws + R_GREC + uidx * 4096 + (yt * 64 + lane) * 16 + xp * 8) = gq; }
              *(u32x2*)((char*)REC + (yt * 64 + lane) * 16 + xp * 8) = qq; }
#pragma unroll
            for (int a = 0; a < 2; ++a) {
                const int it = 2 * xp + a;
                const Frag2 x2 = rw_frag2(RBUFP(B_W2), it, fr, fq);
                const u32x2 kv = rw_tr4(RBUFP(B_KHT) + ((16 * it + 4 * fq + ((lane & 15) >> 2)) * RS + 16 * yt + 4 * (lane & 3)) * 2);
                rw_store_t(RBUFP(B_BT), it, yt, rw_mm(x2, yB, bf4_to_f32(kv)), fr, fq);
                rw_store_t(RBUFP(B_KT), it, yt, rw_mm(x2, yN, nkr[a]), fr, fq);
            }
        }
        __syncthreads();
        {
            const Frag2 fV = rw_frag2_tr(RBUFP(B_VT), yt, lane);
            f32x4 hd[2], yd[2];
#pragma unroll
            for (int a = 0; a < 2; ++a) {
                const Frag2 fX = rw_frag2(RBUFP(B_BT), 2 * xp + a, fr, fq), fZ = rw_frag2(RBUFP(B_KT), 2 * xp + a, fr, fq);
                hd[a] = rw_mm(fX, fV, zero4);
                yd[a] = rw_mm(fV, fZ, zero4);
            }
            REC[(4 + yt * 2 + xp) * 64 + lane] = pk8(hd[0], hd[1]);
            REC[(12 + yt * 2 + xp) * 64 + lane] = pk8(yd[0], yd[1]);
        }
        __syncthreads();
    }
#undef RW_LOAD
#undef RBUFP
}
constexpr int RW2_SLOT = 12288, RW2_NS = 11;
__device__ __forceinline__ void phase_rwkv_state_scan(KP p, char* smem) {
    const int bid = blockIdx.x, G = gridDim.x, tid = tid_(), lane = tid & 63;
    const int wvu = __builtin_amdgcn_readfirstlane(tid >> 6);
    for (int ch = bid; ch < 32; ch += G) {
        unsigned char* srec0 = p->ws + R_SREC + (size_t)ch * 256 * 8192;
        const unsigned char* grec0 = p->ws + R_GREC + (size_t)ch * 256 * 4096 + lane * 16; const unsigned char* hrec0 = rw_rec(p->ws, (size_t)ch * 256) + lane * 16;
#define RW_DMA(cc) do { char* dst_ = smem + ((cc) % RW2_NS) * RW2_SLOT; \
        _Pragma("unroll") for (int q_ = 0; q_ < 3; ++q_) { const int j_ = (wvu - 4) * 3 + q_; \
            const unsigned char* src_ = j_ < 4 ? grec0 + (size_t)(cc) * 4096 + j_ * 1024 : hrec0 + (size_t)(cc) * 20480 + j_ * 1024; \
            __builtin_amdgcn_global_load_lds((const unsigned*)src_, (unsigned LAS*)(dst_ + j_ * 1024), 16, 0, 0); } } while (0)
#define RW_RD(cc, R) do { const u32x4* sl_ = (const u32x4*)(smem + ((cc) % RW2_NS) * RW2_SLOT) + lane; \
        _Pragma("unroll") for (int i_ = 0; i_ < 4; ++i_) R[i_] = sl_[i_ * 64]; R[4] = sl_[(4 + 2 * wvu) * 64]; R[5] = sl_[(5 + 2 * wvu) * 64]; } while (0)
        __syncthreads();
        if (wvu >= 4) {
#pragma unroll
            for (int cc = 0; cc < RW2_NS; ++cc) RW_DMA(cc);
            asm volatile("s_waitcnt vmcnt(30)" ::: "memory");
            __builtin_amdgcn_s_barrier();
#pragma unroll 1
            for (int c = 0; c < 256; ++c) {
                if (c < 255) { const int yg = 254 - c < RW2_NS - 2 ? 254 - c : RW2_NS - 2;
                    if (yg == 9) asm volatile("s_waitcnt vmcnt(27)" ::: "memory"); else if (yg == 8) asm volatile("s_waitcnt vmcnt(24)" ::: "memory");
                    else if (yg == 7) asm volatile("s_waitcnt vmcnt(21)" ::: "memory"); else if (yg == 6) asm volatile("s_waitcnt vmcnt(18)" ::: "memory");
                    else if (yg == 5) asm volatile("s_waitcnt vmcnt(15)" ::: "memory"); else if (yg == 4) asm volatile("s_waitcnt vmcnt(12)" ::: "memory");
                    else if (yg == 3) asm volatile("s_waitcnt vmcnt(9)" ::: "memory"); else if (yg == 2) asm volatile("s_waitcnt vmcnt(6)" ::: "memory");
                    else if (yg == 1) asm volatile("s_waitcnt vmcnt(3)" ::: "memory"); else asm volatile("s_waitcnt vmcnt(0)" ::: "memory"); }
                __builtin_amdgcn_s_barrier();
                asm volatile("" ::: "memory");
                if (c + RW2_NS < 256) RW_DMA(c + RW2_NS);
            }
        } else {
#define RW_STEP(c, CUR, NXT) do { \
            asm volatile("s_waitcnt lgkmcnt(0)" ::: "memory"); \
            __builtin_amdgcn_s_barrier(); \
            asm volatile("" ::: "memory"); \
            if ((c) < 255) RW_RD((c) + 1, NXT); \
            u32x4 sfu0_ = {pk_bf16(sacc[0][0] * 0.125f, sacc[0][1] * 0.125f), pk_bf16(sacc[0][2] * 0.125f, sacc[0][3] * 0.125f), pk_bf16(sacc[1][0] * 0.125f, sacc[1][1] * 0.125f), pk_bf16(sacc[1][2] * 0.125f, sacc[1][3] * 0.125f)}; \
            u32x4 sfu1_ = {pk_bf16(sacc[2][0] * 0.125f, sacc[2][1] * 0.125f), pk_bf16(sacc[2][2] * 0.125f, sacc[2][3] * 0.125f), pk_bf16(sacc[3][0] * 0.125f, sacc[3][1] * 0.125f), pk_bf16(sacc[3][2] * 0.125f, sacc[3][3] * 0.125f)}; \
            { u32x4* sr_ = (u32x4*)(srec0 + (size_t)(c) * 8192 + wvu * 2048); sr_[lane] = sfu0_; sr_[64 + lane] = sfu1_; } \
            const bf16x8 sf0_ = __builtin_bit_cast(bf16x8, sfu0_), sf1_ = __builtin_bit_cast(bf16x8, sfu1_); \
            _Pragma("unroll") for (int mt = 0; mt < 4; ++mt) { \
                const u32x4 hv_ = CUR[4 + (mt >> 1)]; const u32x2 hi2_ = {hv_[(mt & 1) * 2], hv_[(mt & 1) * 2 + 1]}; \
                f32x4 s2_ = bf4_to_f32(hi2_); \
                s2_ = mfma16(fp8x8_to_bf16(CUR[mt][0], CUR[mt][1]), sf0_, s2_);         \
                s2_ = mfma16(fp8x8_to_bf16(CUR[mt][2], CUR[mt][3]), sf1_, s2_); \
                sacc[mt] = s2_; } } while (0)
            __builtin_amdgcn_s_barrier();
            asm volatile("" ::: "memory");
            u32x4 ra[6], rb[6];
            RW_RD(0, ra);
            f32x4 sacc[4];
#pragma unroll
            for (int mt = 0; mt < 4; ++mt) sacc[mt] = (f32x4){0.f, 0.f, 0.f, 0.f};
#pragma unroll 1
            for (int c = 0; c < 256; c += 2) { RW_STEP(c, ra, rb); RW_STEP(c + 1, rb, ra); }
#undef RW_STEP
        }
        asm volatile("s_waitcnt vmcnt(0)" ::: "memory");
        __syncthreads();
#undef RW_DMA
#undef RW_RD
    }
}
__device__ __forceinline__ void phase_rwkv_post(KP p, char* smem) {
    const int bid = blockIdx.x, G = gridDim.x;
    const bf16_t* VV = (const bf16_t*)(p->ws + R_VV); const bf16_t* GG = (const bf16_t*)(p->ws + R_G); bf16_t* YG = (bf16_t*)(p->ws + R_YG);
    const float* ln_w = p->in[22]; const float* ln_b = p->in[23]; const float* BN = (const float*)(p->ws + WS_AFF);
    float* YS = (float*)smem;
    u32x4 a_sf0[2], a_sf1[2], a_yl[2], a_qa[2], a_qb[2];
#define PO_LOAD(uu) do { const int cs_ = (uu) >> 4, h_ = (uu) & 15; const int tl_ = tid_(), ln_ = tl_ & 63, wv_ = tl_ >> 6, vt_ = wv_ & 3, xp_ = wv_ >> 2; \
        _Pragma("unroll") for (int z_ = 0; z_ < 2; ++z_) { const size_t ui_ = (size_t)(z_ * 16 + h_) * 256 + (z_ ? 255 - cs_ : cs_); \
            const unsigned char* rec_ = rw_rec(p->ws, ui_) + ln_ * 16; const unsigned char* sr_ = p->ws + R_SREC + ui_ * 8192 + vt_ * 2048 + ln_ * 16; \
            a_sf0[z_] = *(const u32x4*)sr_; a_sf1[z_] = *(const u32x4*)(sr_ + 1024); a_yl[z_] = *(const u32x4*)(rec_ + (12 + vt_ * 2 + xp_) * 1024); \
            a_qa[z_] = *(const u32x4*)(rec_ + (2 * xp_) * 1024); a_qb[z_] = *(const u32x4*)(rec_ + (1 + 2 * xp_) * 1024); } } while (0)
    if (bid < 4096) PO_LOAD(bid);
    for (int u = bid; u < 4096; u += G) {
        const int cseq = u >> 4, h = u & 15;
        const int tl = tid_(), lane = tl & 63, wv = tl >> 6, fr = lane & 15, fq = lane >> 4, vt = wv & 3, xp = wv >> 2;
        const int c4 = (tl & 15) * 4, cc = h * 64 + c4;
        u32x2 vv[2], gg[2]; float bnq[2];
#pragma unroll
        for (int q = 0; q < 2; ++q) { const int tok = cseq * 64 + (tl >> 4) + q * 32; const size_t o = (size_t)tok * 1024 + cc;
            vv[q] = *(const u32x2*)(VV + o); gg[q] = *(const u32x2*)(GG + o); bnq[q] = BN[(size_t)tok * 16 + h]; }
        const f32x4 lwq = *(const f32x4*)(ln_w + cc), lbq = *(const f32x4*)(ln_b + cc);
#pragma unroll
        for (int z = 0; z < 2; ++z) {
            const bf16x8 sf0 = __builtin_bit_cast(bf16x8, a_sf0[z]), sf1 = __builtin_bit_cast(bf16x8, a_sf1[z]);
#pragma unroll
            for (int a = 0; a < 2; ++a) {
                const u32x2 yi = {a_yl[z][2 * a], a_yl[z][2 * a + 1]}; const u32x4 q8 = a ? a_qb[z] : a_qa[z];
                f32x4 y = bf4_to_f32(yi);
                y = mfma16(sf0, fp8x8_to_bf16(q8[0], q8[1]), y);
                y = mfma16(sf1, fp8x8_to_bf16(q8[2], q8[3]), y);
                const int tau = 16 * (2 * xp + a) + fr, sl = z ? 63 - tau : tau;
                *(f32x4*)(YS + (z * 64 + sl) * 68 + 16 * vt + 4 * fq) = y;
            }
        }
        if (u + G < 4096) PO_LOAD(u + G);
        __syncthreads();
#pragma unroll
        for (int q = 0; q < 2; ++q) {
            const int sl = (tl >> 4) + q * 32; const size_t o = (size_t)(cseq * 64 + sl) * 1024 + cc;
            const f32x4 y = *(const f32x4*)(YS + sl * 68 + c4) + *(const f32x4*)(YS + (64 + sl) * 68 + c4);
            float sm = y[0] + y[1] + y[2] + y[3];
            sm += __shfl_xor(sm, 1); sm += __shfl_xor(sm, 2); sm += __shfl_xor(sm, 4); sm += __shfl_xor(sm, 8);
            const float mean = sm * (1.f / 64.f);
            const f32x4 dlt = y - mean;
            float vs = dlt[0] * dlt[0] + dlt[1] * dlt[1] + dlt[2] * dlt[2] + dlt[3] * dlt[3];
            vs += __shfl_xor(vs, 1); vs += __shfl_xor(vs, 2); vs += __shfl_xor(vs, 4); vs += __shfl_xor(vs, 8);
            const float rs = rsqrtf(vs * (1.f / 64.f) + 64e-5f);
            const f32x4 v = bf4_to_f32(vv[q]); const float bn = bnq[q];
            const float g0 = bf_lo(gg[q][0]), g1 = bf_hi(gg[q][0]), g2 = bf_lo(gg[q][1]), g3 = bf_hi(gg[q][1]);
            f32x4 out;
#pragma unroll
            for (int j = 0; j < 4; ++j) out[j] = dlt[j] * rs * lwq[j] + lbq[j] + bn * v[j];
            u32x2 w; w[0] = pk_bf16(out[0] * g0, out[1] * g1); w[1] = pk_bf16(out[2] * g2, out[3] * g3);
            *(u32x2*)(YG + o) = w;
        }
        __syncthreads();
    }
#undef PO_LOAD
}

__global__ void __launch_bounds__(NTHR, 2) fwd_kernel(Params p_) {
    KP p = (KP)__builtin_amdgcn_kernarg_segment_ptr();
    extern __shared__ __attribute__((aligned(16))) char smem[];
    __shared__ uint4 xb_words;
    const int lo = p_.lo, hi = p_.hi;
    const bool multi = (hi - lo) > 1;
    XcdBarrier bar; bar.bar = (unsigned*)(p->ws + WS_BAR); bar.x = 0; bar.st = (volatile LAS unsigned*)&xb_words;
    if (multi) {
        if (tid_() == 0) xb_words = make_uint4(0u, 0u, 0u, 0u);
        __syncthreads();
        bar = xcd_barrier_post((unsigned*)(p->ws + WS_BAR), (volatile LAS unsigned*)&xb_words);
    }
#if defined(PHASE_MASK)
#define IN(k) (((PHASE_MASK >> (k)) & 1) && lo <= (k) && (k) < hi)
#elif defined(ONLY_PHASE)
#define IN(k) ((k) == ONLY_PHASE && lo <= (k) && (k) < hi)
#else
#define IN(k) (lo <= (k) && (k) < hi)
#endif
#define SEAM(k) do { if (IN(k) && IN((k) + 1)) xcd_barrier(bar); asm volatile("" : "+s"(p) :: "memory"); } while (0)
#define XA ((float*)(p->ws + WS_XA))
#define XB ((float*)(p->ws + WS_XB))

    if (IN(0)) { phase_prologue(p, smem); } SEAM(0);
    if (IN(1)) {
        EpiProj E{(bf16_t*)(p->ws + A_Q), (bf16_t*)(p->ws + A_V), (bf16_t*)(p->ws + A_KF), (bf16_t*)(p->ws + A_AQ), (bf16_t*)(p->ws + A_AK), (bf16_t*)(p->ws + A_AV), (float*)(p->ws + A_LOGF), (bf16_t*)(p->ws + A_GATE), (const float*)(p->ws + WS_LB)};
        int pre = 0;
        for (int L = blockIdx.x; L < 64 * 16; L += gridDim.x) { int pm, pn; tile_order(L, 64, 16, pm, pn);
            const int Ln = L + gridDim.x; GemmNext nx{(const bf16_t*)(p->ws + A_H0), (const bf16_t*)(p->ws + WS_WT_IN), nullptr, 0, 0, Ln < 64 * 16 ? 1 : 0};
            if (nx.valid) { int pm2, pn2; tile_order(Ln, 64, 16, pm2, pn2); nx.brow = pm2 * 256; nx.bcol = pn2 * 256; }
            gemm_tile((const bf16_t*)(p->ws + A_H0), (const bf16_t*)(p->ws + WS_WT_IN), 1024, pm * 256, pn * 256, (bf16_t*)smem, E, nullptr, pre, nx); pre = nx.valid; }
    } SEAM(1);
    if (IN(2)) { phase_hgrn_local(p, smem); phase_attention(p, smem); } SEAM(2);
    if (IN(3)) { phase_hgrn_scan(p); phase_attn_merge(p); } SEAM(3);
    if (IN(4)) { phase_hgrn_out(p, smem); } SEAM(4);
    if (IN(5)) {
        EpiResid E{p->in[0], XA, (bf16_t*)(p->ws + M_HB)};
        for (int L = blockIdx.x; L < 64 * 4; L += gridDim.x) { int pm, pn; tile_order(L, 64, 4, pm, pn);
            gemm_tile((const bf16_t*)(p->ws + A_YAB), (const bf16_t*)(p->ws + WS_WT_OUT), 1024, pm * 256, pn * 256, (bf16_t*)smem, E); }
    } SEAM(5);
    if (IN(6)) { phase_moe_router(p, 0, XA, smem); } SEAM(6);
    if (IN(7)) { phase_moe_select(p, smem);
        { int cb = (int)blockIdx.x - 16, cG = (int)gridDim.x - 16; if (cG <= 0) { cb = blockIdx.x; cG = gridDim.x; }
          if (cb >= 0) { int rot = 0; __syncthreads(); cvt_moe_layer(p, 0, 12, 16, rot, cb, cG, (float*)smem); } }
    } SEAM(7);
    if (IN(9)) { moe_gemms_gateup(p, smem); } SEAM(9);
    if (IN(10)) { moe_gemms_down(p, smem); } SEAM(10);
    if (IN(11)) { phase_combine_mix(p, XA, XB, p->in[7], smem); } SEAM(11);
    if (IN(13)) {
        const bf16_t* MIX = (const bf16_t*)(p->ws + R_MIX);
        int pre = 0;
        for (int L = blockIdx.x; L < 1024; L += gridDim.x) {
            EpiRkvLora E; const bf16_t* Ap; const bf16_t* Bp; int pm, pn;
            if (L < 768) { const int job = L >> 8; tile_order(L & 255, 64, 4, pm, pn);
                E.isl = 0; E.outb = (bf16_t*)(p->ws + (job == 0 ? R_RR : job == 1 ? R_KK : R_VV)); E.out = nullptr; E.al = E.be = E.ga = E.de = 0.f;
                Ap = MIX + (size_t)job * S * 1024; Bp = (const bf16_t*)(p->ws + WS_WT_RKV) + (size_t)job * 1024 * 1024; }
            else { const int job = (L - 768) >> 6; pm = (L - 768) & 63; pn = 0;
                const int mi = job == 0 ? 5 : job == 1 ? 6 : job == 2 ? 3 : 4;
                E.isl = 1; E.outb = nullptr; E.out = (bf16_t*)(p->ws + R_L1O) + (size_t)job * S * 128;
                E.al = job < 2 ? 2.f : job == 2 ? 0.f : 1.f; E.be = job < 2 ? 2.f : 1.f; E.ga = job < 2 ? -1.f : 0.f; E.de = job == 2 ? 1.f : 0.f;
                Ap = MIX + (size_t)mi * S * 1024; Bp = (const bf16_t*)(p->ws + WS_WT_L1) + (size_t)job * 256 * 1024; }
            const int Ln = L + gridDim.x; GemmNext nx{nullptr, nullptr, nullptr, 0, 0, Ln < 1024 ? 1 : 0};
            if (nx.valid) {
                if (Ln < 768) { const int job2 = Ln >> 8; int pm2, pn2; tile_order(Ln & 255, 64, 4, pm2, pn2);
                    nx.A = MIX + (size_t)job2 * S * 1024; nx.Bt = (const bf16_t*)(p->ws + WS_WT_RKV) + (size_t)job2 * 1024 * 1024; nx.brow = pm2 * 256; nx.bcol = pn2 * 256; }
                else { const int job2 = (Ln - 768) >> 6; const int mi2 = job2 == 0 ? 5 : job2 == 1 ? 6 : job2 == 2 ? 3 : 4;
                    nx.A = MIX + (size_t)mi2 * S * 1024; nx.Bt = (const bf16_t*)(p->ws + WS_WT_L1) + (size_t)job2 * 256 * 1024; nx.brow = ((Ln - 768) & 63) * 256; nx.bcol = 0; }
            }
            gemm_tile(Ap, Bp, 1024, pm * 256, pn * 256, (bf16_t*)smem, E, nullptr, pre, nx); pre = nx.valid;
        }
    } SEAM(13);
    if (IN(14)) {
        int pre = 0;
        for (int L = blockIdx.x; L < 4 * 256; L += gridDim.x) { const int job = L >> 8; int pm, pn; tile_order(L & 255, 64, 4, pm, pn);
            const int Ln = L + gridDim.x; GemmNext nx{nullptr, nullptr, nullptr, 0, 0, Ln < 4 * 256 ? 1 : 0};
            if (nx.valid) { const int job2 = Ln >> 8; int pm2, pn2; tile_order(Ln & 255, 64, 4, pm2, pn2);
                nx.A = (const bf16_t*)(p->ws + R_L1O) + (size_t)job2 * S * 128; nx.Bt = (const bf16_t*)(p->ws + WS_WT_L2) + (size_t)job2 * 1024 * 128; nx.brow = pm2 * 256; nx.bcol = pn2 * 256; }
            EpiLora2 E;
            if (job < 2) { E.isg = 0; E.scale = -0.6065306597126334f; E.bias = p->in[11] + job * 1024; E.outb = (bf16_t*)(p->ws + R_LOGW) + (size_t)job * S * 1024; }
            else if (job == 2) { E.isg = 0; E.scale = 1.f; E.bias = p->in[14]; E.outb = (bf16_t*)(p->ws + R_AA); }
            else { E.isg = 1; E.scale = 0.f; E.bias = p->in[14]; E.outb = (bf16_t*)(p->ws + R_G); }
            gemm_tile((const bf16_t*)(p->ws + R_L1O) + (size_t)job * S * 128, (const bf16_t*)(p->ws + WS_WT_L2) + (size_t)job * 1024 * 128, 128, pm * 256, pn * 256, (bf16_t*)smem, E, nullptr, pre, nx); pre = nx.valid; }
    } SEAM(14);
    if (IN(16)) { phase_rwkv_chunk_local(p, smem); } SEAM(16);
    if (IN(17)) {
        phase_rwkv_state_scan(p, smem);
        int cb = (int)blockIdx.x - 32, cG = (int)gridDim.x - 32; if (cG <= 0) { cb = blockIdx.x; cG = gridDim.x; }
        if (cb >= 0) { int rot = 0; __syncthreads(); cvt_moe_layer(p, 1, 0, 12, rot, cb, cG, (float*)smem); }
    } SEAM(17);
    if (IN(18)) { phase_rwkv_post(p, smem); } SEAM(18);
    if (IN(19)) {
        EpiResid E{XB, XA, (bf16_t*)(p->ws + M_HB)};
        for (int L = blockIdx.x; L < 64 * 4; L += gridDim.x) { int pm, pn; tile_order(L, 64, 4, pm, pn);
            gemm_tile((const bf16_t*)(p->ws + R_YG), (const bf16_t*)(p->ws + WS_WT_COUT), 1024, pm * 256, pn * 256, (bf16_t*)smem, E); }
    } SEAM(19);
    if (IN(20)) { phase_moe_router(p, 1, XA, smem); } SEAM(20);
    if (IN(21)) { phase_moe_select(p, smem);
        { int cb = (int)blockIdx.x - 16, cG = (int)gridDim.x - 16; if (cG <= 0) { cb = blockIdx.x; cG = gridDim.x; }
          if (cb >= 0) { int rot = 0; __syncthreads(); cvt_moe_layer(p, 1, 12, 16, rot, cb, cG, (float*)smem); } }
    } SEAM(21);
    if (IN(23)) { moe_gemms_gateup(p, smem); } SEAM(23);
    if (IN(24)) { moe_gemms_down(p, smem); } SEAM(24);
    if (IN(25)) { phase_moe_combine(p, XA, nullptr, p->in[30], p->out); }
#undef IN
#undef SEAM
#undef XA
#undef XB
}

extern "C" void kernel_launch(void* const* d_in, const int* in_sizes, int n_in, void* d_out, int out_size, void* d_ws, size_t ws_size, hipStream_t stream) {
    static int grid = 0;
    if (grid == 0) {
        if (n_in != 31 || ws_size < WS_END) { fprintf(stderr, "kernel_launch: unexpected n_in %d or ws_size %zu (< %zu)\n", n_in, ws_size, (size_t)WS_END); grid = -1; return; }
        int dev = 0, cus = 0;
        if (hipGetDevice(&dev) != hipSuccess || hipDeviceGetAttribute(&cus, hipDeviceAttributeMultiprocessorCount, dev) != hipSuccess) { grid = -1; return; }
        if (hipFuncSetAttribute((const void*)fwd_kernel, hipFuncAttributeMaxDynamicSharedMemorySize, LDS_BYTES) != hipSuccess) { fprintf(stderr, "kernel_launch: hipFuncSetAttribute failed\n"); grid = -1; return; }
        int per_cu = 0;
        if (hipOccupancyMaxActiveBlocksPerMultiprocessor(&per_cu, (const void*)fwd_kernel, NTHR, LDS_BYTES) != hipSuccess || per_cu < 1) fprintf(stderr, "kernel_launch: occupancy query says %d\n", per_cu);
        (void)hipGetLastError();
        grid = cus;
    }
    if (grid < 0) return;
    (void)hipMemsetAsync((char*)d_ws + WS_BAR, 0, 16384, stream);
    Params p{};
    for (int i = 0; i < 31; ++i) p.in[i] = (const float*)d_in[i];
    p.out = (float*)d_out; p.ws = (unsigned char*)d_ws;
    if (PROBE_LO >= 0) {
        const int cuts[4] = {0, PROBE_HI, PROBE_LO, NPH}; const int ends[3] = {PROBE_HI, PROBE_HI, NPH};
        for (int li = 0; li < 3; ++li) { p.lo = cuts[li == 0 ? 0 : li == 1 ? 2 : 1]; p.hi = ends[li];
            if (li) (void)hipMemsetAsync((char*)d_ws + WS_BAR, 0, XCD_BAR_WORDS * sizeof(unsigned), stream);
            if (p.lo < p.hi) hipLaunchKernelGGL(fwd_kernel, dim3(grid), dim3(NTHR), LDS_BYTES, stream, p); }
    } else if (kSingleLaunch) {
        p.lo = 0; p.hi = NPH;
        hipLaunchKernelGGL(fwd_kernel, dim3(grid), dim3(NTHR), LDS_BYTES, stream, p);
    } else {
        for (int ph = 0; ph < NPH; ++ph) { p.lo = ph; p.hi = ph + 1; hipLaunchKernelGGL(fwd_kernel, dim3(grid), dim3(NTHR), LDS_BYTES, stream, p); }
    }
}
```

```cpp
#include <hip/hip_runtime.h>
#include <cstdio>
#include <cstdint>

#define XB_TMO      128
#define XB_XCNT(j)  (256  + 64 * (j))
#define XB_XSUB(j)  (1280 + 64 * (j))
#define XB_XGEN(j)  (2304 + 64 * (j))
#define XB_TOP      3328
#define XB_TOPGEN   3392
#define XCD_BAR_WORDS 3456
#define XB_SPIN_CAP (1u << 22)
#define LAS __attribute__((address_space(3)))

__device__ __forceinline__ unsigned xb_ld(unsigned* p)              { return __hip_atomic_load(p, __ATOMIC_RELAXED, __HIP_MEMORY_SCOPE_AGENT); }
__device__ __forceinline__ unsigned xb_add(unsigned* p, unsigned v) { return __hip_atomic_fetch_add(p, v, __ATOMIC_RELAXED, __HIP_MEMORY_SCOPE_AGENT); }
__device__ __forceinline__ unsigned xb_xcc_id() { return (unsigned)__builtin_amdgcn_s_getreg((3 << 11) | 20) & 0xFu; }
#define XB_SPIN(cond, bar) do { unsigned _sp = 0; while (cond) { __builtin_amdgcn_s_sleep(1); \
    if ((++_sp & 255u) == 0u) { if (xb_ld(&(bar)[XB_TMO])) break; if (_sp > XB_SPIN_CAP) { atomicAdd(&(bar)[XB_TMO], 1u); break; } } } } while (0)

struct XcdBarrier { unsigned* bar; unsigned x; volatile LAS unsigned* st; };

__device__ __forceinline__ XcdBarrier xcd_barrier_post(unsigned* bar, volatile LAS unsigned* st) {
    XcdBarrier b; b.bar = bar; b.x = xb_xcc_id(); b.st = st;
    if (threadIdx.x == 0) (void)xb_add(&bar[XB_XCNT(b.x)], 1u);
    return b;
}
__device__ __forceinline__ void xcd_barrier_complete(unsigned* bar, unsigned x, unsigned& nloc, unsigned& nx) {
    const unsigned G = gridDim.x * gridDim.y * gridDim.z;
    unsigned sum, cnt, mine, sp = 0u;
    for (;;) {
        sum = 0u; cnt = 0u; mine = 0u;
#pragma unroll
        for (unsigned j = 0; j < 16; ++j) { const unsigned c = xb_ld(&bar[XB_XCNT(j)]); sum += c; cnt += (c > 0u) ? 1u : 0u; mine = (j == x) ? c : mine; }
        if (sum == G) break;
        __builtin_amdgcn_s_sleep(1);
        if ((++sp & 255u) == 0u) { if (xb_ld(&bar[XB_TMO])) break; if (sp > XB_SPIN_CAP) { atomicAdd(&bar[XB_TMO], 1u); break; } }
    }
    nloc = mine > 0u ? mine : 1u; nx = cnt > 0u ? cnt : 1u;
}
__device__ __forceinline__ void xcd_barrier(const XcdBarrier& b) {
    asm volatile("s_waitcnt vmcnt(0)" ::: "memory");
    __syncthreads();
    if (threadIdx.x == 0) {
        unsigned* bar = b.bar;
        __builtin_amdgcn_s_waitcnt(0);
        unsigned nloc = b.st[0], nx = b.st[1];
        if (nloc == 0u) { xcd_barrier_complete(bar, b.x, nloc, nx); b.st[0] = nloc; b.st[1] = nx; }
        const unsigned old = xb_add(&bar[XB_XSUB(b.x)], 1u);
        const unsigned gen = old / nloc;
        if (old + 1u == (gen + 1u) * nloc) {
            __builtin_amdgcn_fence(__ATOMIC_RELEASE, "agent");
            asm volatile("s_waitcnt vmcnt(0)" ::: "memory");
            const unsigned og = xb_add(&bar[XB_TOP], 1u);
            const unsigned tg = og / nx;
            if (og + 1u == (tg + 1u) * nx) xb_add(&bar[XB_TOPGEN], 1u);
            else XB_SPIN(xb_ld(&bar[XB_TOPGEN]) == tg, bar);
            __builtin_amdgcn_fence(__ATOMIC_ACQUIRE, "agent");
            xb_add(&bar[XB_XGEN(b.x)], 1u);
            asm volatile("s_waitcnt vmcnt(0)" ::: "memory");
        } else {
            XB_SPIN(xb_ld(&bar[XB_XGEN(b.x)]) == gen, bar);
            __builtin_amdgcn_fence(__ATOMIC_ACQUIRE, "agent");
            asm volatile("s_waitcnt vmcnt(0)" ::: "memory");
        }
    }
    __syncthreads();
}

typedef unsigned short bf16_t;
typedef short bf16x8 __attribute__((ext_vector_type(8)));
typedef float f32x4 __attribute__((ext_vector_type(4)));
typedef unsigned u32x2 __attribute__((ext_vector_type(2)));
typedef unsigned u32x4 __attribute__((ext_vector_type(4)));
typedef int v8i_t __attribute__((ext_vector_type(8)));

constexpr int S = 16384, D = 1024;
constexpr int NTHR = 512;
constexpr int LDS_BYTES = 147456;
constexpr int NPH = 26;
constexpr bool kSingleLaunch = true;
#ifndef PROBE_LO
#define PROBE_LO -1
#define PROBE_HI -1
#endif

typedef __bf16 bf2_t __attribute__((ext_vector_type(2)));
__device__ __forceinline__ unsigned pk_bf16(float lo, float hi) { bf2_t v = {(__bf16)lo, (__bf16)hi}; return __builtin_bit_cast(unsigned, v); }
__device__ __forceinline__ unsigned pk4_fp8(float a, float b, float c, float d) { int w = __builtin_amdgcn_cvt_pk_fp8_f32(a, b, 0, false); w = __builtin_amdgcn_cvt_pk_fp8_f32(c, d, w, true); return (unsigned)w; }
__device__ __forceinline__ float bf_lo(unsigned u) { return __uint_as_float(u << 16); }
__device__ __forceinline__ float bf_hi(unsigned u) { return __uint_as_float(u & 0xffff0000u); }
__device__ __forceinline__ float bf2f(bf16_t b) { return __uint_as_float(((unsigned)b) << 16); }
__device__ __forceinline__ f32x4 bf4_to_f32(u32x2 v) { f32x4 r = {bf_lo(v[0]), bf_hi(v[0]), bf_lo(v[1]), bf_hi(v[1])}; return r; }
__device__ __forceinline__ float wave_sum(float x) {
#pragma unroll
    for (int o = 32; o >= 1; o >>= 1) x += __shfl_xor(x, o);
    return x;
}
__device__ __forceinline__ float sigmoidf_(float z) { return __builtin_amdgcn_rcpf(1.f + __expf(-z)); }
__device__ __forceinline__ f32x4 mfma16(bf16x8 a, bf16x8 b, f32x4 c) { return __builtin_amdgcn_mfma_f32_16x16x32_bf16(a, b, c, 0, 0, 0); }
#define NTL(ptr) __builtin_nontemporal_load(ptr)
#define NTS(val, ptr) __builtin_nontemporal_store(val, ptr)
typedef short s16x4_t __attribute__((ext_vector_type(4)));
__device__ __forceinline__ u32x2 rw_tr4(const char* ad) {
    const s16x4_t v = __builtin_amdgcn_ds_read_tr16_b64_v4i16((s16x4_t LAS*)(unsigned)(size_t)ad);
    return __builtin_bit_cast(u32x2, v);
}
__device__ __forceinline__ bf16x8 lds_frag_tr(const char* img, int ld, int ntile, int c0, int lane) {
    const int g = lane >> 4, q = (lane & 15) >> 2, pp = lane & 3;
    const char* a0 = img + ((c0 + 8 * g + q) * ld + 16 * ntile + 4 * pp) * 2;
    const u32x2 lo = rw_tr4(a0), hi = rw_tr4(a0 + 4 * ld * 2);
    u32x4 t = {lo[0], lo[1], hi[0], hi[1]};
    return __builtin_bit_cast(bf16x8, t);
}

constexpr size_t MiB = 1ull << 20;
constexpr size_t WS_WT_IN = 0, WS_WT_OUT = 8 * MiB, WS_WT_RKV = 10 * MiB, WS_WT_COUT = 16 * MiB, WS_WT_L1 = 18 * MiB, WS_WT_L2 = 20 * MiB;
constexpr size_t WS_BT_GU = 22 * MiB, WS_BT_DN = 150 * MiB, WS_SMALL = 214 * MiB;
constexpr size_t WS_BAR = WS_SMALL, WS_LB = WS_SMALL + 16384, WS_BIAS = WS_SMALL + 20480, WS_DTOT = WS_SMALL + 65536;
constexpr size_t WS_AFF = WS_DTOT + MiB, WS_SLOT = WS_AFF + MiB, WS_IDX = WS_SLOT + MiB, WS_GATEW = WS_IDX + 131072, WS_ATTL = WS_GATEW + 131072;
constexpr size_t WS_RSTD = WS_SMALL + 5 * MiB, WS_RSTDE = WS_RSTD + 65536;
constexpr size_t WS_GT = WS_SMALL + 6 * MiB;
constexpr size_t WS_RCNT = WS_BAR + 14336;
constexpr size_t WS_XA = 222 * MiB, WS_XB = 286 * MiB, WS_ACT = 350 * MiB;
constexpr size_t HH = 32 * MiB;
constexpr size_t WS_END = WS_ACT + 21 * HH;
constexpr size_t A_H0 = WS_ACT, A_Q = WS_ACT + HH, A_V = WS_ACT + HH + HH / 2, A_KF = WS_ACT + 2 * HH, A_LOGF = WS_ACT + 3 * HH, A_GATE = WS_ACT + 5 * HH;
constexpr size_t A_AQ = WS_ACT + 6 * HH, A_AK = A_AQ + HH / 2, A_AV = A_AK + HH / 2, A_YAB = A_AV + HH / 2, A_U = A_YAB + HH, A_SC = A_U + 4 * HH, A_ATTO = A_SC + 2 * HH;
constexpr size_t M_RPART = WS_ACT + 16 * MiB, M_RPSS = WS_ACT + 24 * MiB;
constexpr size_t M_HB = WS_ACT, M_XE = WS_ACT + HH, M_HID = WS_ACT + 3 * HH, M_YE = WS_ACT + 9 * HH;
constexpr size_t R_H1 = WS_ACT, R_MIX = WS_ACT + 2 * HH, R_RR = WS_ACT + 9 * HH, R_KK = WS_ACT + 11 * HH, R_VV = WS_ACT + 13 * HH, R_L1O = WS_ACT + 15 * HH;
constexpr size_t R_SREC = WS_ACT + 2 * HH;
constexpr size_t R_REC_A = WS_ACT + 15 * HH;
constexpr size_t R_GREC = WS_ACT + 4 * HH;
constexpr size_t R_KKN = R_H1;
constexpr size_t R_LOGW = R_MIX;
constexpr size_t R_AA = R_MIX + 4 * HH;
constexpr size_t R_G = R_MIX + 6 * HH;
constexpr size_t R_YG = WS_ACT + HH;

struct Params { const float* in[31]; float* out; unsigned char* ws; int lo, hi; };
typedef const __attribute__((address_space(4))) Params* KP;

__device__ __forceinline__ int tid_() { int t = threadIdx.x; asm volatile("" : "+v"(t)); return t; }

constexpr int BM = 256, BK = 64, HALF = 128, HT = HALF * BK;
__device__ __forceinline__ int lds_byte(int r, int c) { int st = (r >> 4) * 2 + (c >> 5), rr = r & 15, cc = c & 31, ob = rr * 64 + cc * 2; return st * 1024 + (ob ^ (((ob >> 9) & 1) << 5)); }
__device__ __forceinline__ void stage_rc(int b, int& R, int& C) { int st = b / 1024, sb = b % 1024, swz = sb ^ (((sb >> 9) & 1) << 5); R = (st >> 1) * 16 + swz / 64; C = (st & 1) * 32 + (swz % 64) / 2; }

__device__ __forceinline__ void tile_order(int L, int nM, int nN, int& pm, int& pn) {
    const int nwg = nM * nN, q = nwg / 8, xcd = L % 8, off = L / 8, wgid = xcd * q + off;
    const int nig = 8 * nN, gid = wgid / nig, w = wgid % nig;
    pm = gid * 8 + (w % 8); pn = w / 8;
}
template <class T> __device__ __forceinline__ T* uni_ptr(T* p) {
    const unsigned long long u = (unsigned long long)p;
    const unsigned lo = __builtin_amdgcn_readfirstlane((unsigned)u), hi = __builtin_amdgcn_readfirstlane((unsigned)(u >> 32));
    return (T*)(((unsigned long long)hi << 32) | lo);
}

struct GemmNext { const bf16_t* A; const bf16_t* Bt; const int* gidx; int brow, bcol, valid; };
template <class Epi, bool GATHER = false, bool F8 = false>
__device__ __forceinline__ void gemm_tile(const bf16_t* __restrict__ A, const bf16_t* __restrict__ Bt, int K, int brow, int bcol, bf16_t* shm, const Epi& epi, const int* __restrict__ gidx = nullptr,
                                          int pre = 0, GemmNext nx = GemmNext{nullptr, nullptr, nullptr, 0, 0, 0}) {
#define SA(b,h) (shm+((b)*2+(h))*HT)
#define SB(b,h) (shm+(4+(b)*2+(h))*HT)
#define STAGE_X(P,BASE,br,kt) do{ const char* _gb = (const char*)((BASE) + (long)(br)*K + (long)(kt)*BK); \
    __builtin_amdgcn_global_load_lds((const unsigned*)(_gb + voff), (unsigned LAS*)((char*)(P) + wvu*1024), 16, 0, 0); \
    __builtin_amdgcn_global_load_lds((const unsigned*)(_gb + (size_t)K*128 + voff), (unsigned LAS*)((char*)(P) + wvu*1024 + 8192), 16, 0, 0);}while(0)
#define STAGE_A(P,br,kt) do { if constexpr (GATHER) { const char* _ga = (const char*)(A + (long)(kt)*BK); \
    __builtin_amdgcn_global_load_lds((const unsigned*)(_ga + (((br) != brow) ? vA2 : vA0)), (unsigned LAS*)((char*)(P) + wvu*1024), 16, 0, 0); \
    __builtin_amdgcn_global_load_lds((const unsigned*)(_ga + (((br) != brow) ? vA3 : vA1)), (unsigned LAS*)((char*)(P) + wvu*1024 + 8192), 16, 0, 0); } \
    else { STAGE_X(P,A,br,kt); } } while(0)
#define STAGE_B(P,br,kt) STAGE_X(P,Bt,br,kt)
typedef int i32x4_t __attribute__((ext_vector_type(4)));
#define LDA(dst,b,h) do { if constexpr (F8) { for(int m=0;m<4;++m) { \
      const i32x4_t _l = *reinterpret_cast<const i32x4_t*>((char*)SA(b,h)+lds_byte(wr*64+m*16+fr,fq*8)), _h = *reinterpret_cast<const i32x4_t*>((char*)SA(b,h)+lds_byte(wr*64+m*16+fr,32+fq*8)); \
      dst##8[m] = __builtin_shufflevector(_l, _h, 0, 1, 2, 3, 4, 5, 6, 7); } } \
    else { for(int m=0;m<4;++m)for(int k=0;k<2;++k) dst[m][k]=*reinterpret_cast<const bf16x8*>((char*)SA(b,h)+lds_byte(wr*64+m*16+fr,k*32+fq*8)); } } while(0)
#define LDB(dst,b,h) do { if constexpr (F8) { for(int n=0;n<2;++n) { \
      const i32x4_t _l = *reinterpret_cast<const i32x4_t*>((char*)SB(b,h)+lds_byte(wc*32+n*16+fr,fq*8)), _h = *reinterpret_cast<const i32x4_t*>((char*)SB(b,h)+lds_byte(wc*32+n*16+fr,32+fq*8)); \
      dst##8[n] = __builtin_shufflevector(_l, _h, 0, 1, 2, 3, 4, 5, 6, 7); } } \
    else { for(int n=0;n<2;++n)for(int k=0;k<2;++k) dst[n][k]=*reinterpret_cast<const bf16x8*>((char*)SB(b,h)+lds_byte(wc*32+n*16+fr,k*32+fq*8)); } } while(0)
#define MMA(ai,bj,At,Bq) do{__builtin_amdgcn_s_setprio(1); \
    if constexpr (F8) { for(int m=0;m<4;++m)for(int n=0;n<2;++n) \
        asm volatile("v_mfma_scale_f32_16x16x128_f8f6f4 %0, %1, %2, %0, %3, %3 op_sel_hi:[0,0,0]" : "+v"(acc[ai][bj][m][n]) : "v"(Bq##8[n]), "v"(At##8[m]), "v"(f8one)); } \
    else { for(int m=0;m<4;++m)for(int n=0;n<2;++n)for(int k=0;k<2;++k) \
      acc[ai][bj][m][n]=__builtin_amdgcn_mfma_f32_16x16x32_bf16(Bq[n][k],At[m][k],acc[ai][bj][m][n],0,0,0); } \
    __builtin_amdgcn_s_setprio(0);}while(0)
#define WAIT_V(n) asm volatile("s_waitcnt vmcnt(" #n ")":::"memory")
#define WAIT_L(n) asm volatile("s_waitcnt lgkmcnt(" #n ")":::"memory")
#define BAR __builtin_amdgcn_s_barrier()
#define SCHED __builtin_amdgcn_sched_barrier(0)
    int tz = tid_();
    int wid = tz >> 6, lane = tz & 63, wr = wid >> 2, wc = wid & 3, fr = lane & 15, fq = lane >> 4;
    const int wvu = __builtin_amdgcn_readfirstlane(tz >> 6);
    unsigned voff, vA0 = 0, vA1 = 0, vA2 = 0, vA3 = 0; { int _r, _c; stage_rc(tz * 16, _r, _c); voff = (unsigned)((_r * K + _c) * 2);
        if constexpr (GATHER) { const int* gi = gidx + brow + _r; vA0 = (unsigned)((gi[0] * K + _c) * 2); vA1 = (unsigned)((gi[64] * K + _c) * 2); vA2 = (unsigned)((gi[128] * K + _c) * 2); vA3 = (unsigned)((gi[192] * K + _c) * 2); } }
    f32x4 acc[2][2][4][2] = {};
    bf16x8 At[4][2], B0[2][2], B1[2][2];
    v8i_t At8[4], B08[2], B18[2];
    const int f8one = 0x7F7F7F7F;
    const int nt = K / BK;
    if (!pre) {
        STAGE_B(SB(0,0),bcol,0); STAGE_A(SA(0,0),brow,0);
        STAGE_B(SB(0,1),bcol+HALF,0); STAGE_A(SA(0,1),brow+HALF,0);
    }
    if (wr == 1) BAR;
    WAIT_V(4); BAR;
    STAGE_B(SB(1,0),bcol,1); STAGE_A(SA(1,0),brow,1); STAGE_B(SB(1,1),bcol+HALF,1);
    WAIT_V(6); BAR;
    for (int t = 0; t < nt - 2; t += 2) {
        LDB(B0,0,0); SCHED; LDA(At,0,0); STAGE_A(SA(1,1),brow+HALF,t+1);
        WAIT_L(8); BAR; WAIT_L(0); MMA(0,0,At,B0); BAR; SCHED;
        LDB(B1,0,1); STAGE_B(SB(0,0),bcol,t+2);
        BAR; WAIT_L(0); MMA(0,1,At,B1); BAR;
        LDA(At,0,1); STAGE_A(SA(0,0),brow,t+2);
        BAR; WAIT_L(0); MMA(1,0,At,B0); BAR; SCHED;
        STAGE_B(SB(0,1),bcol+HALF,t+2);
        WAIT_V(6); BAR; MMA(1,1,At,B1); BAR;
        LDB(B0,1,0); SCHED; LDA(At,1,0); STAGE_A(SA(0,1),brow+HALF,t+2);
        WAIT_L(8); BAR; WAIT_L(0); MMA(0,0,At,B0); BAR; SCHED;
        LDB(B1,1,1); STAGE_B(SB(1,0),bcol,t+3);
        BAR; WAIT_L(0); MMA(0,1,At,B1); BAR;
        LDA(At,1,1); STAGE_A(SA(1,0),brow,t+3);
        BAR; WAIT_L(0); MMA(1,0,At,B0); BAR; SCHED;
        STAGE_B(SB(1,1),bcol+HALF,t+3);
        WAIT_V(6); BAR; MMA(1,1,At,B1); BAR;
    }
    asm volatile("" : "+v"(tz)); wid = tz >> 6; lane = tz & 63; wr = wid >> 2; wc = wid & 3; fr = lane & 15; fq = lane >> 4;
    const int nxv = __builtin_amdgcn_readfirstlane(nx.valid);
    float rv[8] = {0.f, 0.f, 0.f, 0.f, 0.f, 0.f, 0.f, 0.f};
    if constexpr (Epi::kRowVec) { const float* rp_ = epi.rowvec() + brow + wr * 64 + fr;
#pragma unroll
        for (int q_ = 0; q_ < 8; ++q_) rv[q_] = rp_[(q_ >> 2) * 128 + (q_ & 3) * 16]; }
    int n0 = 0, n1 = 0, n2 = 0, n3 = 0;
    if constexpr (GATHER) { if (nxv) { int _r, _c; stage_rc(tz * 16, _r, _c); const int* gi = nx.gidx + nx.brow + _r; n0 = gi[0]; n1 = gi[64]; n2 = gi[128]; n3 = gi[192]; } }
    { LDB(B0,0,0); WAIT_V(0); LDA(At,0,0); STAGE_A(SA(1,1),brow+HALF,nt-1);
      BAR; WAIT_L(0); MMA(0,0,At,B0); BAR;
      LDB(B1,0,1); BAR; WAIT_L(0); MMA(0,1,At,B1); BAR;
      LDA(At,0,1); WAIT_V(4); BAR; WAIT_L(0); MMA(1,0,At,B0); MMA(1,1,At,B1); BAR; }
    { LDB(B0,1,0); LDA(At,1,0);
      WAIT_V(2);
      BAR;
      if (nxv) {
          const int wvu2 = __builtin_amdgcn_readfirstlane(tz >> 6);
          unsigned vo2; int _c2; { int _r, _c; stage_rc(tz * 16, _r, _c); vo2 = (unsigned)((_r * K + _c) * 2); _c2 = _c; }
          const char* gb0 = (const char*)(nx.Bt + (long)nx.bcol * K); const char* gb1 = (const char*)(nx.Bt + (long)(nx.bcol + HALF) * K);
          __builtin_amdgcn_global_load_lds((const unsigned*)(gb0 + vo2), (unsigned LAS*)((char*)SB(0,0) + wvu2*1024), 16, 0, 0);
          __builtin_amdgcn_global_load_lds((const unsigned*)(gb0 + (size_t)K*128 + vo2), (unsigned LAS*)((char*)SB(0,0) + wvu2*1024 + 8192), 16, 0, 0);
          if constexpr (GATHER) {
              const char* ga = (const char*)nx.A;
              __builtin_amdgcn_global_load_lds((const unsigned*)(ga + (unsigned)((n0 * K + _c2) * 2)), (unsigned LAS*)((char*)SA(0,0) + wvu2*1024), 16, 0, 0);
              __builtin_amdgcn_global_load_lds((const unsigned*)(ga + (unsigned)((n1 * K + _c2) * 2)), (unsigned LAS*)((char*)SA(0,0) + wvu2*1024 + 8192), 16, 0, 0);
          } else {
              const char* ga0 = (const char*)(nx.A + (long)nx.brow * K);
              __builtin_amdgcn_global_load_lds((const unsigned*)(ga0 + vo2), (unsigned LAS*)((char*)SA(0,0) + wvu2*1024), 16, 0, 0);
              __builtin_amdgcn_global_load_lds((const unsigned*)(ga0 + (size_t)K*128 + vo2), (unsigned LAS*)((char*)SA(0,0) + wvu2*1024 + 8192), 16, 0, 0);
          }
          __builtin_amdgcn_global_load_lds((const unsigned*)(gb1 + vo2), (unsigned LAS*)((char*)SB(0,1) + wvu2*1024), 16, 0, 0);
          __builtin_amdgcn_global_load_lds((const unsigned*)(gb1 + (size_t)K*128 + vo2), (unsigned LAS*)((char*)SB(0,1) + wvu2*1024 + 8192), 16, 0, 0);
          if constexpr (GATHER) {
              const char* ga = (const char*)nx.A;
              __builtin_amdgcn_global_load_lds((const unsigned*)(ga + (unsigned)((n2 * K + _c2) * 2)), (unsigned LAS*)((char*)SA(0,1) + wvu2*1024), 16, 0, 0);
              __builtin_amdgcn_global_load_lds((const unsigned*)(ga + (unsigned)((n3 * K + _c2) * 2)), (unsigned LAS*)((char*)SA(0,1) + wvu2*1024 + 8192), 16, 0, 0);
          } else {
              const char* ga1 = (const char*)(nx.A + (long)(nx.brow + HALF) * K);
              __builtin_amdgcn_global_load_lds((const unsigned*)(ga1 + vo2), (unsigned LAS*)((char*)SA(0,1) + wvu2*1024), 16, 0, 0);
              __builtin_amdgcn_global_load_lds((const unsigned*)(ga1 + (size_t)K*128 + vo2), (unsigned LAS*)((char*)SA(0,1) + wvu2*1024 + 8192), 16, 0, 0);
          }
      }
      WAIT_L(0); MMA(0,0,At,B0); BAR;
      LDB(B1,1,1);
      if (nxv) WAIT_V(8); else WAIT_V(0);
      BAR; WAIT_L(0); MMA(0,1,At,B1); BAR;
      LDA(At,1,1); BAR; WAIT_L(0); MMA(1,0,At,B0); MMA(1,1,At,B1); BAR; }
    if (wr == 0) BAR;
    if constexpr (F8) asm volatile("s_nop 15\n\ts_nop 15" ::: "memory");
    if constexpr (Epi::kRowVec) epi(acc, brow + wr * 64 + fr, bcol + wc * 32 + 8 * fq, rv); else epi(acc, brow + wr * 64 + fr, bcol + wc * 32 + 8 * fq);
    __syncthreads();
#undef SA
#undef SB
#undef STAGE_X
#undef STAGE_A
#undef STAGE_B
#undef LDA
#undef LDB
#undef MMA
#undef WAIT_V
#undef WAIT_L
#undef BAR
#undef SCHED
}
#define EPI_FOR3 _Pragma("unroll") for (int ai = 0; ai < 2; ++ai) _Pragma("unroll") for (int m = 0; m < 4; ++m) _Pragma("unroll") for (int bj = 0; bj < 2; ++bj)
typedef f32x4 AccT[2][2][4][2];
__device__ __forceinline__ u32x4 pk8(f32x4 a, f32x4 b) { u32x4 o = {pk_bf16(a[0], a[1]), pk_bf16(a[2], a[3]), pk_bf16(b[0], b[1]), pk_bf16(b[2], b[3])}; return o; }

struct EpiProj {
    static constexpr bool kRowVec = false;
    bf16_t *Q, *V, *KF, *AQ, *AK, *AV; bf16_t *LOGF; bf16_t *GATE; const float* LB;
    __device__ __forceinline__ void operator()(const AccT& acc, int row0, int col0) const {
        const int seg = col0 >> 9; const int cb = col0 & 511;
        EPI_FOR3 {
            const int r = row0 + ai * 128 + m * 16, c = cb + bj * 128;
            const f32x4 v0 = acc[ai][bj][m][0], v1 = acc[ai][bj][m][1];
            if (seg == 1 || seg == 2) {
                const int dir = seg - 1;
                const f32x4 lb0 = *(const f32x4*)(LB + dir * 512 + c), lb1 = *(const f32x4*)(LB + dir * 512 + c + 4);
                f32x4 lf0, lf1, k0, k1;
#pragma unroll
                for (int i = 0; i < 4; ++i) {
                    { const float e = __expf(-fabsf(v0[i])), rr = __builtin_amdgcn_rcpf(1.f + e), sm = e * rr; const float sg = v0[i] >= 0.f ? rr : sm, sgn = v0[i] >= 0.f ? sm : rr;
                      lf0[i] = __logf(lb0[i] + (1.f - lb0[i]) * sg); k0[i] = (1.f - lb0[i]) * sgn; }
                    { const float e = __expf(-fabsf(v1[i])), rr = __builtin_amdgcn_rcpf(1.f + e), sm = e * rr; const float sg = v1[i] >= 0.f ? rr : sm, sgn = v1[i] >= 0.f ? sm : rr;
                      lf1[i] = __logf(lb1[i] + (1.f - lb1[i]) * sg); k1[i] = (1.f - lb1[i]) * sgn; }
                }
                *(u32x4*)(LOGF + ((size_t)dir * S + r) * 512 + c) = pk8(lf0, lf1);
                *(u32x4*)(KF + ((size_t)dir * S + r) * 512 + c) = pk8(k0, k1);
            } else if (seg == 4) {
                f32x4 g0, g1;
#pragma unroll
                for (int i = 0; i < 4; ++i) { g0[i] = v0[i] * sigmoidf_(v0[i]); g1[i] = v1[i] * sigmoidf_(v1[i]); }
                *(u32x4*)(GATE + (size_t)r * 512 + c) = pk8(g0, g1);
            } else {
                bf16_t* dst = seg == 0 ? Q : seg == 3 ? V : seg == 5 ? AQ : seg == 6 ? AK : AV;
                const float sc = seg == 5 ? 0.125f : 1.f;
                *(u32x4*)(dst + (size_t)r * 512 + c) = pk8(v0 * sc, v1 * sc);
            }
        }
    }
};
struct EpiResid {
    const float* res; const bf16_t* resb; bf16_t* out; bf16_t* xh;
    const float* gt;
    float* part; float* pss; unsigned* cnt; float* aff; float* rstd; int* slot; char* lds; int pm, pn;
    static constexpr bool kRowVec = false; static constexpr int kMinOps = 32;
    __device__ __forceinline__ void operator()(const AccT& acc, int row0, int col0) const {
        const int tid = tid_(), lane = tid & 63, wid = tid >> 6, wr = wid >> 2, wc = wid & 3, fr = lane & 15, fq = lane >> 4;
        f32x4 gf[2][2];
#pragma unroll
        for (int bj = 0; bj < 2; ++bj) { gf[bj][0] = *(const f32x4*)(gt + fr * 1024 + col0 + bj * 128); gf[bj][1] = *(const f32x4*)(gt + fr * 1024 + col0 + bj * 128 + 4); }
        f32x4* PL = (f32x4*)lds; float* SSL = (float*)(lds + 65536);
#pragma unroll
        for (int ai = 0; ai < 2; ++ai)
#pragma unroll
            for (int m = 0; m < 4; ++m) {
                f32x4 lg = {0.f, 0.f, 0.f, 0.f}; float ss = 0.f;
#pragma unroll
                for (int bj = 0; bj < 2; ++bj) {
                    const int r = row0 + ai * 128 + m * 16, c = col0 + bj * 128;
                    f32x4 r0, r1;
                    if (res) { const float* rp = res + (size_t)r * 1024 + c; r0 = NTL((const f32x4*)rp); r1 = NTL((const f32x4*)(rp + 4)); }
                    else { const u32x4 rb = NTL((const u32x4*)(resb + (size_t)r * 1024 + c)); const u32x2 ra = {rb[0], rb[1]}, rc = {rb[2], rb[3]}; r0 = bf4_to_f32(ra); r1 = bf4_to_f32(rc); }
                    const f32x4 x0 = r0 + acc[ai][bj][m][0], x1 = r1 + acc[ai][bj][m][1];
                    *(u32x4*)(out + (size_t)r * 1024 + c) = pk8(x0, x1);
                    { u32x2 o8; o8[0] = pk4_fp8(x0[0], x0[1], x0[2], x0[3]); o8[1] = pk4_fp8(x1[0], x1[1], x1[2], x1[3]); *(u32x2*)((unsigned char*)xh + (size_t)r * 1024 + c) = o8; }
#pragma unroll
                    for (int i = 0; i < 4; ++i) { lg = __builtin_amdgcn_mfma_f32_16x16x4f32(x0[i], gf[bj][0][i], lg, 0, 0, 0); lg = __builtin_amdgcn_mfma_f32_16x16x4f32(x1[i], gf[bj][1][i], lg, 0, 0, 0);
                        ss += x0[i] * x0[i] + x1[i] * x1[i]; }
                }
                ss += __shfl_xor(ss, 16); ss += __shfl_xor(ss, 32);
                PL[(wid * 8 + ai * 4 + m) * 64 + lane] = lg;
                if (fq == 0) SSL[(wid * 8 + ai * 4 + m) * 16 + fr] = ss;
            }
        __syncthreads();
#pragma unroll
        for (int q = 0; q < 2; ++q) {
            const int idx = 2 * wc + q; const int rb = (row0 - fr) + (idx >> 2) * 128 + (idx & 3) * 16;
            f32x4 sg = {0.f, 0.f, 0.f, 0.f}; float sq = 0.f;
#pragma unroll
            for (int w2 = 0; w2 < 4; ++w2) { sg += PL[((wr * 4 + w2) * 8 + idx) * 64 + lane]; sq += SSL[((wr * 4 + w2) * 8 + idx) * 16 + fr]; }
#pragma unroll
            for (int i = 0; i < 4; ++i) __hip_atomic_store(part + ((size_t)pn * S + rb + 4 * fq + i) * 16 + fr, sg[i], __ATOMIC_RELAXED, __HIP_MEMORY_SCOPE_AGENT);
            if (fq == 0) __hip_atomic_store(pss + (size_t)pn * S + rb + fr, sq, __ATOMIC_RELAXED, __HIP_MEMORY_SCOPE_AGENT);
        }
        asm volatile("s_waitcnt vmcnt(0)" ::: "memory");
        __syncthreads();
        unsigned* flag = (unsigned*)(lds + 65536 + 4096);
        if (tid == 0) *flag = __hip_atomic_fetch_add(cnt + pm, 1u, __ATOMIC_RELAXED, __HIP_MEMORY_SCOPE_AGENT);
        __syncthreads();
        if (*flag == 3u) {
#pragma unroll 1
            for (int it = 0; it < 8; ++it) {
                const int row = pm * 256 + it * 32 + (tid >> 4), e = tid & 15;
                float lgs = 0.f, sss = 0.f;
#pragma unroll
                for (int q = 0; q < 4; ++q) { lgs += __hip_atomic_load(part + ((size_t)q * S + row) * 16 + e, __ATOMIC_RELAXED, __HIP_MEMORY_SCOPE_AGENT);
                                              sss += __hip_atomic_load(pss + (size_t)q * S + row, __ATOMIC_RELAXED, __HIP_MEMORY_SCOPE_AGENT); }
                const float rs = rsqrtf(sss * (1.f / 1024.f) + 1e-6f);
                const float lgv = lgs * rs;
                float mx = lgv;
                mx = fmaxf(mx, __shfl_xor(mx, 1)); mx = fmaxf(mx, __shfl_xor(mx, 2)); mx = fmaxf(mx, __shfl_xor(mx, 4)); mx = fmaxf(mx, __shfl_xor(mx, 8));
                const float ex = expf(lgv - mx);
                float sm = ex;
                sm += __shfl_xor(sm, 1); sm += __shfl_xor(sm, 2); sm += __shfl_xor(sm, 4); sm += __shfl_xor(sm, 8);
                aff[(size_t)e * S + row] = ex / sm;
                if (e == 0) rstd[row] = rs;
                slot[(size_t)row * 16 + e] = -1;
            }
        }
    }
};
struct EpiSwiglu {
    bf16_t* hid;
    const float* rse;
    static constexpr bool kRowVec = true;
    __device__ __forceinline__ const float* rowvec() const { return rse; }
    __device__ __forceinline__ void operator()(const AccT& acc, int row0, int col0, const float (&rv)[8]) const {
        const int fb = (col0 >> 8) * 128 + (col0 & 255);
#pragma unroll
        for (int ai = 0; ai < 2; ++ai)
#pragma unroll
            for (int m = 0; m < 4; ++m) {
                const int r = row0 + ai * 128 + m * 16; const float rs = rv[ai * 4 + m] * (1.f / 32.f);
                f32x4 h0, h1;
#pragma unroll
                for (int i = 0; i < 4; ++i) { const float g0 = rs * acc[ai][0][m][0][i], g1 = rs * acc[ai][0][m][1][i];
                    h0[i] = g0 * sigmoidf_(g0) * (rs * acc[ai][1][m][0][i]); h1[i] = g1 * sigmoidf_(g1) * (rs * acc[ai][1][m][1][i]); }
                { u32x2 o8; o8[0] = pk4_fp8(h0[0], h0[1], h0[2], h0[3]); o8[1] = pk4_fp8(h1[0], h1[1], h1[2], h1[3]); *(u32x2*)((unsigned char*)hid + (size_t)r * 2048 + fb) = o8; }
            }
    }
};
struct EpiDown {
    bf16_t* ye; const float* gw;
    static constexpr bool kRowVec = true;
    __device__ __forceinline__ const float* rowvec() const { return gw; }
    __device__ __forceinline__ void operator()(const AccT& acc, int row0, int col0, const float (&rv)[8]) const {
        EPI_FOR3 { const int r = row0 + ai * 128 + m * 16, c = col0 + bj * 128;
            const float g = rv[ai * 4 + m] * (1.f / 64.f);
            *(u32x4*)(ye + (size_t)r * 1024 + c) = pk8(acc[ai][bj][m][0] * g, acc[ai][bj][m][1] * g); }
    }
};
struct EpiRkvLora {
    int isl; bf16_t* outb; bf16_t* out; float al, be, ga, de;
    static constexpr bool kRowVec = false;
    __device__ __forceinline__ void operator()(const AccT& acc, int row0, int col0) const {
        if (isl) {
#pragma unroll
            for (int ai = 0; ai < 2; ++ai)
#pragma unroll
                for (int m = 0; m < 4; ++m) { const int r = row0 + ai * 128 + m * 16, c = col0;
                    const f32x4 v0 = acc[ai][0][m][0], v1 = acc[ai][0][m][1]; f32x4 h0, h1;
#pragma unroll
                    for (int i = 0; i < 4; ++i) { h0[i] = al * sigmoidf_(be * v0[i]) + ga + de * v0[i]; h1[i] = al * sigmoidf_(be * v1[i]) + ga + de * v1[i]; }
                    *(u32x4*)(out + (size_t)r * 128 + c) = pk8(h0, h1); }
        } else {
            EPI_FOR3 { const int r = row0 + ai * 128 + m * 16, c = col0 + bj * 128;
                NTS(pk8(acc[ai][bj][m][0], acc[ai][bj][m][1]), (u32x4*)(outb + (size_t)r * 1024 + c)); }
        }
    }
};
struct EpiLora2 {
    int isg; float scale; const float* bias; bf16_t* outb;
    static constexpr bool kRowVec = false;
    __device__ __forceinline__ void operator()(const AccT& acc, int row0, int col0) const {
        if (isg) {
            EPI_FOR3 { const int r = row0 + ai * 128 + m * 16, c = col0 + bj * 128;
                NTS(pk8(acc[ai][bj][m][0], acc[ai][bj][m][1]), (u32x4*)(outb + (size_t)r * 1024 + c)); }
        } else {
            EPI_FOR3 { const int r = row0 + ai * 128 + m * 16, c = col0 + bj * 128;
                const f32x4 b0 = *(const f32x4*)(bias + c), b1 = *(const f32x4*)(bias + c + 4); f32x4 o0, o1;
#pragma unroll
                for (int i = 0; i < 4; ++i) { o0[i] = scale * sigmoidf_(b0[i] + acc[ai][bj][m][0][i]); o1[i] = scale * sigmoidf_(b1[i] + acc[ai][bj][m][1][i]); }
                *(u32x4*)(outb + (size_t)r * 1024 + c) = pk8(o0, o1); }
        }
    }
};

__device__ __forceinline__ void cvt_tile(const float* __restrict__ src, int ldsrc, int k0, int n0, bf16_t* __restrict__ dst, int lddst, int drow0, float* tile, const float* __restrict__ kscale = nullptr, float f8scale = 0.f) {
    const int tid = tid_();
#pragma unroll
    for (int i = 0; i < 2; ++i) {
        const int idx = tid + i * 512, kk = idx >> 4, n4 = (idx & 15) * 4;
        const f32x4 v_ = __builtin_nontemporal_load((const f32x4*)(src + (size_t)(k0 + kk) * ldsrc + n0 + n4)); const float4 v = make_float4(v_[0], v_[1], v_[2], v_[3]);
        float* t = tile + kk * 65 + n4; t[0] = v.x; t[1] = v.y; t[2] = v.z; t[3] = v.w;
    }
    __syncthreads();
    const int n = tid >> 3, kq = (tid & 7) * 8;
    float f[8];
#pragma unroll
    for (int j = 0; j < 8; ++j) f[j] = tile[(kq + j) * 65 + n];
    if (kscale) {
#pragma unroll
        for (int j = 0; j < 8; ++j) f[j] *= kscale[k0 + kq + j];
    }
    const size_t drow = (size_t)(drow0 + (n & 32) + 16 * ((n >> 2) & 1) + 4 * ((n & 31) >> 3) + (n & 3));
    if (f8scale != 0.f) {
        u32x2 o8; o8[0] = pk4_fp8(f[0] * f8scale, f[1] * f8scale, f[2] * f8scale, f[3] * f8scale); o8[1] = pk4_fp8(f[4] * f8scale, f[5] * f8scale, f[6] * f8scale, f[7] * f8scale);
        __builtin_nontemporal_store(o8, (u32x2*)((unsigned char*)dst + drow * lddst + k0 + kq));
    } else {
        u32x4 o; o[0] = pk_bf16(f[0], f[1]); o[1] = pk_bf16(f[2], f[3]); o[2] = pk_bf16(f[4], f[5]); o[3] = pk_bf16(f[6], f[7]);
        *(u32x4*)(dst + drow * lddst + k0 + kq) = o;
    }
    __syncthreads();
}
__device__ __forceinline__ void cvt_job(const float* src, int K, int N, bf16_t* dst, int lddst, int mode, int& rot, int bid, int G, float* tile, const float* kscale = nullptr, float f8scale = 0.f) {
    const int nkt = K / 64, nnt = N / 64, nt = nkt * nnt;
    int start = (bid - rot) % G; if (start < 0) start += G;
    for (int t = start; t < nt; t += G) {
        const int kt = t % nkt, ntile = t / nkt, n0 = ntile * 64;
        int drow0 = n0;
        if (mode == 1) drow0 = (n0 >> 7) * 256 + (n0 & 127); else if (mode == 2) drow0 = (n0 >> 7) * 256 + 128 + (n0 & 127);
        cvt_tile(src, N, kt * 64, n0, dst, lddst, drow0, tile, kscale, f8scale);
    }
    rot = (rot + nt) % G;
}
__device__ __forceinline__ void cvt_moe_layer(KP p, int layer, int e_lo, int e_hi, int& rot, int bid, int G, float* tile) {
    bf16_t* gu = (bf16_t*)(p->ws + WS_BT_GU); bf16_t* dn = (bf16_t*)(p->ws + WS_BT_DN);
    for (int e = e_lo; e < e_hi; ++e) {
        const size_t wo = ((size_t)layer * 16 + e) * 1024 * 2048;
        cvt_job(p->in[27] + wo, 1024, 2048, (bf16_t*)((unsigned char*)gu + (size_t)e * 4096 * 1024), 1024, 1, rot, bid, G, tile, p->in[25] + (size_t)layer * 1024, 32.f);
        cvt_job(p->in[28] + wo, 1024, 2048, (bf16_t*)((unsigned char*)gu + (size_t)e * 4096 * 1024), 1024, 2, rot, bid, G, tile, p->in[25] + (size_t)layer * 1024, 32.f);
        cvt_job(p->in[29] + wo, 2048, 1024, (bf16_t*)((unsigned char*)dn + (size_t)e * 1024 * 2048), 2048, 0, rot, bid, G, tile, nullptr, 64.f);
    }
}
struct CvGroup { const float* src; int lds, e, mat, kt, ng; };
__device__ __forceinline__ CvGroup cv_decode(KP p, int layer, int e_lo, int g) {
    CvGroup d; d.e = e_lo + g / 384; const int r = g % 384; d.mat = r >> 7; const int t = r & 127;
    const size_t wo = ((size_t)layer * 16 + d.e) * 1024 * 2048;
    d.kt = d.mat < 2 ? (t & 15) : (t & 31); d.ng = d.mat < 2 ? (t >> 4) : (t >> 5); d.lds = d.mat < 2 ? 2048 : 1024;
    d.src = (d.mat == 0 ? p->in[27] : d.mat == 1 ? p->in[28] : p->in[29]) + wo + (size_t)(d.kt * 64) * d.lds + d.ng * 256;
    return d;
}
__device__ __forceinline__ void cv_request(KP p, int layer, int e_lo, int g, f32x4 (&pf)[8]) {
    const CvGroup d = cv_decode(p, layer, e_lo, g); const int td = tid_();
#pragma unroll
    for (int c = 0; c < 4; ++c)
#pragma unroll
        for (int i = 0; i < 2; ++i) { const int idx = td + i * 512, kk = idx >> 4, n4 = (idx & 15) * 4; pf[c * 2 + i] = __builtin_nontemporal_load((const f32x4*)(d.src + (size_t)kk * d.lds + 64 * c + n4)); }
}
__device__ __forceinline__ void cv_to_lds(const f32x4 (&pf)[8], float* tile) {
    const int td = tid_();
#pragma unroll
    for (int c = 0; c < 4; ++c)
#pragma unroll
        for (int i = 0; i < 2; ++i) { const int idx = td + i * 512, kk = idx >> 4, n4 = (idx & 15) * 4; const f32x4 v = pf[c * 2 + i];
            float* t = tile + c * 4160 + kk * 65 + n4; t[0] = v[0]; t[1] = v[1]; t[2] = v[2]; t[3] = v[3]; }
}
__device__ __forceinline__ void cv_store(KP p, int layer, int e_lo, int g, const float* tile) {
    const CvGroup d = cv_decode(p, layer, e_lo, g); const int td = tid_();
    const int n = td >> 3, kq = (td & 7) * 8, k0 = d.kt * 64;
    const float f8scale = d.mat < 2 ? 32.f : 64.f;
    const float* gainp = p->in[25] + (size_t)layer * 1024;
    unsigned char* dst = d.mat < 2 ? p->ws + WS_BT_GU + (size_t)d.e * 4096 * 1024 : p->ws + WS_BT_DN + (size_t)d.e * 1024 * 2048;
    const int lddst = d.mat < 2 ? 1024 : 2048;
    float ks[8];
#pragma unroll
    for (int j = 0; j < 8; ++j) ks[j] = d.mat < 2 ? gainp[k0 + kq + j] * f8scale : f8scale;
#pragma unroll
    for (int c = 0; c < 4; ++c) {
        const int n0 = d.ng * 256 + 64 * c;
        const int drow0 = d.mat == 0 ? (n0 >> 7) * 256 + (n0 & 127) : d.mat == 1 ? (n0 >> 7) * 256 + 128 + (n0 & 127) : n0;
        float f[8];
#pragma unroll
        for (int j = 0; j < 8; ++j) f[j] = tile[c * 4160 + (kq + j) * 65 + n] * ks[j];
        const size_t drow = (size_t)(drow0 + (n & 32) + 16 * ((n >> 2) & 1) + 4 * ((n & 31) >> 3) + (n & 3));
        u32x2 o8; o8[0] = pk4_fp8(f[0], f[1], f[2], f[3]); o8[1] = pk4_fp8(f[4], f[5], f[6], f[7]);
        __builtin_nontemporal_store(o8, (u32x2*)(dst + drow * lddst + k0 + kq));
    }
}
__device__ __forceinline__ void cvt_moe_tiles(KP p, int layer, int e_lo, int e_hi, int bid, int G, float* tile) {
    const int nt = (e_hi - e_lo) * 1536, td = tid_();
    float* gl = tile + 64 * 65;
    { const float* gainp = p->in[25] + (size_t)layer * 1024; for (int i = td; i < 1024; i += NTHR) gl[i] = gainp[i] * 32.f; }
    f32x4 pf[4][2];
#define CT_DECODE(t) const int e_ = e_lo + (t) / 1536, r_ = (t) % 1536, mat_ = r_ >> 9, q_ = r_ & 511; \
        const size_t wo_ = ((size_t)layer * 16 + e_) * 1024 * 2048; \
        const int kt_ = mat_ < 2 ? (q_ & 15) : (q_ & 31), nt_ = mat_ < 2 ? (q_ >> 4) : (q_ >> 5), lds_ = mat_ < 2 ? 2048 : 1024; \
        const float* src_ = (mat_ == 0 ? p->in[27] : mat_ == 1 ? p->in[28] : p->in[29]) + wo_ + (size_t)(kt_ * 64) * lds_ + nt_ * 64;
#define CT_LOAD(t, SL) do { if ((t) < nt) { CT_DECODE(t) _Pragma("unroll") for (int i = 0; i < 2; ++i) { const int idx = td + i * 512, kk = idx >> 4, n4 = (idx & 15) * 4; \
        pf[SL][i] = NTL((const f32x4*)(src_ + (size_t)kk * lds_ + n4)); } } } while (0)
#define CT_STEP(t, SL) do { if ((t) < nt) { \
        _Pragma("unroll") for (int i = 0; i < 2; ++i) { const int idx = td + i * 512, kk = idx >> 4, n4 = (idx & 15) * 4; float* w = tile + kk * 65 + n4; w[0] = pf[SL][i][0]; w[1] = pf[SL][i][1]; w[2] = pf[SL][i][2]; w[3] = pf[SL][i][3]; } \
        CT_LOAD((t) + 4 * G, SL); \
        __syncthreads(); \
        { CT_DECODE(t) (void)src_; \
          const int n = td >> 3, kq = (td & 7) * 8, k0 = kt_ * 64; \
          unsigned char* dst = mat_ < 2 ? p->ws + WS_BT_GU + (size_t)e_ * 4096 * 1024 : p->ws + WS_BT_DN + (size_t)e_ * 1024 * 2048; \
          const int lddst = mat_ < 2 ? 1024 : 2048, n0 = nt_ * 64; \
          const int drow0 = mat_ == 0 ? (n0 >> 7) * 256 + (n0 & 127) : mat_ == 1 ? (n0 >> 7) * 256 + 128 + (n0 & 127) : n0; \
          float f[8]; \
          _Pragma("unroll") for (int j = 0; j < 8; ++j) f[j] = tile[(kq + j) * 65 + n] * (mat_ < 2 ? gl[k0 + kq + j] : 64.f); \
          const size_t drow = (size_t)(drow0 + (n & 32) + 16 * ((n >> 2) & 1) + 4 * ((n & 31) >> 3) + (n & 3)); \
          u32x2 o8; o8[0] = pk4_fp8(f[0], f[1], f[2], f[3]); o8[1] = pk4_fp8(f[4], f[5], f[6], f[7]); \
          NTS(o8, (u32x2*)(dst + drow * lddst + k0 + kq)); } \
        __syncthreads(); } } while (0)
    CT_LOAD(bid, 0); CT_LOAD(bid + G, 1); CT_LOAD(bid + 2 * G, 2); CT_LOAD(bid + 3 * G, 3);
    __syncthreads();
    for (int t = bid; t < nt; t += 4 * G) { CT_STEP(t, 0); CT_STEP(t + G, 1); CT_STEP(t + 2 * G, 2); CT_STEP(t + 3 * G, 3); }
#undef CT_DECODE
#undef CT_LOAD
#undef CT_STEP
}
__device__ __forceinline__ void rms_rows_bf16(const float* __restrict__ x, const float* __restrict__ gain, bf16_t* __restrict__ out, int bid, int G) {
    const int lane = tid_() & 63, wv = tid_() >> 6;
    for (int r = bid * 8 + wv; r < S; r += G * 8) {
        float4 v[4]; float ss = 0.f;
#pragma unroll
        for (int i = 0; i < 4; ++i) { { const f32x4 t_ = NTL((const f32x4*)(x + (size_t)r * 1024 + (i * 64 + lane) * 4)); v[i] = make_float4(t_[0], t_[1], t_[2], t_[3]); } ss += v[i].x * v[i].x + v[i].y * v[i].y + v[i].z * v[i].z + v[i].w * v[i].w; }
        ss = wave_sum(ss);
        const float rs = rsqrtf(ss * (1.f / 1024.f) + 1e-6f);
#pragma unroll
        for (int i = 0; i < 4; ++i) { const float4 g = *(const float4*)(gain + (i * 64 + lane) * 4);
            u32x2 o; o[0] = pk_bf16(v[i].x * rs * g.x, v[i].y * rs * g.y); o[1] = pk_bf16(v[i].z * rs * g.z, v[i].w * rs * g.w);
            *(u32x2*)(out + (size_t)r * 1024 + (i * 64 + lane) * 4) = o; }
    }
}
__device__ __forceinline__ int t5_bucket(int rel) {
    const int n = rel < 0 ? -rel : rel;
    int b;
    if (n < 8) b = n; else b = n >= 559 ? 15 : n >= 305 ? 14 : n >= 166 ? 13 : n >= 91 ? 12 : n >= 50 ? 11 : n >= 27 ? 10 : n >= 15 ? 9 : 8;
    return (rel > 0 ? 16 : 0) + b;
}
__device__ __forceinline__ void phase_prologue(KP p, char* smem) {
    const int bid = blockIdx.x, G = gridDim.x, tid = tid_();
    float* tile = (float*)smem;
    rms_rows_bf16(p->in[0], p->in[3], (bf16_t*)(p->ws + A_H0), bid, G);
    { float* GT = (float*)(p->ws + WS_GT);
      for (int i = bid * NTHR + tid; i < 2 * 16384; i += G * NTHR) { const int layer = i >> 14, k = (i >> 4) & 1023, e = i & 15;
          GT[(layer * 16 + e) * 1024 + k] = p->in[26][i] * p->in[25][layer * 1024 + k]; } }
    if (bid == 0) {
        float* LB = (float*)(p->ws + WS_LB);
        for (int i = tid; i < 1024; i += NTHR) { const float a = p->in[2][i], b = p->in[2][1024 + i], c = p->in[2][2048 + i]; const float mx = fmaxf(a, fmaxf(b, c));
            const float ea = __expf(a - mx), eb = __expf(b - mx), ec = __expf(c - mx); LB[i] = ea / (ea + eb + ec); }
    }
    if (bid == 1 % G) {
        float* BI = (float*)(p->ws + WS_BIAS);
        for (int i = tid; i < 3 * 8 * 129; i += NTHR) { const int g = i / (8 * 129), h = (i / 129) % 8, ri = i % 129; const int dil = g == 0 ? 1 : g == 1 ? 4 : 16;
            BI[(g * 8 + h) * 132 + ri] = p->in[1][t5_bucket((ri - 64) * dil) * 8 + h]; }
    }
    {
        bf16_t* l1 = (bf16_t*)(p->ws + WS_WT_L1); bf16_t* l2 = (bf16_t*)(p->ws + WS_WT_L2);
        const u32x4 z = {0u, 0u, 0u, 0u};
        for (int j = 0; j < 4; ++j) {
            const int nv = j == 3 ? 128 : 64;
            const int n16 = (256 - nv) * 1024 / 8;
            for (int i = bid * NTHR + tid; i < n16; i += G * NTHR) *(u32x4*)(l1 + (size_t)j * 256 * 1024 + (size_t)nv * 1024 + (size_t)i * 8) = z;
            const int cpr = (128 - nv) / 8;
            for (int i = bid * NTHR + tid; i < 1024 * cpr; i += G * NTHR) { const int r = i / cpr, c = nv + (i % cpr) * 8; *(u32x4*)(l2 + (size_t)j * 1024 * 128 + (size_t)r * 128 + c) = z; }
        }
    }
    int rot = 0;
    cvt_job(p->in[4], 1024, 4096, (bf16_t*)(p->ws + WS_WT_IN), 1024, 0, rot, bid, G, tile);
    cvt_job(p->in[6], 1024, 1024, (bf16_t*)(p->ws + WS_WT_OUT), 1024, 0, rot, bid, G, tile);
    for (int i = 0; i < 3; ++i) cvt_job(p->in[10] + (size_t)i * 1024 * 1024, 1024, 1024, (bf16_t*)(p->ws + WS_WT_RKV) + (size_t)i * 1024 * 1024, 1024, 0, rot, bid, G, tile);
    cvt_job(p->in[24], 1024, 1024, (bf16_t*)(p->ws + WS_WT_COUT), 1024, 0, rot, bid, G, tile);
    {
        bf16_t* l1 = (bf16_t*)(p->ws + WS_WT_L1); bf16_t* l2 = (bf16_t*)(p->ws + WS_WT_L2);
        cvt_job(p->in[12], 1024, 64, l1, 1024, 0, rot, bid, G, tile);
        cvt_job(p->in[12] + 1024 * 64, 1024, 64, l1 + 256 * 1024, 1024, 0, rot, bid, G, tile);
        cvt_job(p->in[15], 1024, 64, l1 + 2 * 256 * 1024, 1024, 0, rot, bid, G, tile);
        cvt_job(p->in[17], 1024, 128, l1 + 3 * 256 * 1024, 1024, 0, rot, bid, G, tile);
        cvt_job(p->in[13], 64, 1024, l2, 128, 0, rot, bid, G, tile);
        cvt_job(p->in[13] + 64 * 1024, 64, 1024, l2 + 1024 * 128, 128, 0, rot, bid, G, tile);
        cvt_job(p->in[16], 64, 1024, l2 + 2 * 1024 * 128, 128, 0, rot, bid, G, tile);
        cvt_job(p->in[18], 128, 1024, l2 + 3 * 1024 * 128, 128, 0, rot, bid, G, tile);
    }
    __syncthreads(); cvt_moe_tiles(p, 0, 0, 4, bid, G, tile);
}

constexpr int H_CUM = 0, H_TOT = 65536, H_KT = 66560, H_VT = 101376, H_END = 118784;
__device__ __forceinline__ void hgrn_load_cum(KP p, int c, int h, char* smem) {
    float* CUM = (float*)(smem + H_CUM); float* TOT = (float*)(smem + H_TOT);
    const bf16_t* LOGF = (const bf16_t*)(p->ws + A_LOGF);
    const int tid = tid_(), t0 = c * 64;
    for (int i = tid; i < 2 * 64 * 32; i += NTHR) {
        const int dir = i >> 11, s = (i >> 5) & 63, k4 = (i & 31) * 4;
        *(f32x4*)(CUM + (dir * 64 + s) * 128 + k4) = bf4_to_f32(*(const u32x2*)(LOGF + ((size_t)dir * S + t0 + s) * 512 + h * 128 + k4));
    }
    __syncthreads();
    if (tid < 256) {
        const int dir = tid >> 7, k = tid & 127; float* col = CUM + dir * 64 * 128 + k; float v[64];
#pragma unroll
        for (int s = 0; s < 64; ++s) v[s] = col[s * 128];
        float run = 0.f;
#pragma unroll
        for (int s = 0; s < 64; ++s) { const float x = v[s]; if (dir == 0) { run += x; v[s] = run; } else { v[s] = run; run += x; } }
#pragma unroll
        for (int s = 0; s < 64; ++s) col[s * 128] = v[s];
        TOT[dir * 128 + k] = run;
    }
    __syncthreads();
}
__device__ __forceinline__ void hgrn_load_vt(KP p, int c, int h, char* smem) {
    const bf16_t* V = (const bf16_t*)(p->ws + A_V); unsigned* VT = (unsigned*)(smem + H_VT);
    const int tid = tid_(), t0 = c * 64;
    for (int i = tid; i < 32 * 128; i += NTHR) { const int sp = i >> 7, v = i & 127;
        const unsigned a = V[(size_t)(t0 + 2 * sp) * 512 + h * 128 + v], b = V[(size_t)(t0 + 2 * sp + 1) * 512 + h * 128 + v];
        VT[v * 34 + sp] = a | (b << 16); }
}
__device__ __forceinline__ void phase_hgrn_local(KP p, char* smem) {
    const int bid = blockIdx.x, G = gridDim.x, tid = tid_(), lane = tid & 63, wv = tid >> 6, fr = lane & 15, fq = lane >> 4;
    float* CUM = (float*)(smem + H_CUM); float* TOT = (float*)(smem + H_TOT); char* KN = smem + H_KT; char* VN = smem + H_VT;
    const bf16_t* KF = (const bf16_t*)(p->ws + A_KF); const bf16_t* V = (const bf16_t*)(p->ws + A_V); const bf16_t* LOGF = (const bf16_t*)(p->ws + A_LOGF);
    bf16_t* U = (bf16_t*)(p->ws + A_U); float* DTOT = (float*)(p->ws + WS_DTOT);
    u32x2 lf[8]; u32x4 vr[2], kr[4];
    const int c8 = (tid & 15) * 8, sb = tid >> 4;
#define HL_LOAD_LF(uu) do { const int c_ = (uu) >> 2, h_ = (uu) & 3; _Pragma("unroll") for (int q = 0; q < 8; ++q) { const int dir = q >> 2, s_ = ((tid >> 5) + q * 16) & 63; \
        lf[q] = *(const u32x2*)(LOGF + ((size_t)dir * S + c_ * 64 + s_) * 512 + h_ * 128 + (tid & 31) * 4); } } while (0)
#define HL_LOAD_KV(uu) do { const int c_ = (uu) >> 2, h_ = (uu) & 3; \
        _Pragma("unroll") for (int q = 0; q < 2; ++q) vr[q] = *(const u32x4*)(V + (size_t)(c_ * 64 + sb + q * 32) * 512 + h_ * 128 + c8); \
        _Pragma("unroll") for (int q = 0; q < 4; ++q) kr[q] = *(const u32x4*)(KF + ((size_t)(q >> 1) * S + c_ * 64 + sb + (q & 1) * 32) * 512 + h_ * 128 + c8); } while (0)
    if (bid < 1024) { HL_LOAD_LF(bid); HL_LOAD_KV(bid); }
    for (int u = bid; u < 1024; u += G) {
        const int c = u >> 2, h = u & 3;
#pragma unroll
        for (int q = 0; q < 8; ++q) { const int dir = q >> 2, s_ = ((tid >> 5) + q * 16) & 63; *(f32x4*)(CUM + (dir * 64 + s_) * 128 + (tid & 31) * 4) = bf4_to_f32(lf[q]); }
        if (u + G < 1024) HL_LOAD_LF(u + G);
        __syncthreads();
        if (tid < 256) {
            const int dir = tid >> 7, k = tid & 127; float* col = CUM + dir * 64 * 128 + k; float v[64];
#pragma unroll
            for (int s2 = 0; s2 < 64; ++s2) v[s2] = col[s2 * 128];
            float run = 0.f;
#pragma unroll
            for (int s2 = 0; s2 < 64; ++s2) { const float x = v[s2]; if (dir == 0) { run += x; v[s2] = run; } else { v[s2] = run; run += x; } }
#pragma unroll
            for (int s2 = 0; s2 < 64; ++s2) col[s2 * 128] = v[s2];
            TOT[dir * 128 + k] = run;
            DTOT[((size_t)dir * 256 + c) * 512 + h * 128 + k] = __expf(run);
        }
        __syncthreads();
#pragma unroll
        for (int q = 0; q < 2; ++q) *(u32x4*)(VN + ((sb + q * 32) * 136 + c8) * 2) = vr[q];
#pragma unroll
        for (int q = 0; q < 4; ++q) { const int dir = q >> 1, s0 = sb + (q & 1) * 32;
            const f32x4 ca = *(const f32x4*)(CUM + (dir * 64 + s0) * 128 + c8), cb = *(const f32x4*)(CUM + (dir * 64 + s0) * 128 + c8 + 4);
            f32x4 wa, wb;
            if (dir == 0) { const f32x4 La = *(const f32x4*)(TOT + c8), Lb = *(const f32x4*)(TOT + c8 + 4);
#pragma unroll
                for (int j = 0; j < 4; ++j) { wa[j] = __expf(La[j] - ca[j]); wb[j] = __expf(Lb[j] - cb[j]); } }
            else {
#pragma unroll
                for (int j = 0; j < 4; ++j) { wa[j] = __expf(ca[j]); wb[j] = __expf(cb[j]); } }
            const u32x2 k01 = {kr[q][0], kr[q][1]}, k23 = {kr[q][2], kr[q][3]};
            *(u32x4*)(KN + ((dir * 64 + s0) * 136 + c8) * 2) = pk8(bf4_to_f32(k01) * wa, bf4_to_f32(k23) * wb); }
        if (u + G < 1024) HL_LOAD_KV(u + G);
        __syncthreads();
        {
            const int dir = wv >> 2, kt0 = (wv & 3) * 2;
            const char* kimg = KN + dir * 64 * 136 * 2;
            bf16x8 xf[2][2];
#pragma unroll
            for (int a = 0; a < 2; ++a)
#pragma unroll
                for (int ks = 0; ks < 2; ++ks) xf[a][ks] = lds_frag_tr(kimg, 136, kt0 + a, 32 * ks, lane);
            bf16_t* Ub = U + ((size_t)((c * 4 + h) * 2 + dir)) * 16384;
#pragma unroll
            for (int vt = 0; vt < 8; ++vt) {
                bf16x8 yf[2];
#pragma unroll
                for (int ks = 0; ks < 2; ++ks) yf[ks] = lds_frag_tr(VN, 136, vt, 32 * ks, lane);
#pragma unroll
                for (int a = 0; a < 2; ++a) {
                    f32x4 d = {0.f, 0.f, 0.f, 0.f};
                    d = mfma16(xf[a][0], yf[0], d); d = mfma16(xf[a][1], yf[1], d);
                    { u32x2 o; o[0] = pk_bf16(d[0], d[1]); o[1] = pk_bf16(d[2], d[3]); *(u32x2*)(Ub + (size_t)(vt * 16 + fr) * 128 + (kt0 + a) * 16 + 4 * fq) = o; }
                }
            }
        }
        __syncthreads();
    }
#undef HL_LOAD_LF
#undef HL_LOAD_KV
}
__device__ __forceinline__ void phase_hgrn_scan(KP p) {
    const int G = gridDim.x;
    const bf16_t* U = (const bf16_t*)(p->ws + A_U); const float* DTOT = (const float*)(p->ws + WS_DTOT); bf16_t* SC = (bf16_t*)(p->ws + A_SC);
    for (int e = blockIdx.x * NTHR + tid_(); e < 2 * 4 * 16384; e += G * NTHR) {
        const int dir = e >> 16, h = (e >> 14) & 3, vk = e & 16383, k = vk & 127;
        float st = 0.f;
        bf16_t ua[16], ub[16]; float da[16], db[16];
#define HS_LOAD(UU, DD, cc_) do { _Pragma("unroll") for (int j = 0; j < 16; ++j) { const int c = dir == 0 ? (cc_) + j : 255 - ((cc_) + j); \
            UU[j] = NTL(U + ((size_t)((c * 4 + h) * 2 + dir)) * 16384 + vk); DD[j] = DTOT[((size_t)dir * 256 + c) * 512 + h * 128 + k]; } } while (0)
#define HS_PROC(UU, DD, cc_) do { _Pragma("unroll") for (int j = 0; j < 16; ++j) { const int c = dir == 0 ? (cc_) + j : 255 - ((cc_) + j); \
            SC[((size_t)((c * 4 + h) * 2 + dir)) * 16384 + vk] = (bf16_t)(pk_bf16(st, 0.f) & 0xffffu); \
            st = DD[j] * st + bf2f(UU[j]); } } while (0)
        HS_LOAD(ua, da, 0);
#pragma unroll 1
        for (int cc = 0; cc < 256; cc += 32) {
            HS_LOAD(ub, db, cc + 16);
            HS_PROC(ua, da, cc);
            if (cc + 32 < 256) HS_LOAD(ua, da, cc + 32);
            HS_PROC(ub, db, cc + 16);
        }
#undef HS_LOAD
#undef HS_PROC
    }
}
__device__ __forceinline__ float clamp60(float x) { return fminf(fmaxf(x, -60.f), 60.f); }
__device__ __forceinline__ void phase_hgrn_out(KP p, char* smem) {
    const int bid = blockIdx.x, G = gridDim.x;
    float* CUM = (float*)(smem + H_CUM); float* TOT = (float*)(smem + H_TOT);
    float* OB = (float*)(smem + H_KT);
    const bf16_t* Qp = (const bf16_t*)(p->ws + A_Q); const bf16_t* KF = (const bf16_t*)(p->ws + A_KF); const bf16_t* SC = (const bf16_t*)(p->ws + A_SC);
    const bf16_t* GATE = (const bf16_t*)(p->ws + A_GATE); bf16_t* YAB = (bf16_t*)(p->ws + A_YAB); const float* ONORM = p->in[5];
    const bf16_t* V = (const bf16_t*)(p->ws + A_V); const bf16_t* LOGF = (const bf16_t*)(p->ws + A_LOGF); unsigned* VT = (unsigned*)(smem + H_VT);
    u32x2 lf[8]; unsigned va[4], vb[4];
#define HO_LOAD(uu) do { const int c_ = (uu) >> 2, h_ = (uu) & 3; const int t_ = tid_(); _Pragma("unroll") for (int q = 0; q < 8; ++q) { const int dr_ = q >> 2, s_ = ((t_ >> 5) + q * 16) & 63; \
        lf[q] = *(const u32x2*)(LOGF + ((size_t)dr_ * S + c_ * 64 + s_) * 512 + h_ * 128 + (t_ & 31) * 4); } \
        _Pragma("unroll") for (int q = 0; q < 4; ++q) { const bf16_t* vp_ = V + (size_t)(c_ * 64 + 2 * ((t_ >> 6) + q * 8)) * 512 + h_ * 128 + 2 * (t_ & 63); va[q] = *(const unsigned*)vp_; vb[q] = *(const unsigned*)(vp_ + 512); } } while (0)
    if (bid < 1024) HO_LOAD(bid);
    for (int u = bid; u < 1024; u += G) {
        const int c = u >> 2, h = u & 3, t0 = c * 64;
        const int tid = tid_(), lane = tid & 63, wv = tid >> 6, fr = lane & 15, fq = lane >> 4, kp = tid & 63, spb = tid >> 6;
        const int tt = wv & 3, dir = wv >> 2;
        const float* cum = CUM + dir * 64 * 128;
        const int midrow = dir == 0 ? 31 : 32;
        const int trow = tt * 16 + fr;
#pragma unroll
        for (int q = 0; q < 8; ++q) { const int dr_ = q >> 2, s_ = ((tid >> 5) + q * 16) & 63; *(f32x4*)(CUM + (dr_ * 64 + s_) * 128 + (tid & 31) * 4) = bf4_to_f32(lf[q]); }
#pragma unroll
        for (int q = 0; q < 4; ++q) { const int sp = spb + q * 8;
            VT[(2 * kp) * 34 + sp] = (va[q] & 0xffffu) | (vb[q] << 16); VT[(2 * kp + 1) * 34 + sp] = (va[q] >> 16) | (vb[q] & 0xffff0000u); }
        u32x4 qvr[4];
#pragma unroll
        for (int ks = 0; ks < 4; ++ks) qvr[ks] = *(const u32x4*)(Qp + (size_t)(t0 + trow) * 512 + h * 128 + ks * 32 + fq * 8);
        __syncthreads();
        if (tid < 256) {
            const int dr = tid >> 7, k = tid & 127; float* col = CUM + dr * 64 * 128 + k; float run = 0.f;
#pragma unroll
            for (int b4 = 0; b4 < 4; ++b4) { float v[16];
#pragma unroll
                for (int s2 = 0; s2 < 16; ++s2) v[s2] = col[(b4 * 16 + s2) * 128];
#pragma unroll
                for (int s2 = 0; s2 < 16; ++s2) { const float x = v[s2]; if (dr == 0) { run += x; v[s2] = run; } else { v[s2] = run; run += x; } }
#pragma unroll
                for (int s2 = 0; s2 < 16; ++s2) col[(b4 * 16 + s2) * 128] = v[s2]; }
            TOT[dr * 128 + k] = run;
        }
        __syncthreads();
        bf16x8 qm[4], qi[4];
#pragma unroll
        for (int ks = 0; ks < 4; ++ks) {
            const int k0 = ks * 32 + fq * 8;
            const u32x4 qv = qvr[ks];
            unsigned om[4], oi[4];
#pragma unroll
            for (int jj = 0; jj < 4; ++jj) {
                const float q0 = bf_lo(qv[jj]), q1 = bf_hi(qv[jj]);
                const int ka = k0 + 2 * jj, kb = ka + 1;
                const float ca = cum[trow * 128 + ka], cb = cum[trow * 128 + kb], ma = cum[midrow * 128 + ka], mb = cum[midrow * 128 + kb];
                float em0, em1, ei0, ei1;
                if (dir == 0) { em0 = __expf(clamp60(ca - ma)); em1 = __expf(clamp60(cb - mb)); ei0 = __expf(ca); ei1 = __expf(cb); }
                else { em0 = __expf(clamp60(ma - ca)); em1 = __expf(clamp60(mb - cb)); ei0 = __expf(TOT[128 + ka] - ca); ei1 = __expf(TOT[128 + kb] - cb); }
                om[jj] = pk_bf16(q0 * em0, q1 * em1); oi[jj] = pk_bf16(q0 * ei0, q1 * ei1);
            }
            u32x4 tm = {om[0], om[1], om[2], om[3]}, ti = {oi[0], oi[1], oi[2], oi[3]};
            qm[ks] = __builtin_bit_cast(bf16x8, tm); qi[ks] = __builtin_bit_cast(bf16x8, ti);
        }
        f32x4 acc[8];
#pragma unroll
        for (int vt = 0; vt < 8; ++vt) acc[vt] = (f32x4){0.f, 0.f, 0.f, 0.f};
        unsigned pst[4][2];
#pragma unroll
        for (int st = 0; st < 4; ++st) {
            f32x4 sc = {0.f, 0.f, 0.f, 0.f};
            const bool need = dir == 0 ? (st <= tt) : (st >= tt);
            if (need) {
                const int srow = st * 16 + fr;
#pragma unroll
                for (int ks = 0; ks < 4; ++ks) {
                    const int k0 = ks * 32 + fq * 8;
                    const u32x4 kv = *(const u32x4*)(KF + ((size_t)dir * S + t0 + srow) * 512 + h * 128 + k0);
                    unsigned ok[4];
#pragma unroll
                    for (int jj = 0; jj < 4; ++jj) {
                        const int ka = k0 + 2 * jj, kb = ka + 1;
                        const float ca = cum[srow * 128 + ka], cb = cum[srow * 128 + kb], ma = cum[midrow * 128 + ka], mb = cum[midrow * 128 + kb];
                        float e0, e1;
                        if (dir == 0) { e0 = __expf(clamp60(ma - ca)); e1 = __expf(clamp60(mb - cb)); } else { e0 = __expf(clamp60(ca - ma)); e1 = __expf(clamp60(cb - mb)); }
                        ok[jj] = pk_bf16(bf_lo(kv[jj]) * e0, bf_hi(kv[jj]) * e1);
                    }
                    u32x4 tk = {ok[0], ok[1], ok[2], ok[3]};
                    sc = mfma16(__builtin_bit_cast(bf16x8, tk), qm[ks], sc);
                }
            }
            float pv[4];
#pragma unroll
            for (int i = 0; i < 4; ++i) { const int s = st * 16 + 4 * fq + i; const bool ok2 = need && (dir == 0 ? (s <= trow) : (s >= trow)); pv[i] = ok2 ? sc[i] : 0.f; }
            pst[st][0] = pk_bf16(pv[0], pv[1]); pst[st][1] = pk_bf16(pv[2], pv[3]);
        }
        {
            const char* vtb = smem + H_VT;
#pragma unroll
            for (int pp = 0; pp < 2; ++pp) {
                const int a = 2 * pp, b = 2 * pp + 1;
                u32x4 ty = {pst[a][0], pst[a][1], pst[b][0], pst[b][1]};
                const bf16x8 yf = __builtin_bit_cast(bf16x8, ty);
#pragma unroll
                for (int vt = 0; vt < 8; ++vt) {
                    const char* r0 = vtb + ((vt * 16 + fr) * 68) * 2;
                    const u32x2 lo = *(const u32x2*)(r0 + (16 * a + 4 * fq) * 2), hi = *(const u32x2*)(r0 + (16 * b + 4 * fq) * 2);
                    u32x4 tx = {lo[0], lo[1], hi[0], hi[1]};
                    acc[vt] = mfma16(__builtin_bit_cast(bf16x8, tx), yf, acc[vt]);
                }
            }
        }
        {
            const bf16_t* scb = SC + ((size_t)((c * 4 + h) * 2 + dir)) * 16384;
#pragma unroll
            for (int ks = 0; ks < 4; ++ks)
#pragma unroll
                for (int vt = 0; vt < 8; ++vt) {
                    const u32x4 sv = *(const u32x4*)(scb + (size_t)(vt * 16 + fr) * 128 + ks * 32 + fq * 8);
                    acc[vt] = mfma16(__builtin_bit_cast(bf16x8, sv), qi[ks], acc[vt]);
                }
        }
        if (u + G < 1024) HO_LOAD(u + G);
        __syncthreads();
        if (dir == 1) {
#pragma unroll
            for (int vt = 0; vt < 8; ++vt) *(f32x4*)(OB + ((tt * 64 + lane) * 32 + vt * 4)) = acc[vt];
        }
        __syncthreads();
        if (dir == 0) {
            float ss = 0.f;
#pragma unroll
            for (int vt = 0; vt < 8; ++vt) { const f32x4 o = *(const f32x4*)(OB + ((tt * 64 + lane) * 32 + vt * 4)); acc[vt] += o;
                ss += acc[vt][0] * acc[vt][0] + acc[vt][1] * acc[vt][1] + acc[vt][2] * acc[vt][2] + acc[vt][3] * acc[vt][3]; }
            ss += __shfl_xor(ss, 16); ss += __shfl_xor(ss, 32);
            const float rs = rsqrtf(ss * (1.f / 128.f) + 1e-6f);
            const int t = t0 + trow;
#pragma unroll
            for (int vt = 0; vt < 8; ++vt) {
                const int v = vt * 16 + 4 * fq;
                const f32x4 on = *(const f32x4*)(ONORM + h * 128 + v); const f32x4 g = bf4_to_f32(*(const u32x2*)(GATE + (size_t)t * 512 + h * 128 + v));
                u32x2 o; o[0] = pk_bf16(acc[vt][0] * rs * on[0] * g[0], acc[vt][1] * rs * on[1] * g[1]); o[1] = pk_bf16(acc[vt][2] * rs * on[2] * g[2], acc[vt][3] * rs * on[3] * g[3]);
                *(u32x2*)(YAB + (size_t)t * 1024 + h * 128 + v) = o;
            }
        }
        __syncthreads();
    }
#undef HO_LOAD
}

constexpr int AT_V = 0;
constexpr int AT_BIAS = 39168;
constexpr int AT_KL = 39936;
constexpr int AT_CVT = 79104;
__device__ __forceinline__ void phase_attention(KP p, char* smem) {
    const int bid = blockIdx.x, G = gridDim.x, tid = tid_(), lane = tid & 63, wv = tid >> 6, fr = lane & 15, fq = lane >> 4;
    const bf16_t* AQ = (const bf16_t*)(p->ws + A_AQ); const bf16_t* AK = (const bf16_t*)(p->ws + A_AK); const bf16_t* AV = (const bf16_t*)(p->ws + A_AV);
    bf16_t* ATTO = (bf16_t*)(p->ws + A_ATTO); float* ATTL = (float*)(p->ws + WS_ATTL); const float* BI = (const float*)(p->ws + WS_BIAS);
    float* BS = (float*)(smem + AT_BIAS);
    __syncthreads();
    if (tid < 128) { const u32x4 z4 = {0u, 0u, 0u, 0u}; *(u32x4*)(smem + AT_V + (256 + (tid >> 3)) * 144 + (tid & 7) * 16) = z4; }
    float* cvtile = (float*)(smem + AT_CVT);
    f32x4 cvpf[8]; int cvprev = -1;
    for (int u = bid; u < 3072; u += G) {
        cv_request(p, 0, 4, u, cvpf);
        if (cvprev >= 0) cv_store(p, 0, 4, cvprev, cvtile);
        const int g = u >> 10, rem = u & 1023, h = rem & 7, blk = rem >> 3;
        const int dil = g == 0 ? 1 : g == 1 ? 4 : 16, L = S / dil;
        const int r = blk % dil, jb = blk / dil, j0 = jb * 128, jw0 = j0 - 64;
        const int jq = j0 + 16 * wv + fr;
        const size_t qtok = (size_t)jq * dil + r;
        f32x4 sc[9];
        bf16x8 qf[2];
        {
            const int s = tid & 255, dq = tid >> 8;
            const int j = jw0 + s; const bool ok = (j >= 0 && j < L);
            const size_t tok = ok ? (size_t)j * dil + r : 0;
            u32x4 vreg[4], kreg[4];
#pragma unroll
            for (int cch = 0; cch < 4; ++cch) { vreg[cch] = (u32x4){0u, 0u, 0u, 0u}; kreg[cch] = (u32x4){0u, 0u, 0u, 0u};
                if (ok) { vreg[cch] = *(const u32x4*)(AV + tok * 512 + h * 64 + dq * 32 + cch * 8); kreg[cch] = *(const u32x4*)(AK + tok * 512 + h * 64 + dq * 32 + cch * 8); } }
#pragma unroll
            for (int ks = 0; ks < 2; ++ks) { const u32x4 t = *(const u32x4*)(AQ + qtok * 512 + h * 64 + ks * 32 + fq * 8); qf[ks] = __builtin_bit_cast(bf16x8, t); }
#pragma unroll
            for (int cch = 0; cch < 4; ++cch) {
                const int dh0 = dq * 32 + cch * 8;
                *(u32x4*)(smem + AT_KL + s * 144 + dh0 * 2) = kreg[cch];
                *(u32x4*)(smem + AT_V + s * 144 + dh0 * 2) = vreg[cch];
            }
            if (tid < 160) BS[tid] = (tid >= 16 && tid <= 144) ? BI[(g * 8 + h) * 132 + tid - 16] : -1e30f;
        }
        __syncthreads();
#pragma unroll
        for (int st = 0; st < 9; ++st) {
            f32x4 d = {0.f, 0.f, 0.f, 0.f};
#pragma unroll
            for (int ks = 0; ks < 2; ++ks) { const u32x4 t = *(const u32x4*)(smem + AT_KL + (16 * wv + 16 * st + fr) * 144 + ks * 64 + fq * 16); d = mfma16(__builtin_bit_cast(bf16x8, t), qf[ks], d); }
            sc[st] = d;
        }
        {
            float mx = -1e30f;
            const float* bsl = BS + 16 + 4 * fq - fr;
#pragma unroll
            for (int st = 0; st < 9; ++st)
#pragma unroll
                for (int i = 0; i < 4; ++i) sc[st][i] += bsl[16 * st + i];
            if (jw0 < 0 || jw0 + 256 > L) {
#pragma unroll
                for (int st = 0; st < 9; ++st)
#pragma unroll
                    for (int i = 0; i < 4; ++i) { const int jk = j0 + 16 * wv - 64 + 16 * st + 4 * fq + i; if (jk < 0 || jk >= L) sc[st][i] = -1e30f; }
            }
#pragma unroll
            for (int st = 0; st < 9; ++st)
#pragma unroll
                for (int i = 0; i < 4; ++i) mx = fmaxf(mx, sc[st][i]);
            mx = fmaxf(mx, __shfl_xor(mx, 16)); mx = fmaxf(mx, __shfl_xor(mx, 32));
            float sum = 0.f; unsigned pst[10][2];
#pragma unroll
            for (int st = 0; st < 9; ++st) {
                float pv[4];
#pragma unroll
                for (int i = 0; i < 4; ++i) { pv[i] = __expf(sc[st][i] - mx); sum += pv[i]; }
                pst[st][0] = pk_bf16(pv[0], pv[1]); pst[st][1] = pk_bf16(pv[2], pv[3]);
            }
            pst[9][0] = 0u; pst[9][1] = 0u;
            sum += __shfl_xor(sum, 16); sum += __shfl_xor(sum, 32);
            f32x4 o[4];
#pragma unroll
            for (int dt = 0; dt < 4; ++dt) o[dt] = (f32x4){0.f, 0.f, 0.f, 0.f};
#pragma unroll
            for (int pp = 0; pp < 5; ++pp) {
                const int a = 2 * pp, b = 2 * pp + 1;
                u32x4 ty = {pst[a][0], pst[a][1], pst[b][0], pst[b][1]};
                const bf16x8 yf = __builtin_bit_cast(bf16x8, ty);
#pragma unroll
                for (int dt = 0; dt < 4; ++dt) {
                    const char* vb = smem + AT_V + (16 * wv + 4 * fq + ((lane & 15) >> 2)) * 144 + (16 * dt + 4 * (lane & 3)) * 2;
                    const u32x2 ta = rw_tr4(vb + 16 * a * 144), tb = rw_tr4(vb + 16 * b * 144);
                    u32x4 tx = {ta[0], ta[1], tb[0], tb[1]};
                    o[dt] = mfma16(__builtin_bit_cast(bf16x8, tx), yf, o[dt]);
                }
            }
            const float inv = 1.f / sum;
            bf16_t* ob = ATTO + ((size_t)g * S + qtok) * 512 + h * 64;
#pragma unroll
            for (int dt = 0; dt < 4; ++dt) { const f32x4 ov = o[dt] * inv; u32x2 oo = {pk_bf16(ov[0], ov[1]), pk_bf16(ov[2], ov[3])}; *(u32x2*)(ob + dt * 16 + 4 * fq) = oo; }
            if (fq == 0) ATTL[((size_t)g * S + qtok) * 8 + h] = mx + __logf(sum);
        }
        cv_to_lds(cvpf, cvtile); cvprev = u;
        __syncthreads();
    }
    if (cvprev >= 0) cv_store(p, 0, 4, cvprev, cvtile);
    __syncthreads();
}
__device__ __forceinline__ void phase_attn_merge(KP p) {
    const int G = gridDim.x;
    const bf16_t* ATTO = (const bf16_t*)(p->ws + A_ATTO); const float* ATTL = (const float*)(p->ws + WS_ATTL); bf16_t* YAB = (bf16_t*)(p->ws + A_YAB);
    for (int i = blockIdx.x * NTHR + tid_(); i < S * 128; i += G * NTHR) {
        const int t = i >> 7, c = (i & 127) * 4, h = c >> 6;
        const float l0 = ATTL[((size_t)0 * S + t) * 8 + h], l1 = ATTL[((size_t)1 * S + t) * 8 + h], l2 = ATTL[((size_t)2 * S + t) * 8 + h];
        const float mx = fmaxf(l0, fmaxf(l1, l2)); const float e0 = __expf(l0 - mx), e1 = __expf(l1 - mx), e2 = __expf(l2 - mx); const float inv = 1.f / (e0 + e1 + e2);
        const f32x4 a = bf4_to_f32(*(const u32x2*)(ATTO + ((size_t)0 * S + t) * 512 + c)), b = bf4_to_f32(*(const u32x2*)(ATTO + ((size_t)1 * S + t) * 512 + c)), d = bf4_to_f32(*(const u32x2*)(ATTO + ((size_t)2 * S + t) * 512 + c));
        const f32x4 y = (a * e0 + b * e1 + d * e2) * inv;
        u32x2 o; o[0] = pk_bf16(y[0], y[1]); o[1] = pk_bf16(y[2], y[3]);
        *(u32x2*)(YAB + (size_t)t * 1024 + 512 + c) = o;
    }
}

__device__ __forceinline__ void phase_moe_router(KP p, int layer, const float* __restrict__ X, char* smem) {
    const int bid = blockIdx.x, G = gridDim.x, tid = tid_(), lane = tid & 63, wv = tid >> 6, fr = lane & 15, fq = lane >> 4;
    float* RT = (float*)smem;
    float* XCH = (float*)(smem + 65536);
    const float* R = p->in[26] + (size_t)layer * 1024 * 16; const float* gain = p->in[25] + (size_t)layer * 1024;
    for (int i = tid; i < 16384; i += NTHR) { const int k = i >> 4, e = i & 15; RT[e * 1024 + k] = R[i] * gain[k]; }
    __syncthreads();
    float* AFF = (float*)(p->ws + WS_AFF); int* SLOT = (int*)(p->ws + WS_SLOT); float* RSTD = (float*)(p->ws + WS_RSTD);
    const int tw = wv & 3, kh = wv >> 2;
    for (int T = bid * 4 + tw; T < S / 16; T += G * 4) {
        const int t0 = T * 16;
        f32x4 acc = {0.f, 0.f, 0.f, 0.f}; float ssq = 0.f;
        const float* xr = X + (size_t)(t0 + fr) * 1024 + kh * 512 + 4 * fq;
        const float* rr = RT + fr * 1024 + kh * 512 + 4 * fq;
#pragma unroll 1
        for (int jb = 0; jb < 4; ++jb) {
            f32x4 xa[8];
#pragma unroll
            for (int j = 0; j < 8; ++j) xa[j] = *(const f32x4*)(xr + (jb * 8 + j) * 16);
#pragma unroll
            for (int j = 0; j < 8; ++j) {
                const f32x4 rb = *(const f32x4*)(rr + (jb * 8 + j) * 16);
#pragma unroll
                for (int i = 0; i < 4; ++i) { acc = __builtin_amdgcn_mfma_f32_16x16x4f32(xa[j][i], rb[i], acc, 0, 0, 0); ssq += xa[j][i] * xa[j][i]; }
            }
        }
        ssq += __shfl_xor(ssq, 16); ssq += __shfl_xor(ssq, 32);
        if (kh == 1) { float* o = XCH + (tw * 64 + lane) * 5; o[0] = acc[0]; o[1] = acc[1]; o[2] = acc[2]; o[3] = acc[3]; o[4] = ssq; }
        __syncthreads();
        if (kh == 0) {
            const float* o = XCH + (tw * 64 + lane) * 5;
            acc[0] += o[0]; acc[1] += o[1]; acc[2] += o[2]; acc[3] += o[3]; ssq += o[4];
            const float rs_own = rsqrtf(ssq * (1.f / 1024.f) + 1e-6f);
            if (fq == 0) RSTD[t0 + fr] = rs_own;
            float aff[4];
#pragma unroll
            for (int r = 0; r < 4; ++r) {
                const float rs = __shfl(rs_own, 4 * fq + r);
                const float lg = acc[r] * rs;
                float mx = lg;
                mx = fmaxf(mx, __shfl_xor(mx, 1)); mx = fmaxf(mx, __shfl_xor(mx, 2)); mx = fmaxf(mx, __shfl_xor(mx, 4)); mx = fmaxf(mx, __shfl_xor(mx, 8));
                const float ex = expf(lg - mx);
                float sm = ex;
                sm += __shfl_xor(sm, 1); sm += __shfl_xor(sm, 2); sm += __shfl_xor(sm, 4); sm += __shfl_xor(sm, 8);
                aff[r] = ex / sm;
                SLOT[(size_t)(t0 + 4 * fq + r) * 16 + fr] = -1;
            }
            const f32x4 av = {aff[0], aff[1], aff[2], aff[3]};
            *(f32x4*)(AFF + (size_t)fr * S + t0 + 4 * fq) = av;
        }
        __syncthreads();
    }
}
__device__ __forceinline__ void phase_moe_select(KP p, char* smem) {
    const int bid = blockIdx.x, G = gridDim.x, tid = tid_(), lane = tid & 63, wv = tid >> 6;
    unsigned* vals = (unsigned*)smem; unsigned* hist = vals + 16384; unsigned* misc = hist + 256; unsigned* wsum = misc + 16;
    const float* AFF = (const float*)(p->ws + WS_AFF); int* SLOT = (int*)(p->ws + WS_SLOT); int* IDX = (int*)(p->ws + WS_IDX); float* GW = (float*)(p->ws + WS_GATEW);
    const float* RSTD = (const float*)(p->ws + WS_RSTD); float* RSE = (float*)(p->ws + WS_RSTDE);
    for (int e = bid; e < 16; e += G) {
        for (int i = tid; i < 16384; i += NTHR) vals[i] = __float_as_uint(AFF[(size_t)e * S + i]);
        unsigned long long prefix = 0ull; unsigned remaining = 2048u;
        for (int pass = 0; pass < 6; ++pass) {
            const int shift = 40 - 8 * pass;
            if (tid < 256) hist[tid] = 0u;
            __syncthreads();
            {
                unsigned cur = 0u, cn = 0u;
                for (int i = tid; i < 16384; i += NTHR) {
                    const unsigned long long key = ((unsigned long long)vals[i] << 14) | (unsigned long long)(16383 - i);
                    if ((key >> (shift + 8)) == prefix) { const unsigned d = (unsigned)(key >> shift) & 255u;
                        if (cn != 0u && d == cur) ++cn; else { if (cn != 0u) atomicAdd(&hist[cur], cn); cur = d; cn = 1u; } }
                }
                if (cn != 0u) atomicAdd(&hist[cur], cn);
            }
            __syncthreads();
            if (wv == 0) {
                unsigned cj[4]; unsigned loc = 0u;
#pragma unroll
                for (int j = 0; j < 4; ++j) { cj[j] = hist[255 - (4 * lane + j)]; loc += cj[j]; }
                unsigned inc = loc;
#pragma unroll
                for (int o = 1; o < 64; o <<= 1) { const unsigned t = __shfl_up(inc, o); if (lane >= o) inc += t; }
                unsigned before = inc - loc;
#pragma unroll
                for (int j = 0; j < 4; ++j) { if (before < remaining && remaining <= before + cj[j]) { misc[0] = 255u - (unsigned)(4 * lane + j); misc[1] = remaining - before; } before += cj[j]; }
            }
            __syncthreads();
            prefix = (prefix << 8) | (unsigned long long)misc[0]; remaining = misc[1];
            __syncthreads();
        }
        const int tb = tid * 32; unsigned sel = 0u; unsigned cnt = 0u;
#pragma unroll 4
        for (int i = 0; i < 32; ++i) { const int t = tb + i; const unsigned long long key = ((unsigned long long)vals[t] << 14) | (unsigned long long)(16383 - t); if (key >= prefix) { sel |= 1u << i; ++cnt; } }
        unsigned inc = cnt;
#pragma unroll
        for (int o = 1; o < 64; o <<= 1) { const unsigned t = __shfl_up(inc, o); if (lane >= o) inc += t; }
        if (lane == 63) wsum[wv] = inc;
        __syncthreads();
        unsigned base = inc - cnt;
        for (int w = 0; w < wv; ++w) base += wsum[w];
        for (int i = 0; i < 32; ++i) if (sel & (1u << i)) { const int t = tb + i; if (base < 2048u) { IDX[e * 2048 + base] = t; GW[e * 2048 + base] = __uint_as_float(vals[t]); RSE[e * 2048 + base] = RSTD[t]; SLOT[(size_t)t * 16 + e] = (int)base; } ++base; }
        __syncthreads();
    }
}
__device__ __forceinline__ void phase_moe_gather(KP p) {
    const int G = gridDim.x, lane = tid_() & 63, wv = tid_() >> 6;
    const bf16_t* HB = (const bf16_t*)(p->ws + M_HB); bf16_t* XE = (bf16_t*)(p->ws + M_XE); const int* IDX = (const int*)(p->ws + WS_IDX);
    for (int r = blockIdx.x * 8 + wv; r < 32768; r += G * 8) {
        const int t = IDX[r];
        const u32x4 a = *(const u32x4*)(HB + (size_t)t * 1024 + lane * 8), b = *(const u32x4*)(HB + (size_t)t * 1024 + 512 + lane * 8);
        *(u32x4*)(XE + (size_t)r * 1024 + lane * 8) = a; *(u32x4*)(XE + (size_t)r * 1024 + 512 + lane * 8) = b;
    }
}
__device__ __forceinline__ void moe_add_rows(float4 (&v)[4], const bf16_t* __restrict__ YE, int myslot, int lane) {
    unsigned mask = (unsigned)(__ballot(lane < 16 && myslot >= 0) & 0xFFFFull);
    while (mask) {
        u32x2 a[4][4]; int cnt = 0;
#pragma unroll
        for (int k = 0; k < 4; ++k) {
            if (mask) { const int e = __builtin_ctz(mask); mask &= mask - 1; const int sl = __shfl(myslot, e); ++cnt;
                const bf16_t* y = YE + ((size_t)e * 2048 + sl) * 1024;
#pragma unroll
                for (int i = 0; i < 4; ++i) a[k][i] = NTL((const u32x2*)(y + (i * 64 + lane) * 4)); }
            else {
#pragma unroll
                for (int i = 0; i < 4; ++i) a[k][i] = (u32x2){0u, 0u}; }
        }
#pragma unroll
        for (int k = 0; k < 4; ++k)
#pragma unroll
            for (int i = 0; i < 4; ++i) { v[i].x += bf_lo(a[k][i][0]); v[i].y += bf_hi(a[k][i][0]); v[i].z += bf_lo(a[k][i][1]); v[i].w += bf_hi(a[k][i][1]); }
        (void)cnt;
    }
}
__device__ __forceinline__ void phase_moe_combine(KP p, const bf16_t* __restrict__ Xin, float* __restrict__ Xout, const float* __restrict__ gain, float* __restrict__ Hout) {
    const int G = gridDim.x, lane = tid_() & 63, wv = tid_() >> 6;
    const bf16_t* YE = (const bf16_t*)(p->ws + M_YE); const int* SLOT = (const int*)(p->ws + WS_SLOT);
    u32x2 vn[4]; int slotn = -1;
    { const int r0 = blockIdx.x * 8 + wv;
      if (r0 < S) {
#pragma unroll
          for (int i = 0; i < 4; ++i) vn[i] = NTL((const u32x2*)(Xin + (size_t)r0 * 1024 + (i * 64 + lane) * 4));
          slotn = lane < 16 ? SLOT[(size_t)r0 * 16 + lane] : -1; } }
    for (int r = blockIdx.x * 8 + wv; r < S; r += G * 8) {
        float4 v[4];
#pragma unroll
        for (int i = 0; i < 4; ++i) { const f32x4 t = bf4_to_f32(vn[i]); v[i] = make_float4(t[0], t[1], t[2], t[3]); }
        const int myslot = slotn;
        { const int rn = r + G * 8;
          if (rn < S) {
#pragma unroll
              for (int i = 0; i < 4; ++i) vn[i] = NTL((const u32x2*)(Xin + (size_t)rn * 1024 + (i * 64 + lane) * 4));
              slotn = lane < 16 ? SLOT[(size_t)rn * 16 + lane] : -1; } }
        moe_add_rows(v, YE, myslot, lane);
        float ss = 0.f;
#pragma unroll
        for (int i = 0; i < 4; ++i) { if (Xout) *(float4*)(Xout + (size_t)r * 1024 + (i * 64 + lane) * 4) = v[i]; ss += v[i].x * v[i].x + v[i].y * v[i].y + v[i].z * v[i].z + v[i].w * v[i].w; }
        ss = wave_sum(ss);
        const float rs = rsqrtf(ss * (1.f / 1024.f) + 1e-6f);
#pragma unroll
        for (int i = 0; i < 4; ++i) { const float4 g = *(const float4*)(gain + (i * 64 + lane) * 4);
            float4 o; o.x = v[i].x * rs * g.x; o.y = v[i].y * rs * g.y; o.z = v[i].z * rs * g.z; o.w = v[i].w * rs * g.w;
            { const f32x4 o_ = {o.x, o.y, o.z, o.w}; NTS(o_, (f32x4*)(Hout + (size_t)r * 1024 + (i * 64 + lane) * 4)); } }
    }
}
__device__ __forceinline__ void phase_combine_mix(KP p, const bf16_t* __restrict__ Xin, bf16_t* __restrict__ Xout, const float* __restrict__ gain, char* smem) {
    const int G = gridDim.x, tid = tid_(), lane = tid & 63, wv = tid >> 6;
    const bf16_t* YE = (const bf16_t*)(p->ws + M_YE); const int* SLOT = (const int*)(p->ws + WS_SLOT);
    bf16_t* MIX = (bf16_t*)(p->ws + R_MIX); const float* mu = p->in[8]; const float* muw = p->in[9];
    for (int u = blockIdx.x; u < 256; u += G) {
        const int r0 = u * 64 - 1;
        u32x2 vn[4]; int slotn = -1;
        { const int rf = r0 + wv;
          if (rf >= 0 && rf < S) {
#pragma unroll
              for (int i = 0; i < 4; ++i) vn[i] = NTL((const u32x2*)(Xin + (size_t)rf * 1024 + (i * 64 + lane) * 4));
              slotn = lane < 16 ? SLOT[(size_t)rf * 16 + lane] : -1; } }
        for (int j = wv; j < 66; j += 8) {
            const int r = r0 + j;
            u32x2* hrow = (u32x2*)(smem + j * 2048);
            float4 v[4];
#pragma unroll
            for (int i = 0; i < 4; ++i) { const f32x4 t = bf4_to_f32(vn[i]); v[i] = make_float4(t[0], t[1], t[2], t[3]); }
            const int myslot = slotn;
            { const int rn = r + 8;
              if (j + 8 < 66 && rn >= 0 && rn < S) {
#pragma unroll
                  for (int i = 0; i < 4; ++i) vn[i] = NTL((const u32x2*)(Xin + (size_t)rn * 1024 + (i * 64 + lane) * 4));
                  slotn = lane < 16 ? SLOT[(size_t)rn * 16 + lane] : -1; } }
            if (r < 0 || r >= S) {
#pragma unroll
                for (int i = 0; i < 4; ++i) { u32x2 zz = {0u, 0u}; hrow[i * 64 + lane] = zz; }
                continue;
            }
            moe_add_rows(v, YE, myslot, lane);
            float ss = 0.f;
#pragma unroll
            for (int i = 0; i < 4; ++i) { if (j >= 1 && j <= 64) { u32x2 o = {pk_bf16(v[i].x, v[i].y), pk_bf16(v[i].z, v[i].w)}; NTS(o, (u32x2*)(Xout + (size_t)r * 1024 + (i * 64 + lane) * 4)); }
                ss += v[i].x * v[i].x + v[i].y * v[i].y + v[i].z * v[i].z + v[i].w * v[i].w; }
            ss = wave_sum(ss);
            const float rs = rsqrtf(ss * (1.f / 1024.f) + 1e-6f);
#pragma unroll
            for (int i = 0; i < 4; ++i) { const float4 g = *(const float4*)(gain + (i * 64 + lane) * 4);
                u32x2 o; o[0] = pk_bf16(v[i].x * rs * g.x, v[i].y * rs * g.y); o[1] = pk_bf16(v[i].z * rs * g.z, v[i].w * rs * g.w); hrow[i * 64 + lane] = o; }
        }
        __syncthreads();
        for (int j = 1 + wv; j <= 64; j += 8) {
            const int r = r0 + j;
#pragma unroll
            for (int i = 0; i < 2; ++i) {
                const int c = (i * 64 + lane) * 8;
                const u32x4 hb = ((const u32x4*)(smem + j * 2048))[i * 64 + lane], pb = ((const u32x4*)(smem + (j - 1) * 2048))[i * 64 + lane], nb = ((const u32x4*)(smem + (j + 1) * 2048))[i * 64 + lane];
                const u32x2 hb0 = {hb[0], hb[1]}, hb1 = {hb[2], hb[3]}, pb0 = {pb[0], pb[1]}, pb1 = {pb[2], pb[3]}, nb0 = {nb[0], nb[1]}, nb1 = {nb[2], nb[3]};
                const f32x4 h0 = bf4_to_f32(hb0), h1 = bf4_to_f32(hb1);
                const f32x4 xx0 = (bf4_to_f32(pb0) + bf4_to_f32(nb0)) * 0.5f - h0, xx1 = (bf4_to_f32(pb1) + bf4_to_f32(nb1)) * 0.5f - h1;
#pragma unroll
                for (int q = 0; q < 7; ++q) {
                    const float* mp = (q < 5 ? mu + q * 1024 : muw + (q - 5) * 1024) + c;
                    const f32x4 m0 = *(const f32x4*)mp, m1 = *(const f32x4*)(mp + 4);
                    *(u32x4*)(MIX + ((size_t)q * S + r) * 1024 + c) = pk8(h0 + xx0 * m0, h1 + xx1 * m1);
                }
            }
        }
        __syncthreads();
    }
}
__device__ __forceinline__ void moe_gemms_gateup(KP p, char* smem) {
    const bf16_t* HB = (const bf16_t*)(p->ws + M_HB); const int* IDX = (const int*)(p->ws + WS_IDX); const bf16_t* GU = (const bf16_t*)(p->ws + WS_BT_GU); bf16_t* HID = (bf16_t*)(p->ws + M_HID);
    int pre = 0;
    for (int L = blockIdx.x; L < 16 * 128; L += gridDim.x) {
        const int rr = L >> 8, x = L & 7, i = (L >> 3) & 31, e = ((rr >> 2) << 3) + x, pm = (rr & 1) * 4 + (i & 3), pn = ((rr >> 1) & 1) * 8 + (i >> 2);
        const int Ln = L + gridDim.x; GemmNext nx{HB, nullptr, nullptr, 0, 0, Ln < 16 * 128 ? 1 : 0};
        if (nx.valid) { const int rr2 = Ln >> 8, x2 = Ln & 7, i2 = (Ln >> 3) & 31, e2 = ((rr2 >> 2) << 3) + x2;
            nx.Bt = GU + (size_t)e2 * 4096 * 512; nx.gidx = IDX + e2 * 2048; nx.brow = ((rr2 & 1) * 4 + (i2 & 3)) * 256; nx.bcol = (((rr2 >> 1) & 1) * 8 + (i2 >> 2)) * 256; }
        EpiSwiglu E{HID + (size_t)e * 2048 * 1024, (const float*)(p->ws + WS_RSTDE) + e * 2048};
        gemm_tile<EpiSwiglu, true, true>(HB, GU + (size_t)e * 4096 * 512, 512, pm * 256, pn * 256, (bf16_t*)smem, E, IDX + e * 2048, pre, nx);
        pre = nx.valid;
    }
}
__device__ __forceinline__ void moe_gemms_down(KP p, char* smem) {
    const bf16_t* HID = (const bf16_t*)(p->ws + M_HID); const bf16_t* DN = (const bf16_t*)(p->ws + WS_BT_DN); bf16_t* YE = (bf16_t*)(p->ws + M_YE); const float* GW = (const float*)(p->ws + WS_GATEW);
    int pre = 0;
    for (int L = blockIdx.x; L < 16 * 32; L += gridDim.x) {
        const int rr = L >> 8, x = L & 7, i = (L >> 3) & 31, e = 8 * (1 - rr) + x, pm = i & 7, pn = i >> 3;
        const int Ln = L + gridDim.x; GemmNext nx{nullptr, nullptr, nullptr, 0, 0, Ln < 16 * 32 ? 1 : 0};
        if (nx.valid) { const int e2 = 8 * (1 - (Ln >> 8)) + (Ln & 7), i2 = (Ln >> 3) & 31; nx.A = HID + (size_t)e2 * 2048 * 1024; nx.Bt = DN + (size_t)e2 * 1024 * 1024; nx.brow = (i2 & 7) * 256; nx.bcol = (i2 >> 3) * 256; }
        EpiDown E{YE + (size_t)e * 2048 * 1024, GW + e * 2048};
        gemm_tile<EpiDown, false, true>(HID + (size_t)e * 2048 * 1024, DN + (size_t)e * 1024 * 1024, 1024, pm * 256, pn * 256, (bf16_t*)smem, E, nullptr, pre, nx);
        pre = nx.valid;
    }
}

__device__ __forceinline__ void phase_rwkv_mix(KP p) {
    const int G = gridDim.x, lane = tid_() & 63, wv = tid_() >> 6;
    const float* H1 = (const float*)(p->ws + R_H1); bf16_t* MIX = (bf16_t*)(p->ws + R_MIX);
    const float* mu = p->in[8]; const float* muw = p->in[9];
    for (int r = blockIdx.x * 8 + wv; r < S; r += G * 8) {
#pragma unroll
        for (int i = 0; i < 4; ++i) {
            const int c = (i * 64 + lane) * 4;
            const f32x4 h = *(const f32x4*)(H1 + (size_t)r * 1024 + c);
            f32x4 hp = {0.f, 0.f, 0.f, 0.f}, hn = {0.f, 0.f, 0.f, 0.f};
            if (r > 0) hp = *(const f32x4*)(H1 + (size_t)(r - 1) * 1024 + c);
            if (r < S - 1) hn = *(const f32x4*)(H1 + (size_t)(r + 1) * 1024 + c);
            const f32x4 xx = (hp + hn) * 0.5f - h;
#pragma unroll
            for (int j = 0; j < 7; ++j) {
                const f32x4 m = *(const f32x4*)((j < 5 ? mu + j * 1024 : muw + (j - 5) * 1024) + c);
                const f32x4 o = h + xx * m;
                u32x2 w; w[0] = pk_bf16(o[0], o[1]); w[1] = pk_bf16(o[2], o[3]);
                *(u32x2*)(MIX + ((size_t)j * S + r) * 1024 + c) = w;
            }
        }
    }
}
__device__ __forceinline__ void phase_rwkv_prep(KP p) {
    const int G = gridDim.x;
    float* KK = (float*)(p->ws + R_KK); float* AA = (float*)(p->ws + R_AA); float* KKN = (float*)(p->ws + R_KKN);
    const float* k_k = p->in[19]; const float* k_a = p->in[20];
    for (int i = blockIdx.x * NTHR + tid_(); i < S * 256; i += G * NTHR) {
        const int t = i >> 8, c = (i & 255) * 4;
        const f32x4 k = *(const f32x4*)(KK + (size_t)t * 1024 + c), a = *(const f32x4*)(AA + (size_t)t * 1024 + c);
        const f32x4 kkw = *(const f32x4*)(k_k + c), kaw = *(const f32x4*)(k_a + c);
        f32x4 kk = k * kkw;
        float ss = kk[0] * kk[0] + kk[1] * kk[1] + kk[2] * kk[2] + kk[3] * kk[3];
        ss += __shfl_xor(ss, 1); ss += __shfl_xor(ss, 2); ss += __shfl_xor(ss, 4); ss += __shfl_xor(ss, 8);
        const float inv = 1.f / fmaxf(sqrtf(ss), 1e-12f);
        kk = kk * inv;
        f32x4 kn, b;
#pragma unroll
        for (int j = 0; j < 4; ++j) { kn[j] = k[j] * (1.f + (a[j] - 1.f) * kaw[j]); b[j] = kk[j] * a[j]; }
        *(f32x4*)(KKN + (size_t)t * 1024 + c) = kk; *(f32x4*)(KK + (size_t)t * 1024 + c) = kn; *(f32x4*)(AA + (size_t)t * 1024 + c) = b;
    }
}
#ifndef RW_SIMPLE_INV
#define RW_SIMPLE_INV 0
#endif
constexpr int RS = 68;
constexpr int RBUF = 64 * RS * 2;
constexpr int RW_MF = 12 * RBUF;
constexpr int RW_SEG = RW_MF + 64 * 68 * 4;
constexpr int RW_PC = RW_SEG + 2048;
enum { B_AT = 0  , B_ATT = 1, B_BT = 2  , B_KT = 3  , B_RT = 4, B_BHT = 5, B_KHT = 6, B_VT = 7, B_MAK = 8, B_TT = 9, B_NBRT = 10, B_W2 = 11 };

__device__ __forceinline__ bf16x8 rw_frag(const char* buf, int row, int col) {
    const char* ad = buf + (row * RS + col) * 2;
    const u32x2 lo = *(const u32x2*)ad, hi = *(const u32x2*)(ad + 8);
    u32x4 t = {lo[0], lo[1], hi[0], hi[1]};
    return __builtin_bit_cast(bf16x8, t);
}
__device__ __forceinline__ bf16x8 rw_frag_tr(const char* img, int ntile, int c0, int lane) {
    const int g = lane >> 4, q = (lane & 15) >> 2, pp = lane & 3;
    const char* a0 = img + ((c0 + 8 * g + q) * RS + 16 * ntile + 4 * pp) * 2;
    const u32x2 lo = rw_tr4(a0), hi = rw_tr4(a0 + 4 * RS * 2);
    u32x4 t = {lo[0], lo[1], hi[0], hi[1]};
    return __builtin_bit_cast(bf16x8, t);
}
struct Frag2 { bf16x8 f[2]; };
__device__ __forceinline__ Frag2 rw_frag2(const char* buf, int tile, int fr, int fq) { Frag2 r; r.f[0] = rw_frag(buf, tile * 16 + fr, fq * 8); r.f[1] = rw_frag(buf, tile * 16 + fr, 32 + fq * 8); return r; }
__device__ __forceinline__ Frag2 rw_frag2_tr(const char* img, int ntile, int lane) { Frag2 r; r.f[0] = rw_frag_tr(img, ntile, 0, lane); r.f[1] = rw_frag_tr(img, ntile, 32, lane); return r; }
__device__ __forceinline__ f32x4 rw_mm(const Frag2& x, const Frag2& y, f32x4 acc) { acc = mfma16(x.f[0], y.f[0], acc); return mfma16(x.f[1], y.f[1], acc); }
__device__ __forceinline__ f32x4 rw_tile(const char* xbuf, int xt, const char* ybuf, int yt, f32x4 acc, int fr, int fq) {
#pragma unroll
    for (int ks = 0; ks < 2; ++ks) acc = mfma16(rw_frag(xbuf, xt * 16 + fr, ks * 32 + fq * 8), rw_frag(ybuf, yt * 16 + fr, ks * 32 + fq * 8), acc);
    return acc;
}
__device__ __forceinline__ void rw_store_t(char* buf, int xt, int yt, f32x4 d, int fr, int fq) {
    u32x2 o; o[0] = pk_bf16(d[0], d[1]); o[1] = pk_bf16(d[2], d[3]);
    *(u32x2*)(buf + ((yt * 16 + fr) * RS + xt * 16 + 4 * fq) * 2) = o;
}
__device__ __forceinline__ bool nf4(f32x4 v) { return !(fabsf(v[0]) < 1e30f) || !(fabsf(v[1]) < 1e30f) || !(fabsf(v[2]) < 1e30f) || !(fabsf(v[3]) < 1e30f); }
__device__ __forceinline__ bool big4(f32x4 v) { return (fabsf(v[0]) > 1e6f) || (fabsf(v[1]) > 1e6f) || (fabsf(v[2]) > 1e6f) || (fabsf(v[3]) > 1e6f); }
#define DBGFLAG(cond, bit) do { if (cond) atomicOr((unsigned*)(DBGW), 1u << (bit)); } while (0)
__device__ __forceinline__ bool gt4(f32x4 v, float th) { return !(fabsf(v[0]) <= th) || !(fabsf(v[1]) <= th) || !(fabsf(v[2]) <= th) || !(fabsf(v[3]) <= th); }
template <int J> __device__ __forceinline__ void rw_offdiag(const float* MF, char* TTb, int fr, int fq) {
    f32x4 Tb[3];
#pragma unroll
    for (int I = J - 1; I >= 0; --I) {
        f32x4 acc = {0.f, 0.f, 0.f, 0.f};
#pragma unroll
        for (int L = I + 1; L <= J; ++L) {
#pragma unroll
            for (int kk = 0; kk < 4; ++kk) {
                const float a = MF[(16 * I + fr) * 68 + 16 * L + 4 * fq + kk];
                const float b = (L == J) ? MF[(16 * J + 4 * fq + kk) * 68 + 16 * J + fr] : Tb[L < 3 ? L : 0][kk];
                acc = __builtin_amdgcn_mfma_f32_16x16x4f32(a, b, acc, 0, 0, 0);
            }
        }
        f32x4 res = {0.f, 0.f, 0.f, 0.f};
#pragma unroll
        for (int kk = 0; kk < 4; ++kk) { const float a = MF[(16 * I + fr) * 68 + 16 * I + 4 * fq + kk]; res = __builtin_amdgcn_mfma_f32_16x16x4f32(a, acc[kk], res, 0, 0, 0); }
        Tb[I] = res;         u32x2 o; o[0] = pk_bf16(res[0], res[1]); o[1] = pk_bf16(res[2], res[3]);
        *(u32x2*)(TTb + ((16 * J + fr) * RS + 16 * I + 4 * fq) * 2) = o;
    }
}

typedef float f32x2_t __attribute__((ext_vector_type(2)));
__device__ __forceinline__ unsigned pk4_fp8s(f32x4 v) {
    float a = fminf(fmaxf(v[0] * 8.f, -448.f), 448.f), b = fminf(fmaxf(v[1] * 8.f, -448.f), 448.f), c = fminf(fmaxf(v[2] * 8.f, -448.f), 448.f), d = fminf(fmaxf(v[3] * 8.f, -448.f), 448.f);
    return pk4_fp8(a, b, c, d);
}
__device__ __forceinline__ unsigned pk4_fp8c(f32x4 v) {
    return pk4_fp8(fminf(fmaxf(v[0], -448.f), 448.f), fminf(fmaxf(v[1], -448.f), 448.f), fminf(fmaxf(v[2], -448.f), 448.f), fminf(fmaxf(v[3], -448.f), 448.f));
}
__device__ __forceinline__ bf16x8 fp8x8_to_bf16(unsigned lo, unsigned hi) {
    const f32x2_t a = __builtin_amdgcn_cvt_pk_f32_fp8((int)lo, false), b = __builtin_amdgcn_cvt_pk_f32_fp8((int)lo, true), c = __builtin_amdgcn_cvt_pk_f32_fp8((int)hi, false), d = __builtin_amdgcn_cvt_pk_f32_fp8((int)hi, true);
    const u32x4 t = {pk_bf16(a[0], a[1]), pk_bf16(b[0], b[1]), pk_bf16(c[0], c[1]), pk_bf16(d[0], d[1])};
    return __builtin_bit_cast(bf16x8, t);
}
__device__ __forceinline__ unsigned char* rw_rec(unsigned char* ws, size_t uidx) {
    return ws + R_REC_A + uidx * 20480;
}
__device__ __forceinline__ void phase_rwkv_chunk_local(KP p, char* smem) {
    const int bid = blockIdx.x, G = gridDim.x, tid = tid_();
    const bf16_t* RR = (const bf16_t*)(p->ws + R_RR); const bf16_t* KK = (const bf16_t*)(p->ws + R_KK); const bf16_t* VV = (const bf16_t*)(p->ws + R_VV);
    const bf16_t* AAp = (const bf16_t*)(p->ws + R_AA); const bf16_t* LOGW = (const bf16_t*)(p->ws + R_LOGW);
    const float* k_k = p->in[19]; const float* k_a = p->in[20]; const float* r_kp = p->in[21];
    float* CS = (float*)(smem + RW_MF); float* MF = CS; float* SEG = (float*)(smem + RW_SEG); float* PC = (float*)(smem + RW_PC); float* EM = PC + 64; float* EMI = PC + 128;
#define RBUFP(i) (smem + (i) * RBUF)
    const f32x4 zero4 = {0.f, 0.f, 0.f, 0.f};
    const int tau = tid >> 3, k8 = (tid & 7) * 8;
    f32x4 in_lw[2], in_a[2]; u32x4 in_rb, in_kb, in_vb, in_lwb, in_ab;
#define RW_LOAD(uu) do { const int z_ = (uu) & 1, h_ = ((uu) >> 1) & 15, t0_ = ((uu) >> 5) * 64; const int tok_ = z_ ? t0_ + 63 - tau : t0_ + tau; \
        const size_t o_ = (size_t)tok_ * 1024 + h_ * 64 + k8; \
        in_lwb = *(const u32x4*)(LOGW + (size_t)z_ * S * 1024 + o_); in_rb = *(const u32x4*)(RR + o_); \
        in_kb = *(const u32x4*)(KK + o_); in_ab = *(const u32x4*)(AAp + o_); \
        in_vb = *(const u32x4*)(VV + o_); } while (0)
    if (bid < 8192) RW_LOAD(bid);
    for (int u = bid; u < 8192; u += G) {
        const int z = u & 1, h = (u >> 1) & 15, cseq = u >> 5, cproc = z ? 255 - cseq : cseq;
        const size_t uidx = (size_t)(z * 16 + h) * 256 + cproc;
        u32x4* REC = (u32x4*)rw_rec(p->ws, uidx);
        const int tl = tid_(), lane = tl & 63, wv = tl >> 6, fr = lane & 15, fq = lane >> 4, yt = wv & 3, xp = wv >> 2;
        { const u32x2 l0 = {in_lwb[0], in_lwb[1]}, l1 = {in_lwb[2], in_lwb[3]}, a0 = {in_ab[0], in_ab[1]}, a1 = {in_ab[2], in_ab[3]};
          in_lw[0] = bf4_to_f32(l0); in_lw[1] = bf4_to_f32(l1); in_a[0] = bf4_to_f32(a0); in_a[1] = bf4_to_f32(a1); }
        *(f32x4*)(CS + tau * 68 + k8) = in_lw[0]; *(f32x4*)(CS + tau * 68 + k8 + 4) = in_lw[1];
        __syncthreads();
        { const int k = tid & 63, seg = tid >> 6; float loc[8]; float run = 0.f;
#pragma unroll
          for (int j = 0; j < 8; ++j) { run += CS[(seg * 8 + j) * 68 + k]; loc[j] = run; }
          SEG[seg * 64 + k] = run;
          __syncthreads();
          float off = 0.f;
          for (int s2 = 0; s2 < seg; ++s2) off += SEG[s2 * 64 + k];
#pragma unroll
          for (int j = 0; j < 8; ++j) CS[(seg * 8 + j) * 68 + k] = off + loc[j];
          if (seg == 3) { const float mv = off + loc[7]; EM[k] = __expf(mv); EMI[k] = __expf(-mv); }
          if (seg == 7) PC[k] = __expf(off + loc[7]);
        }
        __syncthreads();
        {
            f32x4 kn4[2], kx4[2], b4[2], in_r[2], in_k[2], in_v[2];
            { const u32x2 r0 = {in_rb[0], in_rb[1]}, r1 = {in_rb[2], in_rb[3]}, q0 = {in_kb[0], in_kb[1]}, q1 = {in_kb[2], in_kb[3]}, w0 = {in_vb[0], in_vb[1]}, w1 = {in_vb[2], in_vb[3]};
              in_r[0] = bf4_to_f32(r0); in_r[1] = bf4_to_f32(r1); in_k[0] = bf4_to_f32(q0); in_k[1] = bf4_to_f32(q1); in_v[0] = bf4_to_f32(w0); in_v[1] = bf4_to_f32(w1); }
            {
                const f32x4 kk0 = *(const f32x4*)(k_k + h * 64 + k8), kk1 = *(const f32x4*)(k_k + h * 64 + k8 + 4), ka0 = *(const f32x4*)(k_a + h * 64 + k8), ka1 = *(const f32x4*)(k_a + h * 64 + k8 + 4);
                f32x4 q0 = in_k[0] * kk0, q1 = in_k[1] * kk1;
                float ss = q0[0] * q0[0] + q0[1] * q0[1] + q0[2] * q0[2] + q0[3] * q0[3] + q1[0] * q1[0] + q1[1] * q1[1] + q1[2] * q1[2] + q1[3] * q1[3];
                ss += __shfl_xor(ss, 1); ss += __shfl_xor(ss, 2); ss += __shfl_xor(ss, 4);
                const float inv = 1.f / fmaxf(sqrtf(ss), 1e-12f);
                kn4[0] = q0 * inv; kn4[1] = q1 * inv;
#pragma unroll
                for (int j = 0; j < 4; ++j) { kx4[0][j] = in_k[0][j] * (1.f + (in_a[0][j] - 1.f) * ka0[j]); kx4[1][j] = in_k[1][j] * (1.f + (in_a[1][j] - 1.f) * ka1[j]);
                    b4[0][j] = kn4[0][j] * in_a[0][j]; b4[1][j] = kn4[1][j] * in_a[1][j]; }
                if (z == 0) {
                    const f32x4 rk0 = *(const f32x4*)(r_kp + h * 64 + k8), rk1 = *(const f32x4*)(r_kp + h * 64 + k8 + 4);
                    float bn = 0.f;
#pragma unroll
                    for (int j = 0; j < 4; ++j) bn += in_r[0][j] * kx4[0][j] * rk0[j] + in_r[1][j] * kx4[1][j] * rk1[j];
                    bn += __shfl_xor(bn, 1); bn += __shfl_xor(bn, 2); bn += __shfl_xor(bn, 4);
                    if ((tid & 7) == 0) ((float*)(p->ws + WS_AFF))[(size_t)(cseq * 64 + tau) * 16 + h] = bn;
                }
            }
#pragma unroll
            for (int hh2 = 0; hh2 < 2; ++hh2) {
                const f32x4 cst = *(const f32x4*)(CS + tau * 68 + k8 + 4 * hh2);
                f32x4 csp = {0.f, 0.f, 0.f, 0.f}; if (tau > 0) csp = *(const f32x4*)(CS + (tau - 1) * 68 + k8 + 4 * hh2);
                const f32x4 em = *(const f32x4*)(EM + k8 + 4 * hh2), emi = *(const f32x4*)(EMI + k8 + 4 * hh2), ecl = *(const f32x4*)(PC + k8 + 4 * hh2);
                float at[4], bt[4], kt[4], rt[4], att4[4], bh4[4], kh4[4], vv4[4];
#pragma unroll
                for (int j = 0; j < 4; ++j) {
                    const float r = in_r[hh2][j], kx = kx4[hh2][j], kn = kn4[hh2][j], b = b4[hh2][j], v = in_v[hh2][j];
                    const float ea = __expf(csp[j]), e1 = __expf(cst[j]), r1 = __builtin_amdgcn_rcpf(e1);
                    const float att = -kn * ea; at[j] = att * emi[j];
                    const float e2 = em[j] * r1; bt[j] = b * e2; kt[j] = kx * e2;
                    rt[j] = r * e1 * emi[j];
                    const float e4 = ecl[j] * r1;
                    att4[j] = att; bh4[j] = b * e4; kh4[j] = kx * e4; vv4[j] = v;
                }
                const int ob = (tau * RS + k8 + 4 * hh2) * 2;
#define RW_ST4(bufi, w) do { u32x2 o_ = {pk_bf16(w[0], w[1]), pk_bf16(w[2], w[3])}; *(u32x2*)(RBUFP(bufi) + ob) = o_; } while (0)
                RW_ST4(B_AT, at); RW_ST4(B_BT, bt); RW_ST4(B_KT, kt); RW_ST4(B_RT, rt);
                RW_ST4(B_ATT, att4); RW_ST4(B_BHT, bh4); RW_ST4(B_KHT, kh4); RW_ST4(B_VT, vv4);
#undef RW_ST4
            }
        }
        if (u + G < 8192) RW_LOAD(u + G);
        __syncthreads();
        f32x4 nkr[2];
        {
            const Frag2 yA = rw_frag2(RBUFP(B_AT), yt, fr, fq), yK = rw_frag2(RBUFP(B_KT), yt, fr, fq), yR = rw_frag2(RBUFP(B_RT), yt, fr, fq);
#pragma unroll
            for (int a = 0; a < 2; ++a) {
                const int xt = 2 * xp + a;
                const Frag2 xB = rw_frag2(RBUFP(B_BT), xt, fr, fq), xA = rw_frag2(RBUFP(B_AT), xt, fr, fq), xK = rw_frag2(RBUFP(B_KT), xt, fr, fq);
                if (xt <= yt) {
                    const f32x4 d = rw_mm(xB, yA, zero4);
#pragma unroll
                    for (int i = 0; i < 4; ++i) { const int i_ = 16 * xt + 4 * fq + i, j_ = 16 * yt + fr; MF[i_ * 68 + j_] = (i_ < j_) ? d[i] : 0.f; }
                }
                {
                    f32x4 d = rw_mm(xA, yK, zero4);
#pragma unroll
                    for (int i = 0; i < 4; ++i) { const int l_ = 16 * xt + 4 * fq + i, i_ = 16 * yt + fr; d[i] = (i_ < l_) ? d[i] : 0.f; }
                    rw_store_t(RBUFP(B_MAK), xt, yt, d, fr, fq);
                }
                {
                    f32x4 d = rw_mm(xB, yR, zero4);
#pragma unroll
                    for (int i = 0; i < 4; ++i) { const int j_ = 16 * xt + 4 * fq + i, t_ = 16 * yt + fr; d[i] = (j_ <= t_) ? d[i] : 0.f; }
                    rw_store_t(RBUFP(B_NBRT), xt, yt, d, fr, fq);
                }
                {
                    f32x4 d = rw_mm(xK, yR, zero4);
#pragma unroll
                    for (int i = 0; i < 4; ++i) { const int i_ = 16 * xt + 4 * fq + i, t_ = 16 * yt + fr; d[i] = (i_ <= t_) ? d[i] : 0.f; }
                    nkr[a] = d;
                }
            }
        }
        __syncthreads();
#if RW_SIMPLE_INV
        if (wv == 0) {
            float t[64];
#pragma unroll
            for (int l = 0; l < 64; ++l) t[l] = (l == lane) ? 1.f : 0.f;
#pragma unroll
            for (int ii = 62; ii >= 0; --ii) { float acc = 0.f; asm volatile("" ::: "memory");
#pragma unroll
                for (int l = ii + 1; l < 64; ++l) acc += MF[ii * 68 + l] * t[l];
                t[ii] += acc; }
            char* row = RBUFP(B_TT) + (lane * RS) * 2;
#pragma unroll
            for (int g4 = 0; g4 < 16; ++g4) { u32x2 o; o[0] = pk_bf16(t[4 * g4], t[4 * g4 + 1]); o[1] = pk_bf16(t[4 * g4 + 2], t[4 * g4 + 3]); *(u32x2*)(row + g4 * 8) = o; }
        }
        __syncthreads();
#else
        if (wv == 0) {
            const int I = lane >> 4, jj = lane & 15; float t[16];
#pragma unroll
            for (int l = 0; l < 16; ++l) t[l] = (l == jj) ? 1.f : 0.f;
#pragma unroll
            for (int ii = 14; ii >= 0; --ii) { float acc = 0.f;
#pragma unroll
                for (int l = ii + 1; l < 16; ++l) acc += MF[(16 * I + ii) * 68 + 16 * I + l] * t[l];
                t[ii] += acc; }
#pragma unroll
            for (int ii = 0; ii < 16; ++ii) { MF[(16 * I + ii) * 68 + 16 * I + jj] = t[ii]; }
            char* row = RBUFP(B_TT) + ((16 * I + jj) * RS + 16 * I) * 2;
#pragma unroll
            for (int g4 = 0; g4 < 4; ++g4) { u32x2 o; o[0] = pk_bf16(t[4 * g4], t[4 * g4 + 1]); o[1] = pk_bf16(t[4 * g4 + 2], t[4 * g4 + 3]); *(u32x2*)(row + g4 * 8) = o; }
        } else if (wv >= 4) {
            for (int q = tid - 256; q < 768; q += 256) { const int blk = q >> 7, w = q & 127; const int J = blk < 3 ? 0 : blk < 5 ? 1 : 2; const int I = blk < 3 ? blk + 1 : blk < 5 ? blk - 1 : 3;
                ((unsigned*)RBUFP(B_TT))[(16 * J + (w >> 3)) * (RS / 2) + 8 * I + (w & 7)] = 0u; }
        }
        __syncthreads();
        if (wv == 1) rw_offdiag<1>(MF, RBUFP(B_TT), fr, fq); else if (wv == 2) rw_offdiag<2>(MF, RBUFP(B_TT), fr, fq); else if (wv == 3) rw_offdiag<3>(MF, RBUFP(B_TT), fr, fq);
        __syncthreads();
#endif
        {
            const Frag2 yAT = rw_frag2_tr(RBUFP(B_ATT), yt, lane), yM = rw_frag2(RBUFP(B_MAK), yt, fr, fq);
#pragma unroll
            for (int a = 0; a < 2; ++a) {
                const int xt = 2 * xp + a;
                const Frag2 xT = rw_frag2(RBUFP(B_TT), xt, fr, fq);
                rw_store_t(RBUFP(B_AT), xt, yt, rw_mm(xT, yAT, zero4), fr, fq);
                rw_store_t(RBUFP(B_W2), xt, yt, rw_mm(xT, yM, zero4), fr, fq);
            }
        }
        __syncthreads();
        {
            const Frag2 yB = rw_frag2_tr(RBUFP(B_BHT), yt, lane), yN = rw_frag2(RBUFP(B_NBRT), yt, fr, fq);
            f32x4 g[2], qe[2];
#pragma unroll
            for (int a = 0; a < 2; ++a) {
                const int kt = 2 * xp + a;
                const Frag2 x1 = rw_frag2(RBUFP(B_AT), kt, fr, fq);
                f32x4 d = rw_mm(x1, yB, zero4);
                if (kt == yt) {
#pragma unroll
                    for (int i = 0; i < 4; ++i) d[i] += (4 * fq + i == fr) ? PC[16 * kt + fr] : 0.f;
                }
                g[a] = d;
                const u32x2 rv = *(const u32x2*)(RBUFP(B_RT) + ((16 * yt + fr) * RS + 16 * kt + 4 * fq) * 2);
                f32x4 init = bf4_to_f32(rv); const f32x4 em = *(const f32x4*)(EM + 16 * kt + 4 * fq);
                init = init * em;
                qe[a] = rw_mm(x1, yN, init);
            }
            { const u32x2 qq = {pk4_fp8s(qe[0]), pk4_fp8s(qe[1])};
              { const u32x2 gq = {pk4_fp8s(g[0]), pk4_fp8s(g[1])}; *(u32x2*)(p->ws + R_GREC + uidx * 4096 + (yt * 64 + lane) * 16 + xp * 8) = gq; }
              *(u32x2*)((char*)REC + (yt * 64 + lane) * 16 + xp * 8) = qq; }
#pragma unroll
            for (int a = 0; a < 2; ++a) {
                const int it = 2 * xp + a;
                const Frag2 x2 = rw_frag2(RBUFP(B_W2), it, fr, fq);
                const u32x2 kv = rw_tr4(RBUFP(B_KHT) + ((16 * it + 4 * fq + ((lane & 15) >> 2)) * RS + 16 * yt + 4 * (lane & 3)) * 2);
                rw_store_t(RBUFP(B_BT), it, yt, rw_mm(x2, yB, bf4_to_f32(kv)), fr, fq);
                rw_store_t(RBUFP(B_KT), it, yt, rw_mm(x2, yN, nkr[a]), fr, fq);
            }
        }
        __syncthreads();
        {
            const Frag2 fV = rw_frag2_tr(RBUFP(B_VT), yt, lane);
            f32x4 hd[2], yd[2];
#pragma unroll
            for (int a = 0; a < 2; ++a) {
                const Frag2 fX = rw_frag2(RBUFP(B_BT), 2 * xp + a, fr, fq), fZ = rw_frag2(RBUFP(B_KT), 2 * xp + a, fr, fq);
                hd[a] = rw_mm(fX, fV, zero4);
                yd[a] = rw_mm(fV, fZ, zero4);
            }
            REC[(4 + yt * 2 + xp) * 64 + lane] = pk8(hd[0], hd[1]);
            REC[(12 + yt * 2 + xp) * 64 + lane] = pk8(yd[0], yd[1]);
        }
        __syncthreads();
    }
#undef RW_LOAD
#undef RBUFP
}
constexpr int RW2_SLOT = 12288, RW2_NS = 11;
__device__ __forceinline__ void phase_rwkv_state_scan(KP p, char* smem) {
    const int bid = blockIdx.x, G = gridDim.x, tid = tid_(), lane = tid & 63;
    const int wvu = __builtin_amdgcn_readfirstlane(tid >> 6);
    for (int ch = bid; ch < 32; ch += G) {
        unsigned char* srec0 = p->ws + R_SREC + (size_t)ch * 256 * 4096;
        const unsigned char* grec0 = p->ws + R_GREC + (size_t)ch * 256 * 4096 + lane * 16; const unsigned char* hrec0 = rw_rec(p->ws, (size_t)ch * 256) + lane * 16;
#define RW_DMA(cc) do { char* dst_ = smem + ((cc) % RW2_NS) * RW2_SLOT; \
        _Pragma("unroll") for (int q_ = 0; q_ < 3; ++q_) { const int j_ = (wvu - 4) * 3 + q_; \
            const unsigned char* src_ = j_ < 4 ? grec0 + (size_t)(cc) * 4096 + j_ * 1024 : hrec0 + (size_t)(cc) * 20480 + j_ * 1024; \
            __builtin_amdgcn_global_load_lds((const unsigned*)src_, (unsigned LAS*)(dst_ + j_ * 1024), 16, 0, 0); } } while (0)
#define RW_RD(cc, R) do { const u32x4* sl_ = (const u32x4*)(smem + ((cc) % RW2_NS) * RW2_SLOT) + lane; \
        _Pragma("unroll") for (int i_ = 0; i_ < 4; ++i_) R[i_] = sl_[i_ * 64]; R[4] = sl_[(4 + 2 * wvu) * 64]; R[5] = sl_[(5 + 2 * wvu) * 64]; } while (0)
        __syncthreads();
        if (wvu >= 4) {
#pragma unroll
            for (int cc = 0; cc < RW2_NS; ++cc) RW_DMA(cc);
            asm volatile("s_waitcnt vmcnt(30)" ::: "memory");
            __builtin_amdgcn_s_barrier();
#pragma unroll 1
            for (int c = 0; c < 256; ++c) {
                if (c < 255) { const int yg = 254 - c < RW2_NS - 2 ? 254 - c : RW2_NS - 2;
                    if (yg == 9) asm volatile("s_waitcnt vmcnt(27)" ::: "memory"); else if (yg == 8) asm volatile("s_waitcnt vmcnt(24)" ::: "memory");
                    else if (yg == 7) asm volatile("s_waitcnt vmcnt(21)" ::: "memory"); else if (yg == 6) asm volatile("s_waitcnt vmcnt(18)" ::: "memory");
                    else if (yg == 5) asm volatile("s_waitcnt vmcnt(15)" ::: "memory"); else if (yg == 4) asm volatile("s_waitcnt vmcnt(12)" ::: "memory");
                    else if (yg == 3) asm volatile("s_waitcnt vmcnt(9)" ::: "memory"); else if (yg == 2) asm volatile("s_waitcnt vmcnt(6)" ::: "memory");
                    else if (yg == 1) asm volatile("s_waitcnt vmcnt(3)" ::: "memory"); else asm volatile("s_waitcnt vmcnt(0)" ::: "memory"); }
                __builtin_amdgcn_s_barrier();
                asm volatile("" ::: "memory");
                if (c + RW2_NS < 256) RW_DMA(c + RW2_NS);
            }
        } else {
#define RW_STEP(c, CUR, NXT) do { \
            asm volatile("s_waitcnt lgkmcnt(0)" ::: "memory"); \
            __builtin_amdgcn_s_barrier(); \
            asm volatile("" ::: "memory"); \
            if ((c) < 255) RW_RD((c) + 1, NXT); \
            u32x4 sfu0_ = {pk_bf16(sacc[0][0] * 0.125f, sacc[0][1] * 0.125f), pk_bf16(sacc[0][2] * 0.125f, sacc[0][3] * 0.125f), pk_bf16(sacc[1][0] * 0.125f, sacc[1][1] * 0.125f), pk_bf16(sacc[1][2] * 0.125f, sacc[1][3] * 0.125f)}; \
            u32x4 sfu1_ = {pk_bf16(sacc[2][0] * 0.125f, sacc[2][1] * 0.125f), pk_bf16(sacc[2][2] * 0.125f, sacc[2][3] * 0.125f), pk_bf16(sacc[3][0] * 0.125f, sacc[3][1] * 0.125f), pk_bf16(sacc[3][2] * 0.125f, sacc[3][3] * 0.125f)}; \
            { const u32x4 s8_ = {pk4_fp8c(sacc[0]), pk4_fp8c(sacc[1]), pk4_fp8c(sacc[2]), pk4_fp8c(sacc[3])}; ((u32x4*)(srec0 + (size_t)(c) * 4096 + wvu * 1024))[lane] = s8_; }        \
            const bf16x8 sf0_ = __builtin_bit_cast(bf16x8, sfu0_), sf1_ = __builtin_bit_cast(bf16x8, sfu1_); \
            _Pragma("unroll") for (int mt = 0; mt < 4; ++mt) { \
                const u32x4 hv_ = CUR[4 + (mt >> 1)]; const u32x2 hi2_ = {hv_[(mt & 1) * 2], hv_[(mt & 1) * 2 + 1]}; \
                f32x4 s2_ = bf4_to_f32(hi2_); \
                s2_ = mfma16(fp8x8_to_bf16(CUR[mt][0], CUR[mt][1]), sf0_, s2_);         \
                s2_ = mfma16(fp8x8_to_bf16(CUR[mt][2], CUR[mt][3]), sf1_, s2_); \
                sacc[mt] = s2_; } } while (0)
            __builtin_amdgcn_s_barrier();
            asm volatile("" ::: "memory");
            u32x4 ra[6], rb[6];
            RW_RD(0, ra);
            f32x4 sacc[4];
#pragma unroll
            for (int mt = 0; mt < 4; ++mt) sacc[mt] = (f32x4){0.f, 0.f, 0.f, 0.f};
#pragma unroll 1
            for (int c = 0; c < 256; c += 2) { RW_STEP(c, ra, rb); RW_STEP(c + 1, rb, ra); }
#undef RW_STEP
        }
        asm volatile("s_waitcnt vmcnt(0)" ::: "memory");
        __syncthreads();
#undef RW_DMA
#undef RW_RD
    }
}
__device__ __forceinline__ void phase_rwkv_post(KP p, char* smem) {
    const int bid = blockIdx.x, G = gridDim.x;
    const bf16_t* VV = (const bf16_t*)(p->ws + R_VV); const bf16_t* GG = (const bf16_t*)(p->ws + R_G); bf16_t* YG = (bf16_t*)(p->ws + R_YG);
    const float* ln_w = p->in[22]; const float* ln_b = p->in[23]; const float* BN = (const float*)(p->ws + WS_AFF);
    float* YS = (float*)smem;
    u32x4 a_sf0[2], a_yl[2], a_qa[2], a_qb[2];
#define PO_LOAD(uu) do { const int cs_ = (uu) >> 4, h_ = (uu) & 15; const int tl_ = tid_(), ln_ = tl_ & 63, wv_ = tl_ >> 6, vt_ = wv_ & 3, xp_ = wv_ >> 2; \
        _Pragma("unroll") for (int z_ = 0; z_ < 2; ++z_) { const size_t ui_ = (size_t)(z_ * 16 + h_) * 256 + (z_ ? 255 - cs_ : cs_); \
            const unsigned char* rec_ = rw_rec(p->ws, ui_) + ln_ * 16; const unsigned char* sr_ = p->ws + R_SREC + ui_ * 4096 + vt_ * 1024 + ln_ * 16; \
            a_sf0[z_] = *(const u32x4*)sr_; a_yl[z_] = NTL((const u32x4*)(rec_ + (12 + vt_ * 2 + xp_) * 1024)); \
            a_qa[z_] = *(const u32x4*)(rec_ + (2 * xp_) * 1024); a_qb[z_] = *(const u32x4*)(rec_ + (1 + 2 * xp_) * 1024); } } while (0)
    if (bid < 4096) PO_LOAD(bid);
    for (int u = bid; u < 4096; u += G) {
        const int cseq = u >> 4, h = u & 15;
        const int tl = tid_(), lane = tl & 63, wv = tl >> 6, fr = lane & 15, fq = lane >> 4, vt = wv & 3, xp = wv >> 2;
        const int c4 = (tl & 15) * 4, cc = h * 64 + c4;
        u32x2 vv[2], gg[2]; float bnq[2];
#pragma unroll
        for (int q = 0; q < 2; ++q) { const int tok = cseq * 64 + (tl >> 4) + q * 32; const size_t o = (size_t)tok * 1024 + cc;
            vv[q] = NTL((const u32x2*)(VV + o)); gg[q] = NTL((const u32x2*)(GG + o)); bnq[q] = BN[(size_t)tok * 16 + h]; }
        const f32x4 lwq = *(const f32x4*)(ln_w + cc), lbq = *(const f32x4*)(ln_b + cc);
#pragma unroll
        for (int z = 0; z < 2; ++z) {
            const bf16x8 sf0 = fp8x8_to_bf16(a_sf0[z][0], a_sf0[z][1]), sf1 = fp8x8_to_bf16(a_sf0[z][2], a_sf0[z][3]);
#pragma unroll
            for (int a = 0; a < 2; ++a) {
                const u32x2 yi = {a_yl[z][2 * a], a_yl[z][2 * a + 1]}; const u32x4 q8 = a ? a_qb[z] : a_qa[z];
                f32x4 y = {0.f, 0.f, 0.f, 0.f};
                y = mfma16(sf0, fp8x8_to_bf16(q8[0], q8[1]), y);
                y = mfma16(sf1, fp8x8_to_bf16(q8[2], q8[3]), y);
                y = bf4_to_f32(yi) + y * 0.125f;
                const int tau = 16 * (2 * xp + a) + fr, sl = z ? 63 - tau : tau;
                *(f32x4*)(YS + (z * 64 + sl) * 68 + 16 * vt + 4 * fq) = y;
            }
        }
        if (u + G < 4096) PO_LOAD(u + G);
        __syncthreads();
#pragma unroll
        for (int q = 0; q < 2; ++q) {
            const int sl = (tl >> 4) + q * 32; const size_t o = (size_t)(cseq * 64 + sl) * 1024 + cc;
            const f32x4 y = *(const f32x4*)(YS + sl * 68 + c4) + *(const f32x4*)(YS + (64 + sl) * 68 + c4);
            float sm = y[0] + y[1] + y[2] + y[3];
            sm += __shfl_xor(sm, 1); sm += __shfl_xor(sm, 2); sm += __shfl_xor(sm, 4); sm += __shfl_xor(sm, 8);
            const float mean = sm * (1.f / 64.f);
            const f32x4 dlt = y - mean;
            float vs = dlt[0] * dlt[0] + dlt[1] * dlt[1] + dlt[2] * dlt[2] + dlt[3] * dlt[3];
            vs += __shfl_xor(vs, 1); vs += __shfl_xor(vs, 2); vs += __shfl_xor(vs, 4); vs += __shfl_xor(vs, 8);
            const float rs = rsqrtf(vs * (1.f / 64.f) + 64e-5f);
            const f32x4 v = bf4_to_f32(vv[q]); const float bn = bnq[q];
            const float g0 = bf_lo(gg[q][0]), g1 = bf_hi(gg[q][0]), g2 = bf_lo(gg[q][1]), g3 = bf_hi(gg[q][1]);
            f32x4 out;
#pragma unroll
            for (int j = 0; j < 4; ++j) out[j] = dlt[j] * rs * lwq[j] + lbq[j] + bn * v[j];
            u32x2 w; w[0] = pk_bf16(out[0] * g0, out[1] * g1); w[1] = pk_bf16(out[2] * g2, out[3] * g3);
            *(u32x2*)(YG + o) = w;
        }
        __syncthreads();
    }
#undef PO_LOAD
}

__global__ void __launch_bounds__(NTHR, 2) fwd_kernel(Params p_) {
    KP p = (KP)__builtin_amdgcn_kernarg_segment_ptr();
    extern __shared__ __attribute__((aligned(16))) char smem[];
    __shared__ uint4 xb_words;
    const int lo = p_.lo, hi = p_.hi;
    const bool multi = (hi - lo) > 1;
    XcdBarrier bar; bar.bar = (unsigned*)(p->ws + WS_BAR); bar.x = 0; bar.st = (volatile LAS unsigned*)&xb_words;
    if (multi) {
        if (tid_() == 0) xb_words = make_uint4(0u, 0u, 0u, 0u);
        __syncthreads();
        bar = xcd_barrier_post((unsigned*)(p->ws + WS_BAR), (volatile LAS unsigned*)&xb_words);
    }
#if defined(PHASE_MASK)
#define IN(k) (((PHASE_MASK >> (k)) & 1) && lo <= (k) && (k) < hi)
#elif defined(ONLY_PHASE)
#define IN(k) ((k) == ONLY_PHASE && lo <= (k) && (k) < hi)
#else
#define IN(k) (lo <= (k) && (k) < hi)
#endif
#define SEAM(k) do { if (IN(k) && IN((k) + 1)) xcd_barrier(bar); asm volatile("" : "+s"(p) :: "memory"); } while (0)
#define XA ((bf16_t*)(p->ws + WS_XA))
#define XB ((bf16_t*)(p->ws + WS_XB))

    if (IN(0)) { phase_prologue(p, smem); } SEAM(0);
    if (IN(1)) {
        EpiProj E{(bf16_t*)(p->ws + A_Q), (bf16_t*)(p->ws + A_V), (bf16_t*)(p->ws + A_KF), (bf16_t*)(p->ws + A_AQ), (bf16_t*)(p->ws + A_AK), (bf16_t*)(p->ws + A_AV), (bf16_t*)(p->ws + A_LOGF), (bf16_t*)(p->ws + A_GATE), (const float*)(p->ws + WS_LB)};
        int pre = 0;
        for (int L = blockIdx.x; L < 64 * 16; L += gridDim.x) { int pm, pn; tile_order(L, 64, 16, pm, pn);
            const int Ln = L + gridDim.x; GemmNext nx{(const bf16_t*)(p->ws + A_H0), (const bf16_t*)(p->ws + WS_WT_IN), nullptr, 0, 0, Ln < 64 * 16 ? 1 : 0};
            if (nx.valid) { int pm2, pn2; tile_order(Ln, 64, 16, pm2, pn2); nx.brow = pm2 * 256; nx.bcol = pn2 * 256; }
            gemm_tile((const bf16_t*)(p->ws + A_H0), (const bf16_t*)(p->ws + WS_WT_IN), 1024, pm * 256, pn * 256, (bf16_t*)smem, E, nullptr, pre, nx); pre = nx.valid; }
    } SEAM(1);
    if (IN(2)) { phase_hgrn_local(p, smem); phase_attention(p, smem); } SEAM(2);
    if (IN(3)) { phase_hgrn_scan(p); phase_attn_merge(p); } SEAM(3);
    if (IN(4)) { phase_hgrn_out(p, smem); } SEAM(4);
    if (IN(5)) {
        for (int L = blockIdx.x; L < 64 * 4; L += gridDim.x) { int pm, pn; tile_order(L, 64, 4, pm, pn);
            EpiResid E{p->in[0], nullptr, XA, (bf16_t*)(p->ws + M_HB), (const float*)(p->ws + WS_GT), (float*)(p->ws + M_RPART), (float*)(p->ws + M_RPSS), (unsigned*)(p->ws + WS_RCNT),
                       (float*)(p->ws + WS_AFF), (float*)(p->ws + WS_RSTD), (int*)(p->ws + WS_SLOT), smem, pm, pn};
            gemm_tile((const bf16_t*)(p->ws + A_YAB), (const bf16_t*)(p->ws + WS_WT_OUT), 1024, pm * 256, pn * 256, (bf16_t*)smem, E); }
    } SEAM(5);
    if (IN(7)) { phase_moe_select(p, smem);
        { int cb = (int)blockIdx.x - 16, cG = (int)gridDim.x - 16; if (cG <= 0) { cb = blockIdx.x; cG = gridDim.x; }
          if (cb >= 0) { __syncthreads(); cvt_moe_tiles(p, 0, 12, 16, cb, cG, (float*)smem); } }
    } SEAM(7);
    if (IN(9)) { moe_gemms_gateup(p, smem); } SEAM(9);
    if (IN(10)) { moe_gemms_down(p, smem); } SEAM(10);
    if (IN(11)) { phase_combine_mix(p, XA, XB, p->in[7], smem); } SEAM(11);
    if (IN(13)) {
        const bf16_t* MIX = (const bf16_t*)(p->ws + R_MIX);
        int pre = 0;
        for (int L = blockIdx.x; L < 1024; L += gridDim.x) {
            EpiRkvLora E; const bf16_t* Ap; const bf16_t* Bp; int pm, pn;
            if (L < 768) { const int job = L >> 8; tile_order(L & 255, 64, 4, pm, pn);
                E.isl = 0; E.outb = (bf16_t*)(p->ws + (job == 0 ? R_RR : job == 1 ? R_KK : R_VV)); E.out = nullptr; E.al = E.be = E.ga = E.de = 0.f;
                Ap = MIX + (size_t)job * S * 1024; Bp = (const bf16_t*)(p->ws + WS_WT_RKV) + (size_t)job * 1024 * 1024; }
            else { const int job = (L - 768) >> 6; pm = (L - 768) & 63; pn = 0;
                const int mi = job == 0 ? 5 : job == 1 ? 6 : job == 2 ? 3 : 4;
                E.isl = 1; E.outb = nullptr; E.out = (bf16_t*)(p->ws + R_L1O) + (size_t)job * S * 128;
                E.al = job < 2 ? 2.f : job == 2 ? 0.f : 1.f; E.be = job < 2 ? 2.f : 1.f; E.ga = job < 2 ? -1.f : 0.f; E.de = job == 2 ? 1.f : 0.f;
                Ap = MIX + (size_t)mi * S * 1024; Bp = (const bf16_t*)(p->ws + WS_WT_L1) + (size_t)job * 256 * 1024; }
            const int Ln = L + gridDim.x; GemmNext nx{nullptr, nullptr, nullptr, 0, 0, Ln < 1024 ? 1 : 0};
            if (nx.valid) {
                if (Ln < 768) { const int job2 = Ln >> 8; int pm2, pn2; tile_order(Ln & 255, 64, 4, pm2, pn2);
                    nx.A = MIX + (size_t)job2 * S * 1024; nx.Bt = (const bf16_t*)(p->ws + WS_WT_RKV) + (size_t)job2 * 1024 * 1024; nx.brow = pm2 * 256; nx.bcol = pn2 * 256; }
                else { const int job2 = (Ln - 768) >> 6; const int mi2 = job2 == 0 ? 5 : job2 == 1 ? 6 : job2 == 2 ? 3 : 4;
                    nx.A = MIX + (size_t)mi2 * S * 1024; nx.Bt = (const bf16_t*)(p->ws + WS_WT_L1) + (size_t)job2 * 256 * 1024; nx.brow = ((Ln - 768) & 63) * 256; nx.bcol = 0; }
            }
            gemm_tile(Ap, Bp, 1024, pm * 256, pn * 256, (bf16_t*)smem, E, nullptr, pre, nx); pre = nx.valid;
        }
    } SEAM(13);
    if (IN(14)) {
        int pre = 0;
        for (int L = blockIdx.x; L < 4 * 256; L += gridDim.x) { const int job = L >> 8; int pm, pn; tile_order(L & 255, 64, 4, pm, pn);
            const int Ln = L + gridDim.x; GemmNext nx{nullptr, nullptr, nullptr, 0, 0, Ln < 4 * 256 ? 1 : 0};
            if (nx.valid) { const int job2 = Ln >> 8; int pm2, pn2; tile_order(Ln & 255, 64, 4, pm2, pn2);
                nx.A = (const bf16_t*)(p->ws + R_L1O) + (size_t)job2 * S * 128; nx.Bt = (const bf16_t*)(p->ws + WS_WT_L2) + (size_t)job2 * 1024 * 128; nx.brow = pm2 * 256; nx.bcol = pn2 * 256; }
            EpiLora2 E;
            if (job < 2) { E.isg = 0; E.scale = -0.6065306597126334f; E.bias = p->in[11] + job * 1024; E.outb = (bf16_t*)(p->ws + R_LOGW) + (size_t)job * S * 1024; }
            else if (job == 2) { E.isg = 0; E.scale = 1.f; E.bias = p->in[14]; E.outb = (bf16_t*)(p->ws + R_AA); }
            else { E.isg = 1; E.scale = 0.f; E.bias = p->in[14]; E.outb = (bf16_t*)(p->ws + R_G); }
            gemm_tile((const bf16_t*)(p->ws + R_L1O) + (size_t)job * S * 128, (const bf16_t*)(p->ws + WS_WT_L2) + (size_t)job * 1024 * 128, 128, pm * 256, pn * 256, (bf16_t*)smem, E, nullptr, pre, nx); pre = nx.valid; }
    } SEAM(14);
    if (IN(16)) { phase_rwkv_chunk_local(p, smem); } SEAM(16);
    if (IN(17)) {
        phase_rwkv_state_scan(p, smem);
        int cb = (int)blockIdx.x - 32, cG = (int)gridDim.x - 32; if (cG <= 0) { cb = blockIdx.x; cG = gridDim.x; }
        if (cb >= 0) { int rot = 0; __syncthreads(); cvt_moe_layer(p, 1, 0, 12, rot, cb, cG, (float*)smem); }
    } SEAM(17);
    if (IN(18)) { phase_rwkv_post(p, smem); } SEAM(18);
    if (IN(19)) {
        for (int L = blockIdx.x; L < 64 * 4; L += gridDim.x) { int pm, pn; tile_order(L, 64, 4, pm, pn);
            EpiResid E{nullptr, XB, XA, (bf16_t*)(p->ws + M_HB), (const float*)(p->ws + WS_GT) + 16 * 1024, (float*)(p->ws + M_RPART), (float*)(p->ws + M_RPSS), (unsigned*)(p->ws + WS_RCNT) + 64,
                       (float*)(p->ws + WS_AFF), (float*)(p->ws + WS_RSTD), (int*)(p->ws + WS_SLOT), smem, pm, pn};
            gemm_tile((const bf16_t*)(p->ws + R_YG), (const bf16_t*)(p->ws + WS_WT_COUT), 1024, pm * 256, pn * 256, (bf16_t*)smem, E); }
    } SEAM(19);
    if (IN(21)) { phase_moe_select(p, smem);
        { int cb = (int)blockIdx.x - 16, cG = (int)gridDim.x - 16; if (cG <= 0) { cb = blockIdx.x; cG = gridDim.x; }
          if (cb >= 0) { __syncthreads(); cvt_moe_tiles(p, 1, 12, 16, cb, cG, (float*)smem); } }
    } SEAM(21);
    if (IN(23)) { moe_gemms_gateup(p, smem); } SEAM(23);
    if (IN(24)) { moe_gemms_down(p, smem); } SEAM(24);
    if (IN(25)) { phase_moe_combine(p, XA, nullptr, p->in[30], p->out); }
#undef IN
#undef SEAM
#undef XA
#undef XB
}

extern "C" void kernel_launch(void* const* d_in, const int* in_sizes, int n_in, void* d_out, int out_size, void* d_ws, size_t ws_size, hipStream_t stream) {
    static int grid = 0;
    if (grid == 0) {
        if (n_in != 31 || ws_size < WS_END) { fprintf(stderr, "kernel_launch: unexpected n_in %d or ws_size %zu (< %zu)\n", n_in, ws_size, (size_t)WS_END); grid = -1; return; }
        int dev = 0, cus = 0;
        if (hipGetDevice(&dev) != hipSuccess || hipDeviceGetAttribute(&cus, hipDeviceAttributeMultiprocessorCount, dev) != hipSuccess) { grid = -1; return; }
        if (hipFuncSetAttribute((const void*)fwd_kernel, hipFuncAttributeMaxDynamicSharedMemorySize, LDS_BYTES) != hipSuccess) { fprintf(stderr, "kernel_launch: hipFuncSetAttribute failed\n"); grid = -1; return; }
        int per_cu = 0;
        if (hipOccupancyMaxActiveBlocksPerMultiprocessor(&per_cu, (const void*)fwd_kernel, NTHR, LDS_BYTES) != hipSuccess || per_cu < 1) fprintf(stderr, "kernel_launch: occupancy query says %d\n", per_cu);
        (void)hipGetLastError();
        grid = cus;
    }
    if (grid < 0) return;
    (void)hipMemsetAsync((char*)d_ws + WS_BAR, 0, 16384, stream);
    Params p{};
    for (int i = 0; i < 31; ++i) p.in[i] = (const float*)d_in[i];
    p.out = (float*)d_out; p.ws = (unsigned char*)d_ws;
    if (PROBE_LO >= 0) {
        const int cuts[4] = {0, PROBE_HI, PROBE_LO, NPH}; const int ends[3] = {PROBE_HI, PROBE_HI, NPH};
        for (int li = 0; li < 3; ++li) { p.lo = cuts[li == 0 ? 0 : li == 1 ? 2 : 1]; p.hi = ends[li];
            if (li) (void)hipMemsetAsync((char*)d_ws + WS_BAR, 0, XCD_BAR_WORDS * sizeof(unsigned), stream);
            if (p.lo < p.hi) hipLaunchKernelGGL(fwd_kernel, dim3(grid), dim3(NTHR), LDS_BYTES, stream, p); }
    } else if (kSingleLaunch) {
        p.lo = 0; p.hi = NPH;
        hipLaunchKernelGGL(fwd_kernel, dim3(grid), dim3(NTHR), LDS_BYTES, stream, p);
    } else {
        for (int ph = 0; ph < NPH; ++ph) { p.lo = ph; p.hi = ph + 1; hipLaunchKernelGGL(fwd_kernel, dim3(grid), dim3(NTHR), LDS_BYTES, stream, p); }
    }
}
```
